# Optimizing an MI355X kernel written in HIP

```python
import math
import jax, jax.numpy as jnp
from jax import lax
import numpy as np

D_MODEL = 1024
BATCH = 16
SEQ = 2048
DEPTH = 1

NSA_HEADS = 8
NSA_KV_GROUPS = 2
NSA_HEAD_DIM = 64
NSA_HPG = NSA_HEADS // NSA_KV_GROUPS
CMP_BLOCK = 32
CMP_STRIDE = 16
CMP_HIDDEN = 2 * NSA_HEAD_DIM
SEL_BLOCK = 64
SEL_TOP_N = 8
SEL_QBLK = 64
WINDOW = 512
WIN_QBLK = 128
ROPE_THETA = 500000.0
ROPE_DIM = NSA_HEAD_DIM // 4
GDN_HEADS = 4
GDN_HEAD_DIM = 128
GDN_CONV = 4
GDN_CHUNK = 64
NSA_WIDTH = NSA_HEADS * NSA_HEAD_DIM
NSA_KV_WIDTH = NSA_KV_GROUPS * NSA_HEAD_DIM
GDN_WIDTH = GDN_HEADS * GDN_HEAD_DIM
MIX_WIDTH = NSA_WIDTH + GDN_WIDTH
D_FF = ((8 * D_MODEL + 3 * 256 - 1) // (3 * 256)) * 256
OFF_NSA_KV = NSA_WIDTH
OFF_NSA_GATE = OFF_NSA_KV + 6 * NSA_KV_WIDTH
OFF_GDN_QKV = OFF_NSA_GATE + 3 * NSA_HEADS
OFF_GDN_Z = OFF_GDN_QKV + 3 * GDN_WIDTH
OFF_GDN_B = OFF_GDN_Z + GDN_WIDTH
OFF_GDN_A = OFF_GDN_B + GDN_HEADS
IN_WIDTH = OFF_GDN_A + GDN_HEADS
SPLIT_POINTS = (OFF_NSA_KV, OFF_NSA_GATE, OFF_GDN_QKV, OFF_GDN_Z, OFF_GDN_B, OFF_GDN_A)
NEG_INF = -1e30
FORCE_SCORE = 1e9
RMS_EPS = 1e-6

kernel_name = "nsa_gdn_parallel_hybrid_block"


def rmsnorm(x, g):
    xf = x.astype(jnp.float32)
    y = xf * lax.rsqrt(jnp.mean(xf * xf, axis=-1, keepdims=True) + RMS_EPS)
    return (y * g.astype(jnp.float32)).astype(x.dtype)


def l2norm(x):
    return x * lax.rsqrt(jnp.sum(x * x, axis=-1, keepdims=True) + RMS_EPS)


def partial_rope(x, positions):
    half = ROPE_DIM // 2
    inv = jnp.power(ROPE_THETA, -jnp.arange(half, dtype=jnp.float32) * (2.0 / ROPE_DIM))
    ang = positions.astype(jnp.float32)[..., None] * inv
    cos = jnp.cos(ang)[:, :, None, :]
    sin = jnp.sin(ang)[:, :, None, :]
    xr = x[..., :ROPE_DIM].astype(jnp.float32)
    x1, x2 = xr[..., :half], xr[..., half:]
    rot = jnp.concatenate([x1 * cos - x2 * sin, x2 * cos + x1 * sin], axis=-1)
    return jnp.concatenate([rot.astype(x.dtype), x[..., ROPE_DIM:]], axis=-1)


def masked_softmax(s, mask):
    return jax.nn.softmax(jnp.where(mask, s, NEG_INF), axis=-1)


def nsa_compressed(q, k, v, cmp_pos, cmp_w1, cmp_w2):
    B, T = q.shape[0], q.shape[1]
    n_cmp = (T - CMP_BLOCK) // CMP_STRIDE + 1
    starts = jnp.arange(n_cmp) * CMP_STRIDE
    gidx = starts[:, None] + jnp.arange(CMP_BLOCK)[None, :]

    def compress(x, i):
        blk = x[:, gidx] + cmp_pos[i][None, None, :, None, :]
        blk = jnp.swapaxes(blk, 2, 3).reshape(B, n_cmp, NSA_KV_GROUPS, CMP_BLOCK * NSA_HEAD_DIM)
        return jax.nn.silu(blk @ cmp_w1[i]) @ cmp_w2[i]

    kc = compress(k, 0)
    vc = compress(v, 1)
    s = jnp.einsum('btghd,bngd->bghtn', q, kc, preferred_element_type=jnp.float32) * (NSA_HEAD_DIM ** -0.5)
    t = jnp.arange(T)
    valid = (starts + CMP_BLOCK - 1)[None, :] <= t[:, None]
    has_any = jnp.any(valid, axis=-1)[:, None].astype(jnp.float32)
    p = masked_softmax(s, valid) * has_any
    o = jnp.einsum('bghtn,bngd->btghd', p.astype(vc.dtype), vc)
    return o, p


def nsa_select_indices(p_cmp, T):
    n_cmp = p_cmp.shape[-1]
    n_sel = T // SEL_BLOCK
    cs = jnp.arange(n_cmp) * CMP_STRIDE
    ss = jnp.arange(n_sel) * SEL_BLOCK
    overlap = ((cs[:, None] < ss[None, :] + SEL_BLOCK) & (cs[:, None] + CMP_BLOCK > ss[None, :])).astype(jnp.float32)
    imp = jnp.einsum('bghtn,ns->bgts', p_cmp, overlap)
    cur = jnp.arange(T) // SEL_BLOCK
    j = jnp.arange(n_sel)[None, :]
    causal = j <= cur[:, None]
    forced = (j == 0) | (j == cur[:, None]) | (j == cur[:, None] - 1)
    score = jnp.where(forced, FORCE_SCORE, jnp.where(causal, imp, NEG_INF))
    n_top = min(SEL_TOP_N, n_sel)
    _, idx = lax.top_k(score, n_top)
    return idx


def nsa_selected(q, k, v, idx):
    B, T = q.shape[0], q.shape[1]
    n_sel = T // SEL_BLOCK
    n_top = idx.shape[-1]
    nq = T // SEL_QBLK
    kb = k.reshape(B, n_sel, SEL_BLOCK, NSA_KV_GROUPS, NSA_HEAD_DIM).transpose(0, 3, 1, 2, 4)
    vb = v.reshape(B, n_sel, SEL_BLOCK, NSA_KV_GROUPS, NSA_HEAD_DIM).transpose(0, 3, 1, 2, 4)
    qc = q.reshape(B, nq, SEL_QBLK, NSA_KV_GROUPS, NSA_HPG, NSA_HEAD_DIM).swapaxes(0, 1)
    ic = idx.reshape(B, NSA_KV_GROUPS, nq, SEL_QBLK, n_top).transpose(2, 0, 1, 3, 4)
    gather = jax.vmap(jax.vmap(lambda blocks, ix: blocks[ix]))
    n_keys = n_top * SEL_BLOCK

    def step(args):
        qb, ib, c = args
        kg = gather(kb, ib).reshape(B, NSA_KV_GROUPS, SEL_QBLK, n_keys, NSA_HEAD_DIM)
        vg = gather(vb, ib).reshape(B, NSA_KV_GROUPS, SEL_QBLK, n_keys, NSA_HEAD_DIM)
        s = jnp.einsum('bcghd,bgckd->bghck', qb, kg, preferred_element_type=jnp.float32) * (NSA_HEAD_DIM ** -0.5)
        t = c * SEL_QBLK + jnp.arange(SEL_QBLK)
        kpos = (ib[..., None] * SEL_BLOCK + jnp.arange(SEL_BLOCK)).reshape(B, NSA_KV_GROUPS, SEL_QBLK, n_keys)
        mask = (kpos <= t[None, None, :, None])[:, :, None]
        p = masked_softmax(s, mask)
        return jnp.einsum('bghck,bgckd->bcghd', p.astype(vg.dtype), vg)

    o = lax.map(step, (qc, ic, jnp.arange(nq)))
    return o.swapaxes(0, 1).reshape(B, T, NSA_KV_GROUPS, NSA_HPG, NSA_HEAD_DIM)


def nsa_window(q, k, v):
    B, T = q.shape[0], q.shape[1]
    nb = T // WIN_QBLK
    span = WIN_QBLK + WINDOW
    kp = jnp.pad(k, ((0, 0), (WINDOW, 0), (0, 0), (0, 0)))
    vp = jnp.pad(v, ((0, 0), (WINDOW, 0), (0, 0), (0, 0)))
    qc = q.reshape(B, nb, WIN_QBLK, NSA_KV_GROUPS, NSA_HPG, NSA_HEAD_DIM).swapaxes(0, 1)

    def step(args):
        qb, c = args
        start = c * WIN_QBLK
        kb = lax.dynamic_slice_in_dim(kp, start, span, axis=1)
        vb = lax.dynamic_slice_in_dim(vp, start, span, axis=1)
        s = jnp.einsum('bcghd,bkgd->bghck', qb, kb, preferred_element_type=jnp.float32) * (NSA_HEAD_DIM ** -0.5)
        t = start + jnp.arange(WIN_QBLK)
        kpos = start - WINDOW + jnp.arange(span)
        diff = t[:, None] - kpos[None, :]
        mask = (kpos[None, :] >= 0) & (diff >= 0) & (diff < WINDOW)
        p = masked_softmax(s, mask)
        return jnp.einsum('bghck,bkgd->bcghd', p.astype(vb.dtype), vb)

    o = lax.map(step, (qc, jnp.arange(nb)))
    return o.swapaxes(0, 1).reshape(B, T, NSA_KV_GROUPS, NSA_HPG, NSA_HEAD_DIM)


def causal_depthwise_conv(x, w):
    return lax.conv_general_dilated(x, w[:, None, :], window_strides=(1,), padding=[(GDN_CONV - 1, 0)],
                                    dimension_numbers=('NWC', 'WIO', 'NWC'), feature_group_count=x.shape[-1])


def gated_delta_rule(q, k, v, g, beta):
    B, T, H, Dk = k.shape
    Dv = v.shape[-1]
    C = GDN_CHUNK
    N = T // C

    def chunks(x):
        return x.reshape(B, N, C, H, x.shape[-1]).transpose(1, 0, 3, 2, 4)

    q = chunks(q) * (Dk ** -0.5)
    k = chunks(k)
    v = chunks(v)
    g = g.reshape(B, N, C, H).transpose(1, 0, 3, 2)
    beta = beta.reshape(B, N, C, H).transpose(1, 0, 3, 2)
    gc = jnp.cumsum(g, axis=-1)
    incl = jnp.tril(jnp.ones((C, C), dtype=bool))
    strict = jnp.tril(jnp.ones((C, C), dtype=bool), -1)
    decay = jnp.exp(jnp.where(incl, gc[..., :, None] - gc[..., None, :], -jnp.inf))
    kb = k * beta[..., None]
    a = jnp.where(strict, jnp.einsum('nbhcd,nbhed->nbhce', kb, k) * decay, 0.0)
    eye = jnp.eye(C, dtype=a.dtype)
    tmat = lax.linalg.triangular_solve(a + eye, jnp.broadcast_to(eye, a.shape), left_side=True,
                                       lower=True, unit_diagonal=True)
    u = tmat @ (v * beta[..., None])
    w = tmat @ (kb * jnp.exp(gc)[..., None])
    qk = jnp.where(incl, jnp.einsum('nbhcd,nbhed->nbhce', q, k) * decay, 0.0)

    def step(S, xs):
        q_i, k_i, u_i, w_i, gc_i, qk_i = xs
        v_new = u_i - w_i @ S
        o = (q_i * jnp.exp(gc_i)[..., None]) @ S + qk_i @ v_new
        g_last = gc_i[..., -1:]
        S = S * jnp.exp(g_last)[..., None] + jnp.einsum('bhck,bhcv->bhkv', k_i * jnp.exp(g_last - gc_i)[..., None], v_new)
        return S, o

    S0 = jnp.zeros((B, H, Dk, Dv), jnp.float32)
    _, o = lax.scan(step, S0, (q, k, u, w, gc, qk))
    return o.transpose(1, 0, 3, 2, 4).reshape(B, T, H, Dv)


def gdn_mixer(qkv, z, b, a, conv_w, a_log, dt_bias, norm_g):
    B, T = qkv.shape[0], qkv.shape[1]
    qkv = jax.nn.silu(causal_depthwise_conv(qkv, conv_w)).astype(jnp.float32)
    q, k, v = jnp.split(qkv, 3, axis=-1)
    q = l2norm(q.reshape(B, T, GDN_HEADS, GDN_HEAD_DIM))
    k = l2norm(k.reshape(B, T, GDN_HEADS, GDN_HEAD_DIM))
    v = v.reshape(B, T, GDN_HEADS, GDN_HEAD_DIM)
    beta = jax.nn.sigmoid(b.astype(jnp.float32))
    g = -jnp.exp(a_log.astype(jnp.float32)) * jax.nn.softplus(a.astype(jnp.float32) + dt_bias.astype(jnp.float32))
    o = gated_delta_rule(q, k, v, g, beta)
    o = rmsnorm(o, norm_g) * jax.nn.silu(z.reshape(B, T, GDN_HEADS, GDN_HEAD_DIM).astype(jnp.float32))
    return o.reshape(B, T, GDN_WIDTH).astype(z.dtype)


def hybrid_layer(x, positions, norm1_g, w_in, cmp_pos, cmp_w1, cmp_w2, nsa_norm_g, gdn_conv_w, gdn_a_log,
                 gdn_dt_bias, gdn_norm_g, w_out, norm2_g, w_gate, w_up, w_down):
    B, T = x.shape[0], x.shape[1]
    h = rmsnorm(x, norm1_g)
    proj = h @ w_in
    nsa_q, nsa_kv, nsa_gate, gdn_qkv, gdn_z, gdn_b, gdn_a = jnp.split(proj, SPLIT_POINTS, axis=-1)
    q = partial_rope(nsa_q.reshape(B, T, NSA_HEADS, NSA_HEAD_DIM), positions)
    q = q.reshape(B, T, NSA_KV_GROUPS, NSA_HPG, NSA_HEAD_DIM)
    kv = nsa_kv.reshape(B, T, 6, NSA_KV_GROUPS, NSA_HEAD_DIM)
    k_cmp = partial_rope(kv[:, :, 0], positions)
    k_slc = partial_rope(kv[:, :, 2], positions)
    k_win = partial_rope(kv[:, :, 4], positions)
    o_cmp, p_cmp = nsa_compressed(q, k_cmp, kv[:, :, 1], cmp_pos, cmp_w1, cmp_w2)
    idx = nsa_select_indices(p_cmp, T)
    o_slc = nsa_selected(q, k_slc, kv[:, :, 3], idx)
    o_win = nsa_window(q, k_win, kv[:, :, 5])
    gates = jax.nn.sigmoid(nsa_gate.astype(jnp.float32)).reshape(B, T, NSA_KV_GROUPS, NSA_HPG, 3)
    o_nsa = gates[..., 0:1] * o_cmp + gates[..., 1:2] * o_slc + gates[..., 2:3] * o_win
    o_nsa = rmsnorm(o_nsa.reshape(B, T, NSA_WIDTH).astype(x.dtype), nsa_norm_g)
    o_gdn = gdn_mixer(gdn_qkv, gdn_z, gdn_b, gdn_a, gdn_conv_w, gdn_a_log, gdn_dt_bias, gdn_norm_g)
    x = x + jnp.concatenate([o_nsa, o_gdn], axis=-1) @ w_out
    h = rmsnorm(x, norm2_g)
    x = x + (jax.nn.silu(h @ w_gate) * (h @ w_up)) @ w_down
    return x


def setup_inputs(seed: int = 0) -> dict:
    key = jax.random.key(seed)
    ks = jax.random.split(key, 20)
    f32 = jnp.float32
    L = DEPTH

    def nrm(k, shape, scale):
        return jax.random.normal(k, shape, f32) * scale

    x = nrm(ks[0], (BATCH, SEQ, D_MODEL), 1.0)
    positions = jnp.tile(jnp.arange(SEQ, dtype=jnp.int32)[None, :], (BATCH, 1))
    norm1_g = 1.0 + nrm(ks[1], (L, D_MODEL), 0.02)
    w_in = nrm(ks[2], (L, D_MODEL, IN_WIDTH), D_MODEL ** -0.5)
    cmp_pos = nrm(ks[3], (L, 2, CMP_BLOCK, NSA_HEAD_DIM), 0.1)
    cmp_w1 = nrm(ks[4], (L, 2, CMP_BLOCK * NSA_HEAD_DIM, CMP_HIDDEN), (CMP_BLOCK * NSA_HEAD_DIM) ** -0.5)
    cmp_w2 = nrm(ks[5], (L, 2, CMP_HIDDEN, NSA_HEAD_DIM), CMP_HIDDEN ** -0.5)
    nsa_norm_g = 1.0 + nrm(ks[6], (L, NSA_WIDTH), 0.02)
    gdn_conv_w = nrm(ks[7], (L, GDN_CONV, 3 * GDN_WIDTH), GDN_CONV ** -0.5)
    gdn_a_log = jnp.log(jax.random.uniform(ks[8], (L, GDN_HEADS), f32, 1.0, 16.0))
    dt = jnp.exp(jax.random.uniform(ks[9], (L, GDN_HEADS), f32, math.log(1e-3), math.log(1e-1)))
    gdn_dt_bias = dt + jnp.log(-jnp.expm1(-dt))
    gdn_norm_g = 1.0 + nrm(ks[10], (L, GDN_HEAD_DIM), 0.02)
    w_out = nrm(ks[11], (L, MIX_WIDTH, D_MODEL), MIX_WIDTH ** -0.5)
    norm2_g = 1.0 + nrm(ks[12], (L, D_MODEL), 0.02)
    w_gate = nrm(ks[13], (L, D_MODEL, D_FF), D_MODEL ** -0.5)
    w_up = nrm(ks[14], (L, D_MODEL, D_FF), D_MODEL ** -0.5)
    w_down = nrm(ks[15], (L, D_FF, D_MODEL), D_FF ** -0.5)
    final_g = 1.0 + nrm(ks[16], (D_MODEL,), 0.02)
    return {"x": x, "positions": positions, "norm1_g": norm1_g, "w_in": w_in, "cmp_pos": cmp_pos,
            "cmp_w1": cmp_w1, "cmp_w2": cmp_w2, "nsa_norm_g": nsa_norm_g, "gdn_conv_w": gdn_conv_w,
            "gdn_a_log": gdn_a_log, "gdn_dt_bias": gdn_dt_bias, "gdn_norm_g": gdn_norm_g, "w_out": w_out,
            "norm2_g": norm2_g, "w_gate": w_gate, "w_up": w_up, "w_down": w_down, "final_g": final_g}


def reference(x, positions, norm1_g, w_in, cmp_pos, cmp_w1, cmp_w2, nsa_norm_g, gdn_conv_w, gdn_a_log,
              gdn_dt_bias, gdn_norm_g, w_out, norm2_g, w_gate, w_up, w_down, final_g):
    for l in range(DEPTH):
        x = hybrid_layer(x, positions, norm1_g[l], w_in[l], cmp_pos[l], cmp_w1[l], cmp_w2[l], nsa_norm_g[l],
                         gdn_conv_w[l], gdn_a_log[l], gdn_dt_bias[l], gdn_norm_g[l], w_out[l], norm2_g[l],
                         w_gate[l], w_up[l], w_down[l])
    return rmsnorm(x, final_g)
```

```cpp
#include <hip/hip_runtime.h>
#include <stdint.h>
#include <stdio.h>

typedef unsigned short bf16_t;

constexpr int BATCH = 16, SEQ = 2048, DM = 1024, MTOK = BATCH * SEQ;
constexpr int NSA_HEADS = 8, NSA_G = 2, HPG = 4, HD = 64;
constexpr int NCMP = 127, CMP_L = 32, CMP_S = 16, CMP_HID = 128;
constexpr int NSEL = 32, SELB = 64, TOPN = 8, WIN = 512;
constexpr int GH = 4, GD = 128, DFF = 2816;
constexpr int IN_W = 3360;
constexpr int PJ = 3584;
constexpr int PC_Q = 0, PC_KCMP = 512, PC_VCMP = 640, PC_KSLC = 768, PC_VSLC = 896, PC_KWIN = 1024, PC_VWIN = 1152;
constexpr int PC_GQ = 1280, PC_GK = 1792, PC_GV = 2304, PC_Z = 2816, PC_GATE = 3328, PC_B = 3352, PC_A = 3356;
constexpr float RMS_EPS = 1e-6f;
constexpr float QSCALE = 0.125f * 1.4426950408889634f;

constexpr size_t MiB = 1u << 20;
constexpr size_t WS_CTL = 0;
constexpr size_t WS_ROPE = 1 * MiB;
constexpr size_t WS_KC = 3 * MiB;
constexpr size_t WS_VC = 3 * MiB + 512 * 1024;
constexpr size_t WS_SSQN = 4 * MiB;
constexpr size_t WS_SS2 = 5 * MiB;
constexpr size_t WS_SS3 = 7 * MiB;
constexpr size_t WS_WIN = 9 * MiB;
constexpr size_t WS_WOUT = 16 * MiB;
constexpr size_t WS_WGU = 18 * MiB;
constexpr size_t WS_WDN = 29 * MiB;
constexpr size_t WS_W1T = 35 * MiB;
constexpr size_t WS_W2T = 36 * MiB;
constexpr size_t WS_GL = 37 * MiB;
constexpr size_t WS_XN = 40 * MiB;
constexpr size_t WS_MIX = 104 * MiB;
constexpr size_t WS_PROJ = 168 * MiB;
constexpr size_t WS_END = 392 * MiB;

__device__ __forceinline__ float bf2f(bf16_t v) { return __uint_as_float(((unsigned)v) << 16); }
__device__ __forceinline__ bf16_t f2bf(float f) { unsigned u = __float_as_uint(f); return (bf16_t)((u + 0x7fffu + ((u >> 16) & 1u)) >> 16); }
__device__ __forceinline__ float wave_sum(float v) {
#pragma unroll
    for (int o = 1; o < 64; o <<= 1) v += __shfl_xor(v, o);
    return v;
}
__device__ __forceinline__ float wave_max(float v) {
#pragma unroll
    for (int o = 1; o < 64; o <<= 1) v = fmaxf(v, __shfl_xor(v, o));
    return v;
}
__device__ __forceinline__ float siluf(float x) { return x / (1.f + __expf(-x)); }
__device__ __forceinline__ float sigmf(float x) { return 1.f / (1.f + __expf(-x)); }

__host__ __device__ __forceinline__ int win_orig_col(int p) {
    if (p < 1280) return p;
    if (p < 2816) return p - 1280 + 1304;
    if (p < 3328) return p - 2816 + 2840;
    if (p < 3352) return p - 3328 + 1280;
    if (p < 3360) return p;
    return -1;
}
__global__ void __launch_bounds__(128) k_compress_naive(const bf16_t* proj, const float* cmp_pos, const float* w1, const float* w2, bf16_t* kc, bf16_t* vc) {
    int id = blockIdx.x; const int n = id & 127; id >>= 7; const int g = id & 1; id >>= 1; const int b = id & 15; const int i = id >> 4;
    const int j = threadIdx.x; __shared__ float hid[128];
    bf16_t* outp = (i == 0 ? kc : vc) + ((size_t)(b * 2 + g) * 128 + n) * 64;
    if (n == 127) { if (j < 64) outp[j] = 0; return; }
    const bf16_t* xb = proj + (size_t)(b * SEQ + 16 * n) * PJ + (i == 0 ? PC_KCMP : PC_VCMP) + g * 64;
    const float* pw = w1 + (size_t)i * 2048 * 128; const float* pp = cmp_pos + i * 2048;
    float acc = 0.f;
    for (int l = 0; l < 32; ++l)
        for (int d = 0; d < 64; ++d) acc += (bf2f(xb[(size_t)l * PJ + d]) + pp[l * 64 + d]) * pw[(size_t)(l * 64 + d) * 128 + j];
    hid[j] = siluf(acc); __syncthreads();
    if (j < 64) { float o = 0.f; const float* q = w2 + (size_t)i * 128 * 64;
        for (int jj = 0; jj < 128; ++jj) o += hid[jj] * q[jj * 64 + j];
        outp[j] = f2bf(o); }
}
__global__ void __launch_bounds__(256) k_nsa_naive(const bf16_t* proj, const bf16_t* kc, const bf16_t* vc, bf16_t* mix, float* ssqn) {
    const int m = blockIdx.x >> 1, g = blockIdx.x & 1, b = m / SEQ, t = m % SEQ;
    const int w = threadIdx.x >> 6, lane = threadIdx.x & 63, head = g * 4 + w, cur = t >> 6;
    __shared__ float sc[4][512]; __shared__ float imp[32]; __shared__ unsigned selmask; __shared__ int sellist[8];
    const float NEGB = -1e30f;
    float q[64];
    { const bf16_t* qp = proj + (size_t)m * PJ + PC_Q + head * 64;
#pragma unroll
      for (int d = 0; d < 64; ++d) q[d] = bf2f(qp[d]); }
    const size_t rowb = (size_t)b * SEQ;
    float o_cmp = 0.f;
    {
        const bf16_t* kcb = kc + (size_t)(b * 2 + g) * 128 * 64; const bf16_t* vcb = vc + (size_t)(b * 2 + g) * 128 * 64;
        float s[2]; float mx = NEGB;
#pragma unroll
        for (int i = 0; i < 2; ++i) { const int n = lane + 64 * i; float a = 0.f; const bf16_t* kp = kcb + n * 64;
#pragma unroll
            for (int d = 0; d < 64; ++d) a += q[d] * bf2f(kp[d]);
            const bool valid = (n < NCMP) && (16 * n + 31 <= t); s[i] = valid ? a : NEGB; mx = fmaxf(mx, s[i]); }
        mx = wave_max(mx); float p[2], sum = 0.f;
#pragma unroll
        for (int i = 0; i < 2; ++i) { p[i] = s[i] > -1e29f ? exp2f(s[i] - mx) : 0.f; sum += p[i]; }
        sum = wave_sum(sum); const float inv = (t >= 31 && sum > 0.f) ? 1.f / sum : 0.f;
#pragma unroll
        for (int i = 0; i < 2; ++i) sc[w][lane + 64 * i] = p[i] * inv;
        __syncthreads();
        for (int n = 0; n < NCMP; ++n) o_cmp += sc[w][n] * bf2f(vcb[n * 64 + lane]);
        if (threadIdx.x < 32) { const int s_ = threadIdx.x; float a = 0.f;
            for (int h = 0; h < 4; ++h) for (int n = 4 * s_ - 1; n <= 4 * s_ + 3; ++n) if (n >= 0 && n < NCMP) a += sc[h][n];
            imp[s_] = a; }
        __syncthreads();
        if (threadIdx.x == 0) { unsigned mask = 0u;
            for (int r = 0; r < TOPN; ++r) { float best = -3e38f; int bi = 0;
                for (int j = 0; j < NSEL; ++j) { if (mask >> j & 1u) continue;
                    const bool forced = (j == 0) || (j == cur) || (j == cur - 1);
                    const float v = forced ? 1e9f : (j <= cur ? imp[j] : NEGB);
                    if (v > best) { best = v; bi = j; } }
                mask |= 1u << bi; sellist[r] = bi; }
            selmask = mask; }
        __syncthreads();
    }
    float o_slc = 0.f;
    {
        float s[8]; float mx = NEGB;
#pragma unroll
        for (int i = 0; i < 8; ++i) { const int j = sellist[i]; const int kpos = 64 * j + lane; float a = NEGB;
            if (kpos <= t) { const bf16_t* kp = proj + (rowb + kpos) * PJ + PC_KSLC + g * 64; a = 0.f;
#pragma unroll
                for (int d = 0; d < 64; ++d) a += q[d] * bf2f(kp[d]); }
            s[i] = a; mx = fmaxf(mx, a); }
        mx = wave_max(mx); float sum = 0.f;
#pragma unroll
        for (int i = 0; i < 8; ++i) { s[i] = s[i] > -1e29f ? exp2f(s[i] - mx) : 0.f; sum += s[i]; }
        sum = wave_sum(sum); const float inv = 1.f / sum;
        __syncthreads();
#pragma unroll
        for (int i = 0; i < 8; ++i) sc[w][i * 64 + lane] = s[i] * inv;
        __syncthreads();
        for (int i = 0; i < 8; ++i) { const int j = sellist[i]; if (64 * j > t) continue;
            for (int kk = 0; kk < 64; ++kk) { const int kpos = 64 * j + kk; if (kpos > t) break;
                o_slc += sc[w][i * 64 + kk] * bf2f(proj[(rowb + kpos) * PJ + PC_VSLC + g * 64 + lane]); } }
    }
    float o_win = 0.f;
    {
        float s[8]; float mx = NEGB;
#pragma unroll
        for (int i = 0; i < 8; ++i) { const int kpos = t - 511 + lane + 64 * i; float a = NEGB;
            if (kpos >= 0) { const bf16_t* kp = proj + (rowb + kpos) * PJ + PC_KWIN + g * 64; a = 0.f;
#pragma unroll
                for (int d = 0; d < 64; ++d) a += q[d] * bf2f(kp[d]); }
            s[i] = a; mx = fmaxf(mx, a); }
        mx = wave_max(mx); float sum = 0.f;
#pragma unroll
        for (int i = 0; i < 8; ++i) { s[i] = s[i] > -1e29f ? exp2f(s[i] - mx) : 0.f; sum += s[i]; }
        sum = wave_sum(sum); const float inv = 1.f / sum;
        __syncthreads();
#pragma unroll
        for (int i = 0; i < 8; ++i) sc[w][i * 64 + lane] = s[i] * inv;
        __syncthreads();
        for (int kk = 0; kk < 512; ++kk) { const int kpos = t - 511 + kk; if (kpos < 0) continue;
            o_win += sc[w][kk] * bf2f(proj[(rowb + kpos) * PJ + PC_VWIN + g * 64 + lane]); }
    }
    const bf16_t* gp = proj + (size_t)m * PJ + PC_GATE + head * 3;
    const float o = sigmf(bf2f(gp[0])) * o_cmp + sigmf(bf2f(gp[1])) * o_slc + sigmf(bf2f(gp[2])) * o_win;
    mix[(size_t)m * DM + head * 64 + lane] = f2bf(o);
    const float ss = wave_sum(o * o);
    if (lane == 0) ssqn[m * 8 + head] = ss;
}
__global__ void __launch_bounds__(128) k_gdn_naive(const bf16_t* proj, const float* conv_w, const float* a_log, const float* dt_bias, const float* norm_g, bf16_t* mix) {
    const int b = blockIdx.x >> 2, h = blockIdx.x & 3, n = threadIdx.x, wv = n >> 6, lane = n & 63;
    __shared__ float shq[128], shk[128]; __shared__ float red[2][4];
    float S[128];
#pragma unroll
    for (int k = 0; k < 128; ++k) S[k] = 0.f;
    float wq[4], wk[4], wvv[4];
#pragma unroll
    for (int j = 0; j < 4; ++j) { wq[j] = conv_w[j * 1536 + h * 128 + n]; wk[j] = conv_w[j * 1536 + 512 + h * 128 + n]; wvv[j] = conv_w[j * 1536 + 1024 + h * 128 + n]; }
    float xq0 = 0.f, xq1 = 0.f, xq2 = 0.f, xk0 = 0.f, xk1 = 0.f, xk2 = 0.f, xv0 = 0.f, xv1 = 0.f, xv2 = 0.f;
    const float Aexp = -__expf(a_log[h]), dtb = dt_bias[h], ng = norm_g[n];
    for (int t = 0; t < SEQ; ++t) {
        const bf16_t* pr = proj + (size_t)(b * SEQ + t) * PJ;
        const float xq3 = bf2f(pr[PC_GQ + h * 128 + n]), xk3 = bf2f(pr[PC_GK + h * 128 + n]), xv3 = bf2f(pr[PC_GV + h * 128 + n]);
        float qv = siluf(wq[0] * xq0 + wq[1] * xq1 + wq[2] * xq2 + wq[3] * xq3);
        float kv = siluf(wk[0] * xk0 + wk[1] * xk1 + wk[2] * xk2 + wk[3] * xk3);
        const float vv = siluf(wvv[0] * xv0 + wvv[1] * xv1 + wvv[2] * xv2 + wvv[3] * xv3);
        xq0 = xq1; xq1 = xq2; xq2 = xq3; xk0 = xk1; xk1 = xk2; xk2 = xk3; xv0 = xv1; xv1 = xv2; xv2 = xv3;
        float sq = wave_sum(qv * qv), sk = wave_sum(kv * kv);
        if (lane == 0) { red[wv][0] = sq; red[wv][1] = sk; }
        __syncthreads();
        sq = red[0][0] + red[1][0]; sk = red[0][1] + red[1][1];
        qv *= rsqrtf(sq + RMS_EPS) * 0.08838834764831845f; kv *= rsqrtf(sk + RMS_EPS);
        shq[n] = qv; shk[n] = kv;
        __syncthreads();
        const float beta = sigmf(bf2f(pr[PC_B + h])); const float av = bf2f(pr[PC_A + h]) + dtb;
        const float sp = av > 20.f ? av : log1pf(__expf(av)); const float eg = __expf(Aexp * sp);
        float dot = 0.f;
#pragma unroll
        for (int k = 0; k < 128; ++k) dot += S[k] * shk[k];
        const float vn = beta * (vv - eg * dot);
        float o = 0.f;
#pragma unroll
        for (int k = 0; k < 128; ++k) { S[k] = eg * S[k] + shk[k] * vn; o += S[k] * shq[k]; }
        float so = wave_sum(o * o);
        if (lane == 0) red[wv][2] = so;
        __syncthreads();
        so = red[0][2] + red[1][2];
        const float z = bf2f(pr[PC_Z + h * 128 + n]);
        mix[(size_t)(b * SEQ + t) * DM + 512 + h * 128 + n] = f2bf(o * rsqrtf(so * (1.f / 128.f) + RMS_EPS) * ng * siluf(z));
    }
}

namespace pg8 {
#define PG8_LAS __attribute__((address_space(3)))
typedef unsigned short bf16_t;
typedef short bf16x8 __attribute__((ext_vector_type(8)));
typedef float f32x4 __attribute__((ext_vector_type(4)));
typedef unsigned u32x4 __attribute__((ext_vector_type(4)));
constexpr int BM = 256, BK = 64, HALF = 128, HTB = HALF * BK * 2  , STAGE_BYTES = 8 * HTB, NXCD = 8, WGM = 8;

__host__ __device__ __forceinline__ int lds_byte(int r, int c) { const int st = (r >> 4) * 2 + (c >> 5), rr = r & 15, cc = c & 31, ob = rr * 64 + cc * 2; return st * 1024 + (ob ^ (((ob >> 9) & 1) << 5)); }
__host__ __device__ __forceinline__ void stage_rc(int b, int& R, int& C) { const int st = b / 1024, sb = b % 1024, swz = sb ^ (((sb >> 9) & 1) << 5); R = (st >> 1) * 16 + swz / 64; C = (st & 1) * 32 + (swz % 64) / 2; }
__host__ __device__ __forceinline__ int perm32(int rho) { const int n = rho >> 4, i = rho & 15; return 8 * (i >> 2) + 4 * n + (i & 3); }

struct Unit { int pm, pn; };
struct Gemm { const bf16_t* A; const bf16_t* Bt; int M, N, K; };

struct StaticOrder {
    int nM, nN, nwg, G, c;
    __host__ __device__ void init(int M, int N, int G_, int c_) { nM = M / BM; nN = N / BM; nwg = nM * nN; G = G_; c = c_; }
    __host__ __device__ bool next(int i, Unit& u) const {
        const long L = (long)i * G + c; if (L >= nwg) return false;
        int wgid = (int)L; { const int q = nwg / NXCD, r = nwg % NXCD, xcd = wgid % NXCD, off = wgid / NXCD; wgid = (xcd < r ? xcd * (q + 1) : r * (q + 1) + (xcd - r) * q) + off; }
        const int nig = WGM * nN, gid = wgid / nig, fm = gid * WGM, gsz = (nM - fm) < WGM ? (nM - fm) : WGM;
        u.pm = fm + ((wgid % nig) % gsz); u.pn = (wgid % nig) / gsz; return true;
    }
    __device__ __forceinline__ void a_ready(const Unit&) const {}
    __device__ __forceinline__ void done(const Unit&) const {}
};
__device__ __forceinline__ unsigned cvt_pk_bf16(float lo, float hi) { unsigned r; asm volatile("v_cvt_pk_bf16_f32 %0, %1, %2" : "=v"(r) : "v"(lo), "v"(hi)); return r; }
typedef unsigned u32x2 __attribute__((ext_vector_type(2)));
__device__ __forceinline__ float fast_silu(float v) { return v * __builtin_amdgcn_rcpf(1.0f + __builtin_amdgcn_exp2f(-1.4426950408889634f * v)); }

struct EpiProj {
    static constexpr bool PERM = true, AFTER_DRAIN = false, MIDSCALE = false;
    bf16_t* out; const float* rope; int mid_t;
    __device__ __forceinline__ void midscale(f32x4 (&)[2][2][4][2], const Unit&, int, int) const {}
    __device__ __forceinline__ void operator()(const f32x4 (&acc)[2][2][4][2], const Unit& u, int wr, int wc, int fr, int fq) const {
        const int row0 = u.pm * BM + wr * 64 + fr, colt = u.pn * BM, lcol = wc * 32 + 8 * fq;
        const float sc = (u.pn < 2) ? QSCALE : 1.f;
        const bool wave_rope = ((wc & 1) == 0) && (u.pn < 5);
#pragma unroll
        for (int ai = 0; ai < 2; ++ai)
#pragma unroll
            for (int m = 0; m < 4; ++m) {
                const int r = row0 + ai * HALF + m * 16;
                f32x4 c0 = {1.f, 1.f, 1.f, 1.f}, c1 = c0, s0 = {0.f, 0.f, 0.f, 0.f}, s1 = s0;
                if (wave_rope) { const f32x4* tp = (const f32x4*)(rope + (size_t)r * 16); c0 = tp[0]; c1 = tp[1]; s0 = tp[2]; s1 = tp[3]; }
                bf16_t* rowp = out + (size_t)r * PJ + colt + lcol;
#pragma unroll
                for (int bj = 0; bj < 2; ++bj) {
                    f32x4 v0 = acc[ai][bj][m][0] * sc, v1 = acc[ai][bj][m][1] * sc;
                    const bool tile_rope = wave_rope && ((u.pn < 2) || (bj == 0));
                    if (tile_rope) {
                        f32x4 p0, p1;
#pragma unroll
                        for (int j = 0; j < 4; ++j) { p0[j] = __shfl_xor(v0[j], 16); p1[j] = __shfl_xor(v1[j], 16); }
                        if (fq == 0) { v0 = v0 * c0 - p0 * s0; v1 = v1 * c1 - p1 * s1; }
                        else if (fq == 1) { v0 = v0 * c0 + p0 * s0; v1 = v1 * c1 + p1 * s1; }
                    }
                    u32x4 w; w.x = cvt_pk_bf16(v0[0], v0[1]); w.y = cvt_pk_bf16(v0[2], v0[3]); w.z = cvt_pk_bf16(v1[0], v1[1]); w.w = cvt_pk_bf16(v1[2], v1[3]);
                    *(u32x4*)(rowp + bj * HALF) = w;
                }
            }
    }
};
struct EpiOut {
    static constexpr bool PERM = false, AFTER_DRAIN = false, MIDSCALE = true;
    const float* x; float* x1; bf16_t* x1b; float* ss2; const float* ssqn; int mid_t;
    __device__ __forceinline__ void midscale(f32x4 (&acc)[2][2][4][2], const Unit& u, int wr, int fr) const {
#pragma unroll
        for (int ai = 0; ai < 2; ++ai)
#pragma unroll
            for (int m = 0; m < 4; ++m) {
                const int r = u.pm * BM + ai * HALF + wr * 64 + m * 16 + fr;
                const f32x4 a = *(const f32x4*)(ssqn + (size_t)r * 8), b = *(const f32x4*)(ssqn + (size_t)r * 8 + 4);
                const float s = ((a[0] + a[1]) + (a[2] + a[3])) + ((b[0] + b[1]) + (b[2] + b[3]));
                const float rs = __builtin_amdgcn_rsqf(s * (1.0f / 512.0f) + RMS_EPS);
#pragma unroll
                for (int bj = 0; bj < 2; ++bj)
#pragma unroll
                    for (int n = 0; n < 2; ++n) acc[ai][bj][m][n] = acc[ai][bj][m][n] * rs;
            }
    }
    __device__ __forceinline__ void operator()(const f32x4 (&acc)[2][2][4][2], const Unit& u, int wr, int wc, int fr, int fq) const {
#pragma unroll
        for (int ai = 0; ai < 2; ++ai)
#pragma unroll
            for (int m = 0; m < 4; ++m) {
                const int r = u.pm * BM + ai * HALF + wr * 64 + m * 16 + fr; float ssum = 0.f;
#pragma unroll
                for (int bj = 0; bj < 2; ++bj)
#pragma unroll
                    for (int n = 0; n < 2; ++n) {
                        const size_t off = (size_t)r * DM + u.pn * BM + bj * HALF + wc * 32 + n * 16 + 4 * fq;
                        const f32x4 y = *(const f32x4*)(x + off) + acc[ai][bj][m][n];
                        *(f32x4*)(x1 + off) = y;
                        u32x2 w; w.x = cvt_pk_bf16(y[0], y[1]); w.y = cvt_pk_bf16(y[2], y[3]); *(u32x2*)(x1b + off) = w;
                        ssum += (y[0] * y[0] + y[1] * y[1]) + (y[2] * y[2] + y[3] * y[3]);
                    }
                ssum += __shfl_xor(ssum, 16); ssum += __shfl_xor(ssum, 32);
                if (fq == 0) ss2[(size_t)r * 16 + u.pn * 4 + wc] = ssum;
            }
    }
};
struct EpiGU {
    static constexpr bool PERM = true, AFTER_DRAIN = false, MIDSCALE = false;
    bf16_t* h; const float* ss2; int mid_t;
    __device__ __forceinline__ void midscale(f32x4 (&)[2][2][4][2], const Unit&, int, int) const {}
    __device__ __forceinline__ void operator()(const f32x4 (&acc)[2][2][4][2], const Unit& u, int wr, int wc, int fr, int fq) const {
#pragma unroll
        for (int ai = 0; ai < 2; ++ai)
#pragma unroll
            for (int m = 0; m < 4; ++m) {
                const int r = u.pm * BM + ai * HALF + wr * 64 + m * 16 + fr;
                const f32x4* sp = (const f32x4*)(ss2 + (size_t)r * 16); const f32x4 a = sp[0], b = sp[1], c = sp[2], d = sp[3];
                const f32x4 t = (a + b) + (c + d); const float s = (t[0] + t[1]) + (t[2] + t[3]);
                const float rs = __builtin_amdgcn_rsqf(s * (1.0f / 1024.0f) + RMS_EPS);
                const f32x4 g0 = acc[ai][0][m][0] * rs, g1 = acc[ai][0][m][1] * rs, u0 = acc[ai][1][m][0] * rs, u1 = acc[ai][1][m][1] * rs;
                float o[8];
#pragma unroll
                for (int j = 0; j < 4; ++j) { o[j] = fast_silu(g0[j]) * u0[j]; o[4 + j] = fast_silu(g1[j]) * u1[j]; }
                u32x4 w; w.x = cvt_pk_bf16(o[0], o[1]); w.y = cvt_pk_bf16(o[2], o[3]); w.z = cvt_pk_bf16(o[4], o[5]); w.w = cvt_pk_bf16(o[6], o[7]);
                *(u32x4*)(h + (size_t)r * DFF + u.pn * 128 + wc * 32 + 8 * fq) = w;
            }
    }
};
struct EpiDown {
    static constexpr bool PERM = false, AFTER_DRAIN = false, MIDSCALE = false;
    float* x1; float* ss3; int mid_t;
    __device__ __forceinline__ void midscale(f32x4 (&)[2][2][4][2], const Unit&, int, int) const {}
    __device__ __forceinline__ void operator()(const f32x4 (&acc)[2][2][4][2], const Unit& u, int wr, int wc, int fr, int fq) const {
#pragma unroll
        for (int ai = 0; ai < 2; ++ai)
#pragma unroll
            for (int m = 0; m < 4; ++m) {
                const int r = u.pm * BM + ai * HALF + wr * 64 + m * 16 + fr; float ssum = 0.f;
#pragma unroll
                for (int bj = 0; bj < 2; ++bj)
#pragma unroll
                    for (int n = 0; n < 2; ++n) {
                        const size_t off = (size_t)r * DM + u.pn * BM + bj * HALF + wc * 32 + n * 16 + 4 * fq;
                        const f32x4 y = *(const f32x4*)(x1 + off) + acc[ai][bj][m][n];
                        *(f32x4*)(x1 + off) = y;
                        ssum += (y[0] * y[0] + y[1] * y[1]) + (y[2] * y[2] + y[3] * y[3]);
                    }
                ssum += __shfl_xor(ssum, 16); ssum += __shfl_xor(ssum, 32);
                if (fq == 0) ss3[(size_t)r * 16 + u.pn * 4 + wc] = ssum;
            }
    }
};
template <class Epi, class Sched, bool ALIGN_EPI = false, bool SP2 = false>
__device__ __forceinline__ void gemm_phase(PG8_LAS unsigned char* lds, const Gemm g, const Sched& S, const Epi& E) {
    const int tid = threadIdx.x, wid = __builtin_amdgcn_readfirstlane(tid >> 6), lane = tid & 63, wr = wid >> 2, wc = wid & 3, fr = lane & 15, fq = lane >> 4;
    const int K = g.K, nt = K / BK;
    unsigned voffA[2], voffB[2];
#pragma unroll
    for (int i = 0; i < 2; ++i) { int R, C; stage_rc(tid * 16 + i * 8192, R, C); const int Rb = Epi::PERM ? ((R & ~31) + perm32(R & 31)) : R;
        voffA[i] = (unsigned)(R * K + C) * 2u; voffB[i] = (unsigned)(Rb * K + C) * 2u; }
    const size_t kstep = (size_t)(BK * 2);
    const size_t hstep = (size_t)HALF * K * 2;
    const size_t tstep = 2 * hstep;
    const unsigned ldsw = (unsigned)wid * 1024u;
    const int aoff = lds_byte(wr * 64 + fr, fq * 8), boff = lds_byte(wc * 32 + fr, fq * 8);
#define PG8_SA(b, h) (((b) * 2 + (h)) * HTB)
#define PG8_SB(b, h) ((4 + (b) * 2 + (h)) * HTB)
#define PG8_STAGE(bufoff, gbase, voff) do { _Pragma("unroll") for (int _i = 0; _i < 2; ++_i) \
        __builtin_amdgcn_global_load_lds((const unsigned*)((const char*)(gbase) + (voff)[_i]), (PG8_LAS unsigned*)(lds + (bufoff) + ldsw + _i * 8192), 16, 0, 0); } while (0)
#define PG8_LDA(dst, b, h) do { _Pragma("unroll") for (int m = 0; m < 4; ++m) _Pragma("unroll") for (int k = 0; k < 2; ++k) dst[m][k] = *(const PG8_LAS bf16x8*)(lds + PG8_SA(b, h) + aoff + m * 2048 + k * 1024); } while (0)
#define PG8_LDB(dst, b, h) do { _Pragma("unroll") for (int n = 0; n < 2; ++n) _Pragma("unroll") for (int k = 0; k < 2; ++k) dst[n][k] = *(const PG8_LAS bf16x8*)(lds + PG8_SB(b, h) + boff + n * 2048 + k * 1024); } while (0)
#define PG8_MMA(ai, bj, At, Bt) do { __builtin_amdgcn_s_setprio(1); _Pragma("unroll") for (int m = 0; m < 4; ++m) _Pragma("unroll") for (int n = 0; n < 2; ++n) _Pragma("unroll") for (int k = 0; k < 2; ++k) \
        acc[ai][bj][m][n] = __builtin_amdgcn_mfma_f32_16x16x32_bf16(Bt[n][k], At[m][k], acc[ai][bj][m][n], 0, 0, 0); __builtin_amdgcn_s_setprio(0); } while (0)
#define PG8_WAIT_V(n) asm volatile("s_waitcnt vmcnt(" #n ")" ::: "memory")
#define PG8_WAIT_L(n) asm volatile("s_waitcnt lgkmcnt(" #n ")" ::: "memory")
#define PG8_BAR __builtin_amdgcn_s_barrier()
#define PG8_SCHED __builtin_amdgcn_sched_barrier(0)
    Unit cur, nxt; int ui = 0;
    if (!S.next(0, cur)) return;
    f32x4 acc[2][2][4][2];
#pragma unroll
    for (int a = 0; a < 2; ++a)
#pragma unroll
        for (int b = 0; b < 2; ++b)
#pragma unroll
            for (int m = 0; m < 4; ++m)
#pragma unroll
                for (int n = 0; n < 2; ++n) acc[a][b][m][n] = (f32x4){0.f, 0.f, 0.f, 0.f};
    bf16x8 At[4][2], B0[2][2], B1[2][2];
    const char* cA = (const char*)g.A + (size_t)cur.pm * tstep; const char* cB = (const char*)g.Bt + (size_t)cur.pn * tstep;
    S.a_ready(cur);
    if constexpr (SP2) {
        PG8_STAGE(PG8_SB(0, 0), cB, voffB); PG8_STAGE(PG8_SB(0, 1), cB + hstep, voffB); PG8_STAGE(PG8_SA(0, 0), cA, voffA); PG8_STAGE(PG8_SA(0, 1), cA + hstep, voffA);
        if (wr == 1) PG8_BAR;
        PG8_WAIT_V(2); PG8_BAR;
        PG8_STAGE(PG8_SB(1, 0), cB + kstep, voffB); PG8_STAGE(PG8_SA(1, 0), cA + kstep, voffA); PG8_STAGE(PG8_SB(1, 1), cB + hstep + kstep, voffB);
        PG8_WAIT_V(6); PG8_BAR;
    } else {
        PG8_STAGE(PG8_SB(0, 0), cB, voffB); PG8_STAGE(PG8_SA(0, 0), cA, voffA); PG8_STAGE(PG8_SB(0, 1), cB + hstep, voffB); PG8_STAGE(PG8_SA(0, 1), cA + hstep, voffA);
        if (wr == 1) PG8_BAR;
        PG8_WAIT_V(4); PG8_BAR;
        PG8_STAGE(PG8_SB(1, 0), cB + kstep, voffB); PG8_STAGE(PG8_SA(1, 0), cA + kstep, voffA); PG8_STAGE(PG8_SB(1, 1), cB + hstep + kstep, voffB);
        PG8_WAIT_V(6); PG8_BAR;
    }
    for (;;) {
        const bool has_next = S.next(ui + 1, nxt);
        const char* nA = has_next ? (const char*)g.A + (size_t)nxt.pm * tstep : cA; const char* nB = has_next ? (const char*)g.Bt + (size_t)nxt.pn * tstep : cB;
        for (int t = 0; t < nt; t += 2) {
            const bool last = (t == nt - 2);
            if constexpr (Epi::MIDSCALE) { if (t == E.mid_t) E.midscale(acc, cur, wr, fr); }
            const char* a1 = cA + (size_t)(t + 1) * kstep;
            const char* a2 = last ? nA : cA + (size_t)(t + 2) * kstep; const char* b2 = last ? nB : cB + (size_t)(t + 2) * kstep;
            const char* a3 = a2 + kstep; const char* b3 = b2 + kstep;
            if (last && has_next) S.a_ready(nxt);
            if constexpr (SP2) {
            PG8_LDB(B0, 0, 0); PG8_LDB(B1, 0, 1); PG8_SCHED; PG8_LDA(At, 0, 0); PG8_STAGE(PG8_SA(1, 1), a1 + hstep, voffA);
            PG8_WAIT_V(8); PG8_WAIT_L(0); PG8_BAR; PG8_MMA(0, 0, At, B0); PG8_MMA(0, 1, At, B1); PG8_BAR; PG8_SCHED;
            PG8_LDA(At, 0, 1); PG8_STAGE(PG8_SB(0, 0), b2, voffB); PG8_STAGE(PG8_SB(0, 1), b2 + hstep, voffB); PG8_STAGE(PG8_SA(0, 0), a2, voffA);
            PG8_WAIT_V(8); PG8_WAIT_L(0); PG8_BAR; PG8_MMA(1, 0, At, B0); PG8_MMA(1, 1, At, B1); PG8_BAR; PG8_SCHED;
            PG8_LDB(B0, 1, 0); PG8_LDB(B1, 1, 1); PG8_SCHED; PG8_LDA(At, 1, 0); PG8_STAGE(PG8_SA(0, 1), a2 + hstep, voffA);
            PG8_WAIT_V(8); PG8_WAIT_L(0); PG8_BAR; PG8_MMA(0, 0, At, B0); PG8_MMA(0, 1, At, B1); PG8_BAR; PG8_SCHED;
            PG8_LDA(At, 1, 1); PG8_STAGE(PG8_SB(1, 0), b3, voffB); PG8_STAGE(PG8_SB(1, 1), b3 + hstep, voffB); PG8_STAGE(PG8_SA(1, 0), a3, voffA);
            PG8_WAIT_V(8); PG8_WAIT_L(0); PG8_BAR; PG8_MMA(1, 0, At, B0); PG8_MMA(1, 1, At, B1); PG8_BAR; PG8_SCHED;
            } else {
            PG8_LDB(B0, 0, 0); PG8_SCHED; PG8_LDA(At, 0, 0); PG8_STAGE(PG8_SA(1, 1), a1 + hstep, voffA);
            PG8_WAIT_L(8); PG8_BAR; PG8_WAIT_L(0); PG8_MMA(0, 0, At, B0); PG8_BAR; PG8_SCHED;
            PG8_LDB(B1, 0, 1); PG8_STAGE(PG8_SB(0, 0), b2, voffB);
            PG8_BAR; PG8_WAIT_L(0); PG8_MMA(0, 1, At, B1); PG8_BAR;
            PG8_LDA(At, 0, 1); PG8_STAGE(PG8_SA(0, 0), a2, voffA);
            PG8_BAR; PG8_WAIT_L(0); PG8_MMA(1, 0, At, B0); PG8_BAR; PG8_SCHED;
            PG8_STAGE(PG8_SB(0, 1), b2 + hstep, voffB);
            PG8_WAIT_V(6); PG8_BAR; PG8_MMA(1, 1, At, B1); PG8_BAR;
            PG8_LDB(B0, 1, 0); PG8_SCHED; PG8_LDA(At, 1, 0); PG8_STAGE(PG8_SA(0, 1), a2 + hstep, voffA);
            PG8_WAIT_L(8); PG8_BAR; PG8_WAIT_L(0); PG8_MMA(0, 0, At, B0); PG8_BAR; PG8_SCHED;
            PG8_LDB(B1, 1, 1); PG8_STAGE(PG8_SB(1, 0), b3, voffB);
            PG8_BAR; PG8_WAIT_L(0); PG8_MMA(0, 1, At, B1); PG8_BAR;
            PG8_LDA(At, 1, 1); PG8_STAGE(PG8_SA(1, 0), a3, voffA);
            PG8_BAR; PG8_WAIT_L(0); PG8_MMA(1, 0, At, B0); PG8_BAR; PG8_SCHED;
            PG8_STAGE(PG8_SB(1, 1), b3 + hstep, voffB);
            PG8_WAIT_V(6); PG8_BAR; PG8_MMA(1, 1, At, B1); PG8_BAR;
            }
        }
        if constexpr (ALIGN_EPI) { if (wr == 0) PG8_BAR; }
        if constexpr (!Epi::AFTER_DRAIN) { E(acc, cur, wr, wc, fr, fq); S.done(cur); }
        if (!has_next) break;
#pragma unroll
        for (int a = 0; a < 2; ++a)
#pragma unroll
            for (int b = 0; b < 2; ++b)
#pragma unroll
                for (int m = 0; m < 4; ++m)
#pragma unroll
                    for (int n = 0; n < 2; ++n) acc[a][b][m][n] = (f32x4){0.f, 0.f, 0.f, 0.f};
        cur = nxt; cA = nA; cB = nB; ++ui;
        if constexpr (ALIGN_EPI) { if (wr == 1) PG8_BAR; }
    }
    PG8_WAIT_V(0);
    if constexpr (!ALIGN_EPI) { if (wr == 0) PG8_BAR; }
    PG8_BAR;
    if constexpr (Epi::AFTER_DRAIN) { E.fused(acc, cur, wr, wc, fr, fq, lds, wid, lane); S.done(cur); }
#undef PG8_SA
#undef PG8_SB
#undef PG8_STAGE
#undef PG8_LDA
#undef PG8_LDB
#undef PG8_MMA
#undef PG8_WAIT_V
#undef PG8_WAIT_L
#undef PG8_BAR
#undef PG8_SCHED
}
}

#ifndef PG8_SP2
#define PG8_SP2 true
#endif

#define LAS __attribute__((address_space(3)))
#define XB_TMO      128
#define XB_XCNT(j)  (256  + 64 * (j))
#define XB_XSUB(j)  (1280 + 64 * (j))
#define XB_XGEN(j)  (2304 + 64 * (j))
#define XB_TOP      3328
#define XB_TOPGEN   3392
#define XCD_BAR_WORDS 3456
#define XB_SPIN_CAP (1u << 18)

__device__ __forceinline__ unsigned xb_ld(unsigned* p)              { return __hip_atomic_load(p, __ATOMIC_RELAXED, __HIP_MEMORY_SCOPE_AGENT); }
__device__ __forceinline__ unsigned xb_add(unsigned* p, unsigned v) { return __hip_atomic_fetch_add(p, v, __ATOMIC_RELAXED, __HIP_MEMORY_SCOPE_AGENT); }
__device__ __forceinline__ unsigned xb_xcc_id() { return (unsigned)__builtin_amdgcn_s_getreg((3 << 11) | 20) & 0xFu; }
#define XB_SPIN(cond, bar) do { unsigned _sp = 0; while (cond) { __builtin_amdgcn_s_sleep(1); \
    if ((++_sp & 255u) == 0u) { if (xb_ld(&(bar)[XB_TMO])) break; if (_sp > XB_SPIN_CAP) { atomicAdd(&(bar)[XB_TMO], 1u); break; } } } } while (0)

struct XcdBarrier {
    unsigned* bar; unsigned x;
    volatile LAS unsigned* st;
};

__device__ __forceinline__ XcdBarrier xcd_barrier_post(unsigned* bar, volatile LAS unsigned* st) {
    XcdBarrier b; b.bar = bar; b.x = xb_xcc_id(); b.st = st;
    if (threadIdx.x == 0) (void)xb_add(&bar[XB_XCNT(b.x)], 1u);
    return b;
}
__device__ __forceinline__ void xcd_barrier_complete(unsigned* bar, unsigned x, unsigned& nloc, unsigned& nx) {
    const unsigned G = gridDim.x * gridDim.y * gridDim.z;
    unsigned sum, cnt, mine, sp = 0u;
    for (;;) {
        sum = 0u; cnt = 0u; mine = 0u;
#pragma unroll
        for (unsigned j = 0; j < 16; ++j) { const unsigned c = xb_ld(&bar[XB_XCNT(j)]); sum += c; cnt += (c > 0u) ? 1u : 0u; mine = (j == x) ? c : mine; }
        if (sum == G) break;
        __builtin_amdgcn_s_sleep(1);
        if ((++sp & 255u) == 0u) { if (xb_ld(&bar[XB_TMO])) break; if (sp > XB_SPIN_CAP) { atomicAdd(&bar[XB_TMO], 1u); break; } }
    }
    nloc = mine > 0u ? mine : 1u; nx = cnt > 0u ? cnt : 1u;
}

__device__ __forceinline__ void xcd_barrier(const XcdBarrier& b) {
    asm volatile("s_waitcnt vmcnt(0)" ::: "memory");
    __syncthreads();
    if (threadIdx.x == 0) {
        unsigned* bar = b.bar;
        __builtin_amdgcn_s_waitcnt(0);
        unsigned nloc = b.st[0], nx = b.st[1];
        if (nloc == 0u) { xcd_barrier_complete(bar, b.x, nloc, nx); b.st[0] = nloc; b.st[1] = nx; }
        const unsigned old = xb_add(&bar[XB_XSUB(b.x)], 1u);
        const unsigned gen = old / nloc;
        if (old + 1u == (gen + 1u) * nloc) {
            __builtin_amdgcn_fence(__ATOMIC_RELEASE, "agent");
            asm volatile("s_waitcnt vmcnt(0)" ::: "memory");
            const unsigned og = xb_add(&bar[XB_TOP], 1u);
            const unsigned tg = og / nx;
            if (og + 1u == (tg + 1u) * nx) xb_add(&bar[XB_TOPGEN], 1u);
            else XB_SPIN(xb_ld(&bar[XB_TOPGEN]) == tg, bar);
            __builtin_amdgcn_fence(__ATOMIC_ACQUIRE, "agent");
            xb_add(&bar[XB_XGEN(b.x)], 1u);
            asm volatile("s_waitcnt vmcnt(0)" ::: "memory");
        } else {
            XB_SPIN(xb_ld(&bar[XB_XGEN(b.x)]) == gen, bar);
            __builtin_amdgcn_fence(__ATOMIC_ACQUIRE, "agent");
            asm volatile("s_waitcnt vmcnt(0)" ::: "memory");
        }
    }
    __syncthreads();
}

struct Args {
    const float* x; const int* positions; const float* norm1_g; const float* w_in; const float* cmp_pos; const float* cmp_w1; const float* cmp_w2;
    const float* nsa_norm_g; const float* conv_w; const float* a_log; const float* dt_bias; const float* gdn_norm_g; const float* w_out; const float* norm2_g;
    const float* w_gate; const float* w_up; const float* w_down; const float* final_g;
    float* out; unsigned char* ws; int ph_lo, ph_hi;
};

#ifndef LAS
#define LAS __attribute__((address_space(3)))
#endif
namespace nsa {
typedef float f32x16 __attribute__((ext_vector_type(16)));
typedef float f32x4 __attribute__((ext_vector_type(4)));
typedef float f32x2 __attribute__((ext_vector_type(2)));
typedef __bf16 bf16x2_t __attribute__((ext_vector_type(2)));
typedef short bf16x8 __attribute__((ext_vector_type(8)));
typedef short s16x4 __attribute__((ext_vector_type(4)));
typedef unsigned u32x4 __attribute__((ext_vector_type(4)));
typedef unsigned u32x2 __attribute__((ext_vector_type(2)));

constexpr int L_KV = 0, KV_STAGE = 16384;
constexpr int L_IMP = 32768;
constexpr int L_SELM = 65536;
constexpr int L_UNION = 65536 + 256;
constexpr int L_QUEUE = 65536 + 260;
constexpr int L_RED = 0;
constexpr int L_HT = 65536 + 512;
constexpr float NEG_INF = -__builtin_inff();

__device__ __forceinline__ int crow(int r, int hi) { return (r & 3) + 8 * (r >> 2) + 4 * hi; }
__device__ __forceinline__ unsigned cvtpk(float lo, float hi) { f32x2 v = {lo, hi}; bf16x2_t b = __builtin_convertvector(v, bf16x2_t); return __builtin_bit_cast(unsigned, b); }
__device__ __forceinline__ bf16x8 pack8(float a0, float a1, float a2, float a3, float a4, float a5, float a6, float a7) {
    u32x4 w; w.x = cvtpk(a0, a1); w.y = cvtpk(a2, a3); w.z = cvtpk(a4, a5); w.w = cvtpk(a6, a7); return __builtin_bit_cast(bf16x8, w); }
__device__ __forceinline__ void dma_tile(const unsigned char* gbase, size_t pitch, LAS unsigned char* dst, int wave, int lane) {
    const int row = wave * 8 + (lane >> 3); const int c = (lane & 7) ^ (lane >> 3);
    __builtin_amdgcn_global_load_lds((const unsigned*)(gbase + (size_t)row * pitch + c * 16), (LAS unsigned*)(dst + wave * 1024), 16, 0, 0);
}
typedef short v4i16_t __attribute__((ext_vector_type(4)));
__device__ __forceinline__ s16x4 vtr(LAS const unsigned char* p) { return __builtin_bit_cast(s16x4, __builtin_amdgcn_ds_read_tr16_b64_v4i16((LAS v4i16_t*)p)); }

__device__ __forceinline__ void qk_tile(f32x16& p0, f32x16& p1, LAS const unsigned char* kbuf, const bf16x8 (&qr)[4], int r32, int hi) {
    p0 = (f32x16){}; p1 = (f32x16){};
    LAS const unsigned char* k0 = kbuf + r32 * 128; const int sw = r32 & 7;
#pragma unroll
    for (int ds = 0; ds < 4; ++ds) {
        const int off = ((2 * ds + hi) ^ sw) << 4;
        const bf16x8 a0 = *(LAS const bf16x8*)(k0 + off), a1 = *(LAS const bf16x8*)(k0 + 4096 + off);
        p0 = __builtin_amdgcn_mfma_f32_32x32x16_bf16(a0, qr[ds], p0, 0, 0, 0);
        p1 = __builtin_amdgcn_mfma_f32_32x32x16_bf16(a1, qr[ds], p1, 0, 0, 0);
    }
}
__device__ __forceinline__ void pv_tile(f32x16 (&o)[2], LAS const unsigned char* vb0, LAS const unsigned char* vb1, const bf16x8 (&pb)[4]) {
#pragma unroll
    for (int ks = 0; ks < 4; ++ks) {
        { const s16x4 lo = vtr(vb0 + ks * 2048), hh = vtr(vb0 + ks * 2048 + 1024);
          const bf16x8 a = {lo[0], lo[1], lo[2], lo[3], hh[0], hh[1], hh[2], hh[3]};
          o[0] = __builtin_amdgcn_mfma_f32_32x32x16_bf16(a, pb[ks], o[0], 0, 0, 0); }
        { const s16x4 lo = vtr(vb1 + ks * 2048), hh = vtr(vb1 + ks * 2048 + 1024);
          const bf16x8 a = {lo[0], lo[1], lo[2], lo[3], hh[0], hh[1], hh[2], hh[3]};
          o[1] = __builtin_amdgcn_mfma_f32_32x32x16_bf16(a, pb[ks], o[1], 0, 0, 0); }
    }
}
__device__ __forceinline__ float max16(const f32x16& p) {
    float a = fmaxf(fmaxf(p[0], p[1]), fmaxf(p[2], p[3])), b = fmaxf(fmaxf(p[4], p[5]), fmaxf(p[6], p[7]));
    float c = fmaxf(fmaxf(p[8], p[9]), fmaxf(p[10], p[11])), d = fmaxf(fmaxf(p[12], p[13]), fmaxf(p[14], p[15]));
    return fmaxf(fmaxf(a, b), fmaxf(c, d));
}
__device__ __forceinline__ float sum16(const f32x16& p) {
    return (((p[0] + p[1]) + (p[2] + p[3])) + ((p[4] + p[5]) + (p[6] + p[7]))) + (((p[8] + p[9]) + (p[10] + p[11])) + ((p[12] + p[13]) + (p[14] + p[15])));
}
__device__ __forceinline__ void mask_tile(f32x16& p0, f32x16& p1, int key0, int hi, int lo, int hi_) {
#pragma unroll
    for (int r = 0; r < 16; ++r) { const int k = key0 + crow(r, hi);
        p0[r] = (k >= lo && k <= hi_) ? p0[r] : NEG_INF; p1[r] = (k + 32 >= lo && k + 32 <= hi_) ? p1[r] : NEG_INF; }
}
__device__ __forceinline__ void attn_tile(LAS const unsigned char* kbuf, LAS const unsigned char* vb0, LAS const unsigned char* vb1, const bf16x8 (&qr)[4],
                                          f32x16 (&o)[2], float& m, float& l, int key0, int lo, int hi_, bool domask, int r32, int hi) {
    f32x16 p0, p1; qk_tile(p0, p1, kbuf, qr, r32, hi);
    if (domask) mask_tile(p0, p1, key0, hi, lo, hi_);
    float mx = fmaxf(max16(p0), max16(p1)); mx = fmaxf(mx, __shfl_xor(mx, 32));
    const float mn = fmaxf(m, mx); const float alpha = __builtin_amdgcn_exp2f(m - mn); m = mn;
#pragma unroll
    for (int r = 0; r < 16; ++r) { p0[r] = __builtin_amdgcn_exp2f(p0[r] - mn); p1[r] = __builtin_amdgcn_exp2f(p1[r] - mn); }
    l = l * alpha + (sum16(p0) + sum16(p1));
    o[0] = o[0] * alpha; o[1] = o[1] * alpha;
    bf16x8 pb[4];
    pb[0] = pack8(p0[0], p0[1], p0[2], p0[3], p0[4], p0[5], p0[6], p0[7]); pb[1] = pack8(p0[8], p0[9], p0[10], p0[11], p0[12], p0[13], p0[14], p0[15]);
    pb[2] = pack8(p1[0], p1[1], p1[2], p1[3], p1[4], p1[5], p1[6], p1[7]); pb[3] = pack8(p1[8], p1[9], p1[10], p1[11], p1[12], p1[13], p1[14], p1[15]);
    pv_tile(o, vb0, vb1, pb);
}

__device__ __forceinline__ void attn_unit(unsigned char* ws, LAS unsigned char* lds, int b, int g, int qb, int wave, int lane) {
    const int tid = threadIdx.x, r32 = lane & 31, hi = lane >> 5, hh = wave >> 1, th = wave & 1, head = g * 4 + hh;
    const int tl = 32 * th + r32, t = 64 * qb + tl; const size_t m = (size_t)b * SEQ + t;
    const bf16_t* proj = (const bf16_t*)(ws + WS_PROJ);
    const unsigned char* pb_ = (const unsigned char*)(proj + (size_t)b * SEQ * PJ);
    LAS unsigned char* kv = lds + L_KV;
    LAS float* IMP = (LAS float*)(lds + L_IMP); LAS unsigned* SELM = (LAS unsigned*)(lds + L_SELM); LAS unsigned* UNI = (LAS unsigned*)(lds + L_UNION);
    const int gq = (lane & 15) >> 2, gp = lane & 3, x7 = 4 * hi + gq, clow = 2 * ((lane >> 4) & 1) + (gp >> 1);
    const int vo0 = x7 * 128 + (((0 + clow) ^ x7) << 4) + (gp & 1) * 8, vo1 = x7 * 128 + (((4 + clow) ^ x7) << 4) + (gp & 1) * 8;
    bf16x8 qr[4];
    { const bf16_t* qp = proj + m * PJ + PC_Q + head * 64 + 8 * hi;
#pragma unroll
      for (int ds = 0; ds < 4; ++ds) qr[ds] = *(const bf16x8*)(qp + 16 * ds); }
    const bf16_t* gp_ = proj + m * PJ + PC_GATE + head * 3;
    const float g_cmp = sigmf(bf2f(gp_[0])), g_slc = sigmf(bf2f(gp_[1])), g_win = sigmf(bf2f(gp_[2]));
    f32x16 outa[2]; outa[0] = (f32x16){}; outa[1] = (f32x16){};
    if (tid == 0) *UNI = 0u;
    {
        const bool two = qb >= 16;
        const unsigned char* kcb = ws + WS_KC + (size_t)(b * 2 + g) * 128 * 128; const unsigned char* vcb = ws + WS_VC + (size_t)(b * 2 + g) * 128 * 128;
        dma_tile(kcb, 128, kv, wave, lane); dma_tile(vcb, 128, kv + 8192, wave, lane);
        if (two) { dma_tile(kcb + 64 * 128, 128, kv + KV_STAGE, wave, lane); dma_tile(vcb + 64 * 128, 128, kv + KV_STAGE + 8192, wave, lane); }
        asm volatile("s_waitcnt vmcnt(0)" ::: "memory"); __syncthreads();
        f32x16 c00, c01, c10, c11;
        qk_tile(c00, c01, kv, qr, r32, hi);
        const int nmax = t >= 31 ? (((t - 31) >> 4) < 126 ? ((t - 31) >> 4) : 126) : -1;
        mask_tile(c00, c01, 0, hi, 0, nmax);
        if (two) { qk_tile(c10, c11, kv + KV_STAGE, qr, r32, hi); mask_tile(c10, c11, 64, hi, 0, nmax); }
        else { c10 = (f32x16){}; c11 = (f32x16){};
#pragma unroll
            for (int r = 0; r < 16; ++r) { c10[r] = NEG_INF; c11[r] = NEG_INF; } }
        float mx = fmaxf(fmaxf(max16(c00), max16(c01)), fmaxf(max16(c10), max16(c11))); mx = fmaxf(mx, __shfl_xor(mx, 32));
        mx = fmaxf(mx, -1e30f);
#pragma unroll
        for (int r = 0; r < 16; ++r) { c00[r] = __builtin_amdgcn_exp2f(c00[r] - mx); c01[r] = __builtin_amdgcn_exp2f(c01[r] - mx);
            c10[r] = __builtin_amdgcn_exp2f(c10[r] - mx); c11[r] = __builtin_amdgcn_exp2f(c11[r] - mx); }
        float ls = (sum16(c00) + sum16(c01)) + (sum16(c10) + sum16(c11)); ls += __shfl_xor(ls, 32);
        const float inv = ls > 0.f ? 1.0f / ls : 0.f;
        c00 = c00 * inv; c01 = c01 * inv; c10 = c10 * inv; c11 = c11 * inv;
        float Gv[16], Ev[16];
#pragma unroll
        for (int a = 0; a < 4; ++a) {
            Gv[a] = (c00[4 * a] + c00[4 * a + 1]) + (c00[4 * a + 2] + c00[4 * a + 3]); Ev[a] = c00[4 * a + 3];
            Gv[4 + a] = (c01[4 * a] + c01[4 * a + 1]) + (c01[4 * a + 2] + c01[4 * a + 3]); Ev[4 + a] = c01[4 * a + 3];
            Gv[8 + a] = (c10[4 * a] + c10[4 * a + 1]) + (c10[4 * a + 2] + c10[4 * a + 3]); Ev[8 + a] = c10[4 * a + 3];
            Gv[12 + a] = (c11[4 * a] + c11[4 * a + 1]) + (c11[4 * a + 2] + c11[4 * a + 3]); Ev[12 + a] = c11[4 * a + 3];
        }
        LAS float* ip = IMP + ((hh * 64 + tl) * 32) + hi;
#pragma unroll
        for (int a = 0; a < 16; ++a) {
            const float eprev = a > 0 ? Ev[a > 0 ? a - 1 : 0] : 0.f;
            const float send = hi ? eprev : Ev[a];
            const float recv = __shfl_xor(send, 32);
            ip[2 * a] = Gv[a] + recv;
        }
        f32x16 oc[2]; oc[0] = (f32x16){}; oc[1] = (f32x16){};
        { bf16x8 pb[4];
          pb[0] = pack8(c00[0], c00[1], c00[2], c00[3], c00[4], c00[5], c00[6], c00[7]); pb[1] = pack8(c00[8], c00[9], c00[10], c00[11], c00[12], c00[13], c00[14], c00[15]);
          pb[2] = pack8(c01[0], c01[1], c01[2], c01[3], c01[4], c01[5], c01[6], c01[7]); pb[3] = pack8(c01[8], c01[9], c01[10], c01[11], c01[12], c01[13], c01[14], c01[15]);
          pv_tile(oc, kv + 8192 + vo0, kv + 8192 + vo1, pb); }
        if (two) { bf16x8 pb[4];
          pb[0] = pack8(c10[0], c10[1], c10[2], c10[3], c10[4], c10[5], c10[6], c10[7]); pb[1] = pack8(c10[8], c10[9], c10[10], c10[11], c10[12], c10[13], c10[14], c10[15]);
          pb[2] = pack8(c11[0], c11[1], c11[2], c11[3], c11[4], c11[5], c11[6], c11[7]); pb[3] = pack8(c11[8], c11[9], c11[10], c11[11], c11[12], c11[13], c11[14], c11[15]);
          pv_tile(oc, kv + KV_STAGE + 8192 + vo0, kv + KV_STAGE + 8192 + vo1, pb); }
        outa[0] = oc[0] * g_cmp; outa[1] = oc[1] * g_cmp;
    }
    __syncthreads();
    {
        const int tok = 8 * wave + (lane >> 3), sub = lane & 7;
        f32x4 v = *(LAS const f32x4*)(IMP + (0 * 64 + tok) * 32 + 4 * sub);
        v = v + *(LAS const f32x4*)(IMP + (1 * 64 + tok) * 32 + 4 * sub);
        v = v + *(LAS const f32x4*)(IMP + (2 * 64 + tok) * 32 + 4 * sub);
        v = v + *(LAS const f32x4*)(IMP + (3 * 64 + tok) * 32 + 4 * sub);
        float sc[4];
#pragma unroll
        for (int i = 0; i < 4; ++i) { const int s = 4 * sub + i; const bool forced = (s == 0) || (s == qb) || (s == qb - 1);
            sc[i] = forced ? 1e9f : (s <= qb ? v[i] : -1e30f); }
        unsigned taken = 0u, mask = 0u;
#pragma unroll 1
        for (int round = 0; round < TOPN; ++round) {
            float bv = -3e38f; int bi = 64;
#pragma unroll
            for (int i = 0; i < 4; ++i) { const bool ok = !((taken >> i) & 1u) && sc[i] > bv; bv = ok ? sc[i] : bv; bi = ok ? 4 * sub + i : bi; }
#pragma unroll
            for (int off = 1; off < 8; off <<= 1) { const float ov = __shfl_xor(bv, off); const int oi = __shfl_xor(bi, off);
                const bool take = (ov > bv) || (ov == bv && oi < bi); bv = take ? ov : bv; bi = take ? oi : bi; }
            mask |= 1u << bi; if ((bi >> 2) == sub) taken |= 1u << (bi & 3);
        }
        if (sub == 0) SELM[tok] = mask;
        unsigned um = mask; um |= __shfl_xor(um, 8); um |= __shfl_xor(um, 16); um |= __shfl_xor(um, 32);
        if (lane == 0) atomicOr((unsigned*)UNI, um);
    }
    __syncthreads();
    const unsigned mysel = SELM[tl]; const unsigned uni = *UNI;
    {
        const int wlo = qb > 8 ? qb - 8 : 0;
        unsigned wrem = ((2u << qb) - 1u) & ~((1u << wlo) - 1u);
        unsigned srem = uni & ((2u << qb) - 1u);
        const unsigned char* kwin = pb_ + (size_t)(PC_KWIN + g * 64) * 2; const unsigned char* vwin = pb_ + (size_t)(PC_VWIN + g * 64) * 2;
        const unsigned char* kslc = pb_ + (size_t)(PC_KSLC + g * 64) * 2; const unsigned char* vslc = pb_ + (size_t)(PC_VSLC + g * 64) * 2;
        const size_t pitch = (size_t)PJ * 2;
        int cb = 0, cj = 0;
        if (wrem) { cb = 1; cj = __builtin_ctz(wrem); wrem &= wrem - 1; } else if (srem) { cb = 2; cj = __builtin_ctz(srem); srem &= srem - 1; }
        int st = 0;
        if (cb) { dma_tile((cb == 1 ? kwin : kslc) + (size_t)cj * 64 * pitch, pitch, kv, wave, lane); dma_tile((cb == 1 ? vwin : vslc) + (size_t)cj * 64 * pitch, pitch, kv + 8192, wave, lane); }
        f32x16 o[2]; o[0] = (f32x16){}; o[1] = (f32x16){}; float mrun = -1e30f, lrun = 0.f; int prevb = cb;
        while (cb) {
            int nb_ = 0, nj = 0;
            if (wrem) { nb_ = 1; nj = __builtin_ctz(wrem); wrem &= wrem - 1; } else if (srem) { nb_ = 2; nj = __builtin_ctz(srem); srem &= srem - 1; }
            asm volatile("s_waitcnt vmcnt(0)" ::: "memory"); __syncthreads();
            if (nb_) { LAS unsigned char* d = kv + (st ^ 1) * KV_STAGE;
                dma_tile((nb_ == 1 ? kwin : kslc) + (size_t)nj * 64 * pitch, pitch, d, wave, lane); dma_tile((nb_ == 1 ? vwin : vslc) + (size_t)nj * 64 * pitch, pitch, d + 8192, wave, lane); }
            if (cb != prevb) {
                float lt = lrun + __shfl_xor(lrun, 32); const float f = g_win / lt;
                outa[0] = outa[0] + o[0] * f; outa[1] = outa[1] + o[1] * f;
                o[0] = (f32x16){}; o[1] = (f32x16){}; mrun = -1e30f; lrun = 0.f; prevb = cb;
            }
            LAS const unsigned char* kb = kv + st * KV_STAGE; LAS const unsigned char* vb = kb + 8192;
            {
                bool run = true, domask; int lo_, hi2 = t;
                if (cb == 1) { domask = !((cj >= qb - 7) && (cj <= qb - 1)); lo_ = t - (WIN - 1); }
                else { const bool sel = (mysel >> cj) & 1u; const unsigned long long bal = __ballot(sel);
                    run = bal != 0ull; domask = !((cj < qb) && (bal == ~0ull)); lo_ = sel ? 0 : (1 << 30); }
                if (run) attn_tile(kb, vb + vo0, vb + vo1, qr, o, mrun, lrun, 64 * cj, lo_, hi2, domask, r32, hi);
            }
            cb = nb_; cj = nj; st ^= 1;
        }
        { float lt = lrun + __shfl_xor(lrun, 32); const float f = (prevb == 1 ? g_win : g_slc) / lt;
          outa[0] = outa[0] + o[0] * f; outa[1] = outa[1] + o[1] * f; }
    }
    {
        bf16_t* mp = (bf16_t*)(ws + WS_MIX) + m * DM + head * 64; float ss = 0.f;
#pragma unroll
        for (int dt = 0; dt < 2; ++dt)
#pragma unroll
            for (int a = 0; a < 4; ++a) {
                const float y0 = outa[dt][4 * a], y1 = outa[dt][4 * a + 1], y2 = outa[dt][4 * a + 2], y3 = outa[dt][4 * a + 3];
                ss += (y0 * y0 + y1 * y1) + (y2 * y2 + y3 * y3);
                u32x2 w; w.x = cvtpk(y0, y1); w.y = cvtpk(y2, y3);
                *(u32x2*)(mp + 32 * dt + 8 * a + 4 * hi) = w;
            }
        ss += __shfl_xor(ss, 32);
        if (hi == 0) ((float*)(ws + WS_SSQN))[m * 8 + head] = ss;
    }
    __syncthreads();
}

__device__ __forceinline__ void compress_unit(unsigned char* ws, const float* cmp_pos, LAS unsigned char* lds, int unit, int wave, int lane) {
    const int nt = unit & 7, g = (unit >> 3) & 1, b = (unit >> 4) & 15, i = unit >> 8;
    const int c = lane & 15, q = lane >> 4, n = 16 * nt + c;
    const bf16_t* proj = (const bf16_t*)(ws + WS_PROJ); const bf16_t* w1t = (const bf16_t*)(ws + WS_W1T) + (size_t)i * 128 * 2048;
    const bf16_t* w2t = (const bf16_t*)(ws + WS_W2T) + (size_t)i * 64 * 128;
    f32x4 acc[8];
#pragma unroll
    for (int jt = 0; jt < 8; ++jt) acc[jt] = (f32x4){0.f, 0.f, 0.f, 0.f};
#pragma unroll 2
    for (int s = 0; s < 8; ++s) {
        const int ks = 8 * wave + s, l = ks >> 1, d0 = (ks & 1) * 32 + 8 * q;
        const u32x4 xv = *(const u32x4*)(proj + (size_t)(b * SEQ + 16 * n + l) * PJ + (i ? PC_VCMP : PC_KCMP) + g * 64 + d0);
        const f32x4 pA = *(const f32x4*)(cmp_pos + i * 2048 + l * 64 + d0), pB = *(const f32x4*)(cmp_pos + i * 2048 + l * 64 + d0 + 4);
        const bf16x8 bfrag = pack8(__uint_as_float(xv.x << 16) + pA[0], __uint_as_float(xv.x & 0xffff0000u) + pA[1], __uint_as_float(xv.y << 16) + pA[2], __uint_as_float(xv.y & 0xffff0000u) + pA[3],
                                   __uint_as_float(xv.z << 16) + pB[0], __uint_as_float(xv.z & 0xffff0000u) + pB[1], __uint_as_float(xv.w << 16) + pB[2], __uint_as_float(xv.w & 0xffff0000u) + pB[3]);
#pragma unroll
        for (int jt = 0; jt < 8; ++jt) { const bf16x8 af = *(const bf16x8*)(w1t + (size_t)(16 * jt + c) * 2048 + 32 * ks + 8 * q);
            acc[jt] = __builtin_amdgcn_mfma_f32_16x16x32_bf16(af, bfrag, acc[jt], 0, 0, 0); }
    }
    LAS f32x4* RED = (LAS f32x4*)(lds + L_RED);
#pragma unroll
    for (int jt = 0; jt < 8; ++jt) RED[(wave * 8 + jt) * 64 + lane] = acc[jt];
    __syncthreads();
    f32x4 h = RED[(0 * 8 + wave) * 64 + lane];
#pragma unroll
    for (int w2 = 1; w2 < 8; ++w2) h = h + RED[(w2 * 8 + wave) * 64 + lane];
    LAS unsigned char* HT = lds + L_HT;
    { u32x2 w; w.x = cvtpk(siluf(h[0]), siluf(h[1])); w.y = cvtpk(siluf(h[2]), siluf(h[3])); *(LAS u32x2*)(HT + c * 256 + (16 * wave + 4 * q) * 2) = w; }
    __syncthreads();
    if (wave < 4) {
        f32x4 o2 = {0.f, 0.f, 0.f, 0.f};
#pragma unroll
        for (int s = 0; s < 4; ++s) { const bf16x8 bf = *(LAS const bf16x8*)(HT + c * 256 + (32 * s + 8 * q) * 2);
            const bf16x8 af = *(const bf16x8*)(w2t + (size_t)(16 * wave + c) * 128 + 32 * s + 8 * q);
            o2 = __builtin_amdgcn_mfma_f32_16x16x32_bf16(af, bf, o2, 0, 0, 0); }
        bf16_t* outp = (bf16_t*)(ws + (i ? WS_VC : WS_KC)) + ((size_t)(b * 2 + g) * 128 + n) * 64 + 16 * wave + 4 * q;
        u32x2 w; w.x = cvtpk(o2[0], o2[1]); w.y = cvtpk(o2[2], o2[3]); if (n == 127) { w.x = 0u; w.y = 0u; }
        *(u32x2*)outp = w;
    }
    __syncthreads();
}
}

namespace gdn {
typedef float f32x4 __attribute__((ext_vector_type(4)));
typedef short bf16x8 __attribute__((ext_vector_type(8)));
typedef unsigned u32x4 __attribute__((ext_vector_type(4)));
typedef unsigned u32x2 __attribute__((ext_vector_type(2)));
using nsa::cvtpk; using nsa::pack8;

constexpr int REC_W = 0, REC_QG = 16384, REC_KD = 32768, REC_QK = 49152, REC_BYTES = 57344;
constexpr int UREC_BYTES = 32768;
constexpr int NCHUNK = SEQ / 64;
constexpr int P_KR = 0, P_QR = 16384, P_AT = 32768, P_QKI = 49152, P_SC = 57344, P_HALF = 61440;
constexpr int SC_BETA = 0, SC_GC = 64, SC_EGC = 128, SC_EKD = 192, SC_RK2 = 256, SC_RQ2 = 320;
constexpr int S_BUF = 0, S_SSQ = 2 * REC_BYTES;

__device__ __forceinline__ int perm32pos(int kl) { return 8 * ((kl & 15) >> 2) + 4 * (kl >> 4) + (kl & 3); }
__device__ __forceinline__ int off256(int i, int k) { const int pos = perm32pos(k & 31), ch = 4 * (k >> 5) + (pos >> 3); return i * 256 + ((ch ^ (i & 15)) << 4) + (pos & 7) * 2; }
__device__ __forceinline__ int off128(int row, int j) { const int pos = perm32pos(j & 31), ch = 4 * (j >> 5) + (pos >> 3); return row * 128 + ((ch ^ (row & 7)) << 4) + (pos & 7) * 2; }
__device__ __forceinline__ float softplusf(float x) { return x > 20.f ? x : log1pf(__expf(x)); }

__device__ __forceinline__ void conv64(float (&y)[64], const bf16_t* xp, const float* cw, int ch1536, bool first) {
    const float w0 = cw[ch1536], w1 = cw[1536 + ch1536], w2 = cw[2 * 1536 + ch1536], w3 = cw[3 * 1536 + ch1536];
    float x0 = first ? 0.f : bf2f(xp[-3 * PJ]), x1 = first ? 0.f : bf2f(xp[-2 * PJ]), x2 = first ? 0.f : bf2f(xp[-1 * PJ]);
#pragma unroll
    for (int i = 0; i < 64; ++i) { const float x3 = bf2f(xp[(size_t)i * PJ]); y[i] = siluf(w0 * x0 + w1 * x1 + w2 * x2 + w3 * x3); x0 = x1; x1 = x2; x2 = x3; }
}

__device__ __forceinline__ void prep_unit(const Args& a, LAS unsigned char* lds, int u, int wave, int lane) {
    unsigned char* ws = a.ws;
    const int tid = threadIdx.x, half = tid >> 8, c = tid & 255, w4 = wave & 3, fr = lane & 15, fq = lane >> 4;
    const int bh = u >> 4, b = bh >> 2, h = bh & 3, chunk = 2 * (u & 15) + half;
    LAS unsigned char* L = lds + half * P_HALF; LAS float* SC = (LAS float*)(L + P_SC); LAS float* AT = (LAS float*)(L + P_AT);
    const bf16_t* proj = (const bf16_t*)(ws + WS_PROJ); const size_t row0 = (size_t)b * SEQ + 64 * chunk;
    unsigned char* rec = (unsigned char*)a.out + (size_t)(bh * NCHUNK + chunk) * REC_BYTES;
    unsigned char* urec = ws + WS_XN + (size_t)(bh * NCHUNK + chunk) * UREC_BYTES;
    if (w4 == 0) {
        const bf16_t* pr = proj + (row0 + lane) * PJ;
        const float beta = sigmf(bf2f(pr[PC_B + h])); const float av = bf2f(pr[PC_A + h]) + a.dt_bias[h];
        float g = -__expf(a.a_log[h]) * softplusf(av);
#pragma unroll
        for (int o = 1; o < 64; o <<= 1) { const float up = __shfl_up(g, o); if (lane >= o) g += up; }
        const float glast = __shfl(g, 63);
        SC[SC_BETA + lane] = beta; SC[SC_GC + lane] = g; SC[SC_EGC + lane] = __expf(g); SC[SC_EKD + lane] = __expf(glast - g);
        if (lane == 63) ((float*)(ws + WS_GL))[bh * NCHUNK + chunk] = __expf(g);
    }
    float x[64];
    const int kc = c & 127;
    { const int pos = perm32pos(kc & 31), ch = 4 * (kc >> 5) + (pos >> 3), jb = (pos & 7) * 2;
      if (c < 128) { conv64(x, proj + row0 * PJ + PC_GQ + h * 128 + kc, a.conv_w, h * 128 + kc, chunk == 0);
#pragma unroll
          for (int i = 0; i < 64; ++i) *(LAS bf16_t*)(L + P_QR + i * 256 + ((ch ^ (i & 15)) << 4) + jb) = f2bf(x[i]);
          conv64(x, proj + row0 * PJ + PC_GV + h * 128 + kc, a.conv_w, 1024 + h * 128 + kc, chunk == 0);
      } else { conv64(x, proj + row0 * PJ + PC_GK + h * 128 + kc, a.conv_w, 512 + h * 128 + kc, chunk == 0);
#pragma unroll
          for (int i = 0; i < 64; ++i) { const bf16_t kb = f2bf(x[i]); *(LAS bf16_t*)(L + P_KR + i * 256 + ((ch ^ (i & 15)) << 4) + jb) = kb; x[i] = bf2f(kb); }
      } }
    __syncthreads();
    f32x4 kk[4], qk[4], qq;
    {
        bf16x8 ak[4], aq[4];
        const int ri = 16 * w4 + fr;
#pragma unroll
        for (int s = 0; s < 4; ++s) { const int o = ri * 256 + (((4 * s + fq) ^ fr) << 4); ak[s] = *(LAS const bf16x8*)(L + P_KR + o); aq[s] = *(LAS const bf16x8*)(L + P_QR + o); }
        qq = (f32x4){0.f, 0.f, 0.f, 0.f};
#pragma unroll
        for (int s = 0; s < 4; ++s) qq = __builtin_amdgcn_mfma_f32_16x16x32_bf16(aq[s], aq[s], qq, 0, 0, 0);
#pragma unroll
        for (int nt = 0; nt < 4; ++nt) {
            kk[nt] = (f32x4){0.f, 0.f, 0.f, 0.f}; qk[nt] = (f32x4){0.f, 0.f, 0.f, 0.f};
            if (nt <= w4) {
                const int rj = 16 * nt + fr;
#pragma unroll
                for (int s = 0; s < 4; ++s) { const bf16x8 bk = *(LAS const bf16x8*)(L + P_KR + rj * 256 + (((4 * s + fq) ^ fr) << 4));
                    kk[nt] = __builtin_amdgcn_mfma_f32_16x16x32_bf16(ak[s], bk, kk[nt], 0, 0, 0);
                    qk[nt] = __builtin_amdgcn_mfma_f32_16x16x32_bf16(aq[s], bk, qk[nt], 0, 0, 0); }
            }
        }
#pragma unroll
        for (int nt = 0; nt < 4; ++nt) if (nt == w4) {
#pragma unroll
            for (int r = 0; r < 4; ++r) if (fr == 4 * fq + r) { SC[SC_RK2 + 16 * w4 + fr] = kk[nt][r]; SC[SC_RQ2 + 16 * w4 + fr] = qq[r]; } }
    }
    __syncthreads();
    {
#pragma unroll
        for (int nt = 0; nt < 4; ++nt) {
            const int j = 16 * nt + fr; const float rkj = rsqrtf(SC[SC_RK2 + j] + RMS_EPS), gcj = SC[SC_GC + j];
            f32x4 av; float qv[4];
#pragma unroll
            for (int r = 0; r < 4; ++r) { const int i = 16 * w4 + 4 * fq + r; const float gci = SC[SC_GC + i];
                const float dec = __expf(fminf(gci - gcj, 0.f));
                const float rki = rsqrtf(SC[SC_RK2 + i] + RMS_EPS), rqi = rsqrtf(SC[SC_RQ2 + i] + RMS_EPS);
                av[r] = (nt <= w4 && j < i) ? SC[SC_BETA + i] * kk[nt][r] * rki * rkj * dec : 0.f;
                qv[r] = (nt <= w4 && j <= i) ? qk[nt][r] * rqi * rkj * 0.08838834764831845f * dec : 0.f; }
            *(LAS f32x4*)(AT + j * 64 + 16 * w4 + 4 * fq) = av;
#pragma unroll
            for (int r = 0; r < 4; ++r) { const int i = 16 * w4 + 4 * fq + r; *(LAS bf16_t*)(L + P_QKI + off128(i, j)) = f2bf(qv[r]); }
        }
        if (c >= 128) {
            float kd[64];
#pragma unroll
            for (int j = 0; j < 64; ++j) kd[j] = x[j] * SC[SC_EKD + j] * rsqrtf(SC[SC_RK2 + j] + RMS_EPS);
#pragma unroll
            for (int ch = 0; ch < 8; ++ch) { const int j0 = 32 * (ch >> 2) + 4 * (ch & 3);
                const bf16x8 v = pack8(kd[j0], kd[j0 + 1], kd[j0 + 2], kd[j0 + 3], kd[j0 + 16], kd[j0 + 17], kd[j0 + 18], kd[j0 + 19]);
                *(bf16x8*)(rec + REC_KD + kc * 128 + ((ch ^ (kc & 7)) << 4)) = v; }
#pragma unroll
            for (int i = 0; i < 64; ++i) x[i] = x[i] * SC[SC_BETA + i] * SC[SC_EGC + i] * rsqrtf(SC[SC_RK2 + i] + RMS_EPS);
        } else {
#pragma unroll
            for (int i = 0; i < 64; ++i) x[i] = x[i] * SC[SC_BETA + i];
        }
        { const int i = c >> 2; const float f = rsqrtf(SC[SC_RQ2 + i] + RMS_EPS) * 0.08838834764831845f * SC[SC_EGC + i];
#pragma unroll
          for (int cc = 0; cc < 4; ++cc) { const int o = i * 256 + ((4 * (c & 3) + cc) << 4);
              const u32x4 v = *(LAS const u32x4*)(L + P_QR + o);
              const bf16x8 w = pack8(__uint_as_float(v.x << 16) * f, __uint_as_float(v.x & 0xffff0000u) * f, __uint_as_float(v.y << 16) * f, __uint_as_float(v.y & 0xffff0000u) * f,
                                     __uint_as_float(v.z << 16) * f, __uint_as_float(v.z & 0xffff0000u) * f, __uint_as_float(v.w << 16) * f, __uint_as_float(v.w & 0xffff0000u) * f);
              *(bf16x8*)(rec + REC_QG + o) = w; } }
    }
    __syncthreads();
    {
        const LAS f32x4* AT4 = (const LAS f32x4*)AT;
#pragma unroll
        for (int j = 0; j < 63; ++j) {
            const float xj = x[j];
#pragma unroll
            for (int i4 = (j + 1) / 4; i4 < 16; ++i4) { const f32x4 av = AT4[j * 16 + i4];
#pragma unroll
                for (int r = 0; r < 4; ++r) if (4 * i4 + r > j) x[4 * i4 + r] -= av[r] * xj; }
        }
#pragma unroll
        for (int cc = 0; cc < 2; ++cc) { const int o = (c * 2 + cc) * 16; *(u32x4*)(rec + REC_QK + o) = *(LAS const u32x4*)(L + P_QKI + o); }
        if (c < 128) {
            const int wv = kc >> 4, cc = kc & 15;
#pragma unroll
            for (int it = 0; it < 4; ++it)
#pragma unroll
                for (int q = 0; q < 4; ++q) { const int i0 = 16 * it + 4 * q;
                    *(f32x4*)(urec + (size_t)(((wv * 4 + it) * 64) + q * 16 + cc) * 16) = (f32x4){x[i0], x[i0 + 1], x[i0 + 2], x[i0 + 3]}; }
        } else {
            const int pos = perm32pos(kc & 31), ch = 4 * (kc >> 5) + (pos >> 3), jb = (pos & 7) * 2;
#pragma unroll
            for (int i = 0; i < 64; ++i) *(LAS bf16_t*)(L + P_KR + i * 256 + ((ch ^ (i & 15)) << 4) + jb) = f2bf(-x[i]);
        }
    }
    __syncthreads();
#pragma unroll
    for (int cc = 0; cc < 4; ++cc) { const int o = (c * 4 + cc) * 16; *(u32x4*)(rec + REC_W + o) = *(LAS const u32x4*)(L + P_KR + o); }
    __syncthreads();
}

__device__ __forceinline__ void scan_unit(const Args& a, LAS unsigned char* lds, int bh, int wave, int lane) {
    unsigned char* ws = a.ws;
    const int b = bh >> 2, h = bh & 3, fr = lane & 15, fq = lane >> 4;
    const unsigned char* recb = (const unsigned char*)a.out + (size_t)bh * NCHUNK * REC_BYTES;
    const unsigned char* urecb = ws + WS_XN + (size_t)bh * NCHUNK * UREC_BYTES;
    const float* gl = (const float*)(ws + WS_GL) + bh * NCHUNK;
    const bf16_t* proj = (const bf16_t*)(ws + WS_PROJ); bf16_t* mix = (bf16_t*)(ws + WS_MIX);
    const float ng = a.gdn_norm_g[16 * wave + fr];
    f32x4 S[8];
#pragma unroll
    for (int kt = 0; kt < 8; ++kt) S[kt] = (f32x4){0.f, 0.f, 0.f, 0.f};
#pragma unroll
    for (int p = 0; p < 7; ++p) __builtin_amdgcn_global_load_lds((const unsigned*)(recb + (size_t)(wave + 8 * p) * 1024 + lane * 16), (LAS unsigned*)(lds + S_BUF + (wave + 8 * p) * 1024), 16, 0, 0);
    for (int ck = 0; ck < NCHUNK; ++ck) {
        LAS const unsigned char* buf = lds + S_BUF + (ck & 1) * REC_BYTES;
        asm volatile("s_waitcnt vmcnt(0)" ::: "memory"); __syncthreads();
        if (ck + 1 < NCHUNK) { const unsigned char* src = recb + (size_t)(ck + 1) * REC_BYTES; LAS unsigned char* dst = lds + S_BUF + ((ck + 1) & 1) * REC_BYTES;
#pragma unroll
            for (int p = 0; p < 7; ++p) __builtin_amdgcn_global_load_lds((const unsigned*)(src + (size_t)(wave + 8 * p) * 1024 + lane * 16), (LAS unsigned*)(dst + (wave + 8 * p) * 1024), 16, 0, 0); }
        const f32x4* up = (const f32x4*)(urecb + (size_t)ck * UREC_BYTES) + (wave * 4) * 64 + lane;
        f32x4 av[4], ao[4];
#pragma unroll
        for (int it = 0; it < 4; ++it) { av[it] = up[it * 64]; ao[it] = (f32x4){0.f, 0.f, 0.f, 0.f}; }
        const float egl = gl[ck];
        float zv[16];
        { const bf16_t* zp = proj + ((size_t)b * SEQ + 64 * ck) * PJ + PC_Z + h * 128 + 16 * wave + fr;
#pragma unroll
          for (int it = 0; it < 4; ++it)
#pragma unroll
              for (int r = 0; r < 4; ++r) zv[4 * it + r] = bf2f(zp[(size_t)(16 * it + 4 * fq + r) * PJ]); }
        bf16x8 Sb[4];
#pragma unroll
        for (int s = 0; s < 4; ++s) Sb[s] = pack8(S[2 * s][0], S[2 * s][1], S[2 * s][2], S[2 * s][3], S[2 * s + 1][0], S[2 * s + 1][1], S[2 * s + 1][2], S[2 * s + 1][3]);
#pragma unroll
        for (int it = 0; it < 4; ++it) { const int o = (16 * it + fr) * 256;
#pragma unroll
            for (int s = 0; s < 4; ++s) { const int co = ((4 * s + fq) ^ fr) << 4;
                av[it] = __builtin_amdgcn_mfma_f32_16x16x32_bf16(*(LAS const bf16x8*)(buf + REC_W + o + co), Sb[s], av[it], 0, 0, 0);
                ao[it] = __builtin_amdgcn_mfma_f32_16x16x32_bf16(*(LAS const bf16x8*)(buf + REC_QG + o + co), Sb[s], ao[it], 0, 0, 0); } }
        bf16x8 vb[2];
#pragma unroll
        for (int s = 0; s < 2; ++s) vb[s] = pack8(av[2 * s][0], av[2 * s][1], av[2 * s][2], av[2 * s][3], av[2 * s + 1][0], av[2 * s + 1][1], av[2 * s + 1][2], av[2 * s + 1][3]);
#pragma unroll
        for (int it = 0; it < 4; ++it) { const int o = (16 * it + fr) * 128;
#pragma unroll
            for (int s = 0; s < 2; ++s) ao[it] = __builtin_amdgcn_mfma_f32_16x16x32_bf16(*(LAS const bf16x8*)(buf + REC_QK + o + (((4 * s + fq) ^ (fr & 7)) << 4)), vb[s], ao[it], 0, 0, 0); }
#pragma unroll
        for (int kt = 0; kt < 8; ++kt) { S[kt] = S[kt] * egl; const int o = (16 * kt + fr) * 128;
#pragma unroll
            for (int s = 0; s < 2; ++s) S[kt] = __builtin_amdgcn_mfma_f32_16x16x32_bf16(*(LAS const bf16x8*)(buf + REC_KD + o + (((4 * s + fq) ^ (fr & 7)) << 4)), vb[s], S[kt], 0, 0, 0); }
        LAS float* SSQ = (LAS float*)(lds + S_SSQ) + (ck & 1) * 512;
#pragma unroll
        for (int it = 0; it < 4; ++it)
#pragma unroll
            for (int r = 0; r < 4; ++r) { float s2 = ao[it][r] * ao[it][r]; s2 += __shfl_xor(s2, 1); s2 += __shfl_xor(s2, 2); s2 += __shfl_xor(s2, 4); s2 += __shfl_xor(s2, 8);
                if (fr == 0) SSQ[(16 * it + 4 * fq + r) * 8 + wave] = s2; }
        __syncthreads();
#pragma unroll
        for (int it = 0; it < 4; ++it)
#pragma unroll
            for (int r = 0; r < 4; ++r) { const int i = 16 * it + 4 * fq + r; const f32x4 p0 = *(LAS const f32x4*)(SSQ + i * 8), p1 = *(LAS const f32x4*)(SSQ + i * 8 + 4);
                const float tot = ((p0[0] + p0[1]) + (p0[2] + p0[3])) + ((p1[0] + p1[1]) + (p1[2] + p1[3]));
                const float rs = rsqrtf(tot * (1.f / 128.f) + RMS_EPS);
                mix[((size_t)b * SEQ + 64 * ck + i) * DM + 512 + h * 128 + 16 * wave + fr] = f2bf(ao[it][r] * rs * ng * siluf(zv[4 * it + r])); }
    }
    __syncthreads();
}
}

#ifndef PG8_ALIGN
#define PG8_ALIGN true
#endif
constexpr int NWAVES = 8;
constexpr int RING_BYTES = 131072;
constexpr int MISC_OFF = RING_BYTES + 320;
constexpr int LDS_BYTES = 147456;
#ifndef LAS
#define LAS __attribute__((address_space(3)))
#endif
#define GAS __attribute__((address_space(1)))
typedef unsigned v4u __attribute__((ext_vector_type(4)));
typedef float f32x4 __attribute__((ext_vector_type(4)));
#define LDS_WAIT() asm volatile("s_waitcnt lgkmcnt(0)" ::: "memory")
#define VM_WAIT() asm volatile("s_waitcnt vmcnt(0)" ::: "memory")
constexpr int CW_BAR = 4096, CW_QUEUE = 8192;


__device__ __forceinline__ unsigned pk2(float lo, float hi) { return (unsigned)f2bf(lo) | ((unsigned)f2bf(hi) << 16); }
__device__ __forceinline__ void p0_transpose_item(const float* colp, int ld, const float* gain, int gain_n, int K, bf16_t* WT, LAS float* scr, int k0, int n0, int lane) {
#pragma unroll 8
    for (int i = 0; i < 32; ++i) { const int kk = 2 * i + (lane >> 5); float v = 0.f;
        if (colp) { v = colp[(size_t)(k0 + kk) * ld]; if (gain && (k0 + kk) < gain_n) v *= gain[k0 + kk]; }
        scr[kk * 33 + (lane & 31)] = v; }
    LDS_WAIT(); asm volatile("" ::: "memory");
    const int c = lane & 7;
#pragma unroll
    for (int j = 0; j < 4; ++j) { const int n = (lane >> 3) + 8 * j; const LAS float* s = scr + (8 * c) * 33 + n;
        v4u o; o.x = pk2(s[0 * 33], s[1 * 33]); o.y = pk2(s[2 * 33], s[3 * 33]); o.z = pk2(s[4 * 33], s[5 * 33]); o.w = pk2(s[6 * 33], s[7 * 33]);
        *(v4u*)(WT + (size_t)(n0 + n) * K + k0 + 8 * c) = o; }
    LDS_WAIT(); asm volatile("" ::: "memory");
}
__device__ __forceinline__ void p0_prologue(const Args& a, LAS unsigned char* lds, int vcu, int G, int wave, int lane) {
    unsigned char* ws = a.ws;
    LAS float* scr = (LAS float*)(lds + wave * 16384);
    const int gw = vcu * NWAVES + wave, NGW = G * NWAVES;
    constexpr int I_IN = 16 * (PJ / 32), I_OUT = 16 * 32, I_GU = 16 * (2 * DFF / 32), I_DN = (DFF / 64) * 32, I_W1 = 2 * 32 * 4, I_W2 = 2 * 2 * 2;
    constexpr int NITEMS = I_IN + I_OUT + I_GU + I_DN + I_W1 + I_W2;
    for (int it = gw; it < NITEMS; it += NGW) {
        int r = it;
        if (r < I_IN) { const int nblk = PJ / 32, kb = r / nblk, nb = r % nblk; const int n = nb * 32 + (lane & 31); const int oc = win_orig_col(n);
            p0_transpose_item(oc < 0 ? nullptr : a.w_in + oc, IN_W, nullptr, 0, DM, (bf16_t*)(ws + WS_WIN), scr, kb * 64, nb * 32, lane); continue; } r -= I_IN;
        if (r < I_OUT) { const int kb = r / 32, nb = r % 32; const int n = nb * 32 + (lane & 31);
            p0_transpose_item(a.w_out + n, DM, a.nsa_norm_g, 512, DM, (bf16_t*)(ws + WS_WOUT), scr, kb * 64, nb * 32, lane); continue; } r -= I_OUT;
        if (r < I_GU) { const int nblk = 2 * DFF / 32, kb = r / nblk, nb = r % nblk; const int n = nb * 32 + (lane & 31); const int pn = n >> 8, wi = n & 255;
            const float* W = (wi < 128) ? a.w_gate : a.w_up;
            p0_transpose_item(W + pn * 128 + (wi & 127), DFF, a.norm2_g, DM, DM, (bf16_t*)(ws + WS_WGU), scr, kb * 64, nb * 32, lane); continue; } r -= I_GU;
        if (r < I_DN) { const int kb = r / 32, nb = r % 32; const int n = nb * 32 + (lane & 31);
            p0_transpose_item(a.w_down + n, DM, nullptr, 0, DFF, (bf16_t*)(ws + WS_WDN), scr, kb * 64, nb * 32, lane); continue; } r -= I_DN;
        if (r < I_W1) { const int i = r / 128, rr = r % 128, kb = rr / 4, nb = rr % 4; const int n = nb * 32 + (lane & 31);
            p0_transpose_item(a.cmp_w1 + (size_t)i * 2048 * 128 + n, 128, nullptr, 0, 2048, (bf16_t*)(ws + WS_W1T) + (size_t)i * 128 * 2048, scr, kb * 64, nb * 32, lane); continue; } r -= I_W1;
        { const int i = r / 4, rr = r % 4, kb = rr / 2, nb = rr % 2; const int n = nb * 32 + (lane & 31);
            p0_transpose_item(a.cmp_w2 + (size_t)i * 128 * 64 + n, 64, nullptr, 0, 128, (bf16_t*)(ws + WS_W2T) + (size_t)i * 64 * 128, scr, kb * 64, nb * 32, lane); }
    }
    bf16_t* xn = (bf16_t*)(ws + WS_XN);
    for (int m = gw; m < MTOK; m += NGW) {
        const f32x4* xr = (const f32x4*)(a.x + (size_t)m * DM) + lane;
        f32x4 v[4]; float s = 0.f;
#pragma unroll
        for (int j = 0; j < 4; ++j) { v[j] = xr[64 * j]; s += (v[j].x * v[j].x + v[j].y * v[j].y) + (v[j].z * v[j].z + v[j].w * v[j].w); }
        s = wave_sum(s); const float rstd = rsqrtf(s * (1.f / DM) + RMS_EPS);
        unsigned long long* o8 = (unsigned long long*)(xn + (size_t)m * DM) + lane;
#pragma unroll
        for (int j = 0; j < 4; ++j) { const f32x4 gg = *((const f32x4*)a.norm1_g + lane + 64 * j);
            o8[64 * j] = (unsigned long long)pk2(v[j].x * rstd * gg.x, v[j].y * rstd * gg.y) | ((unsigned long long)pk2(v[j].z * rstd * gg.z, v[j].w * rstd * gg.w) << 32); }
    }
    float* tab = (float*)(ws + WS_ROPE);
    for (int i = gw * 64 + lane; i < MTOK * 8; i += NGW * 64) {
        const int m = i >> 3, f = i & 7;
        const float inv = powf(500000.0f, -(float)f * (2.0f / 16.0f));
        const float ang = (float)a.positions[m] * inv;
        tab[m * 16 + f] = cosf(ang); tab[m * 16 + 8 + f] = sinf(ang);
    }
}
__device__ __forceinline__ void p7_final(const Args& a, int vcu, int G, int wave, int lane) {
    const int gw = vcu * NWAVES + wave, NGW = G * NWAVES; const float* ss = (const float*)(a.ws + WS_SS3);
    for (int m = gw; m < MTOK; m += NGW) {
        const f32x4* sp = (const f32x4*)(ss + (size_t)m * 16); const f32x4 t = (sp[0] + sp[1]) + (sp[2] + sp[3]);
        const float rstd = rsqrtf(((t[0] + t[1]) + (t[2] + t[3])) * (1.f / DM) + RMS_EPS);
        f32x4* xr = (f32x4*)(a.out + (size_t)m * DM) + lane;
#pragma unroll
        for (int j = 0; j < 4; ++j) { const f32x4 gg = *((const f32x4*)a.final_g + lane + 64 * j); xr[64 * j] = xr[64 * j] * rstd * gg; }
    }
}

__global__ void __launch_bounds__(NWAVES * 64, 2) mk_fwd(Args args) {
    extern __shared__ __attribute__((aligned(16))) unsigned char lds_raw[];
    LAS unsigned char* lds = (LAS unsigned char*)lds_raw;
    volatile LAS unsigned* MISC = (volatile LAS unsigned*)(lds + MISC_OFF);
    const int tid = threadIdx.x, lane = tid & 63, wave = __builtin_amdgcn_readfirstlane(tid >> 6);
    const int G = gridDim.x; const int bx = blockIdx.x; const int vcu = (G % 8 == 0) ? (bx % 8) * (G / 8) + bx / 8 : bx;
    unsigned char* ws = args.ws;
    for (int u = tid; u < (LDS_BYTES - RING_BYTES) / 4; u += NWAVES * 64) ((LAS unsigned*)(lds + RING_BYTES))[u] = 0u;
    __syncthreads();
    const int lo = args.ph_lo, hi = args.ph_hi;
    const bool multi = (hi - lo) > 1;
    XcdBarrier bar; bar.bar = (unsigned*)(ws + WS_CTL) + CW_BAR; bar.x = 0; bar.st = nullptr;
    if (multi) bar = xcd_barrier_post((unsigned*)(ws + WS_CTL) + CW_BAR, MISC + 8);
#define IN(k) (lo <= (k) && (k) < hi)
#define SEAM(k) do { if (IN(k) && IN((k) + 1)) xcd_barrier(bar); } while (0)
    if (IN(0)) { p0_prologue(args, lds, vcu, G, wave, lane); SEAM(0); }
    if (IN(1)) {
        pg8::Gemm g{(const bf16_t*)(ws + WS_XN), (const bf16_t*)(ws + WS_WIN), MTOK, PJ, DM}; pg8::StaticOrder S; S.init(MTOK, PJ, G, bx);
        pg8::EpiProj E{(bf16_t*)(ws + WS_PROJ), (const float*)(ws + WS_ROPE), -1};
        pg8::gemm_phase<pg8::EpiProj, pg8::StaticOrder, PG8_ALIGN, PG8_SP2>(lds, g, S, E);
        SEAM(1);
    }
    if (IN(2)) {
        for (int u = vcu; u < 512; u += G) nsa::compress_unit(ws, args.cmp_pos, lds, u, wave, lane);
        for (int u = vcu; u < 1024; u += G) gdn::prep_unit(args, lds, u, wave, lane);
        SEAM(2);
    }
    if (IN(3)) {
        if (vcu < BATCH * GH) gdn::scan_unit(args, lds, vcu, wave, lane);
        unsigned* qctr = (unsigned*)(ws + WS_CTL) + CW_QUEUE; LAS int* QW = (LAS int*)(lds + nsa::L_QUEUE);
        for (;;) {
            if (tid == 0) *QW = (int)atomicAdd(qctr, 1u);
            __syncthreads();
            const int u = *QW;
            if (u >= 1024) break;
            nsa::attn_unit(ws, lds, (u & 31) >> 1, u & 1, 31 - (u >> 5), wave, lane);
        }
        SEAM(3);
    }
    if (IN(4)) {
        pg8::Gemm g{(const bf16_t*)(ws + WS_MIX), (const bf16_t*)(ws + WS_WOUT), MTOK, DM, DM}; pg8::StaticOrder S; S.init(MTOK, DM, G, bx);
        pg8::EpiOut E{args.x, args.out, (bf16_t*)(ws + WS_XN), (float*)(ws + WS_SS2), (const float*)(ws + WS_SSQN), 8};
        pg8::gemm_phase<pg8::EpiOut, pg8::StaticOrder, PG8_ALIGN, PG8_SP2>(lds, g, S, E);
        SEAM(4);
    }
    if (IN(5)) {
        pg8::Gemm g{(const bf16_t*)(ws + WS_XN), (const bf16_t*)(ws + WS_WGU), MTOK, 2 * DFF, DM}; pg8::StaticOrder S; S.init(MTOK, 2 * DFF, G, bx);
        pg8::EpiGU E{(bf16_t*)(ws + WS_PROJ), (const float*)(ws + WS_SS2), -1};
        pg8::gemm_phase<pg8::EpiGU, pg8::StaticOrder, PG8_ALIGN, PG8_SP2>(lds, g, S, E);
        SEAM(5);
    }
    if (IN(6)) {
        pg8::Gemm g{(const bf16_t*)(ws + WS_PROJ), (const bf16_t*)(ws + WS_WDN), MTOK, DM, DFF}; pg8::StaticOrder S; S.init(MTOK, DM, G, bx);
        pg8::EpiDown E{args.out, (float*)(ws + WS_SS3), -1};
        pg8::gemm_phase<pg8::EpiDown, pg8::StaticOrder, PG8_ALIGN, PG8_SP2>(lds, g, S, E);
        SEAM(6);
    }
    if (IN(7)) p7_final(args, vcu, G, wave, lane);
#undef IN
#undef SEAM
}

extern "C" void kernel_launch(void* const* d_in, const int* in_sizes, int n_in, void* d_out, int out_size, void* d_ws, size_t ws_size, hipStream_t stream) {
    static int grid = 0;
    if (grid == 0) {
        if (n_in != 18 || ws_size < WS_END) { fprintf(stderr, "kernel_launch: unexpected inputs / workspace (%d, %zu)\n", n_in, ws_size); grid = -1; return; }
        int dev = 0, cus = 0;
        if (hipGetDevice(&dev) != hipSuccess || hipDeviceGetAttribute(&cus, hipDeviceAttributeMultiprocessorCount, dev) != hipSuccess) { grid = -1; return; }
        if (hipFuncSetAttribute((const void*)mk_fwd, hipFuncAttributeMaxDynamicSharedMemorySize, LDS_BYTES) != hipSuccess) { fprintf(stderr, "kernel_launch: hipFuncSetAttribute failed\n"); grid = -1; return; }
        (void)hipGetLastError();
        grid = cus;
    }
    if (grid < 0) return;
    (void)hipMemsetAsync((char*)d_ws + WS_CTL, 0, 1 * MiB, stream);
    Args a{};
    a.x = (const float*)d_in[0]; a.positions = (const int*)d_in[1]; a.norm1_g = (const float*)d_in[2]; a.w_in = (const float*)d_in[3]; a.cmp_pos = (const float*)d_in[4];
    a.cmp_w1 = (const float*)d_in[5]; a.cmp_w2 = (const float*)d_in[6]; a.nsa_norm_g = (const float*)d_in[7]; a.conv_w = (const float*)d_in[8]; a.a_log = (const float*)d_in[9];
    a.dt_bias = (const float*)d_in[10]; a.gdn_norm_g = (const float*)d_in[11]; a.w_out = (const float*)d_in[12]; a.norm2_g = (const float*)d_in[13]; a.w_gate = (const float*)d_in[14];
    a.w_up = (const float*)d_in[15]; a.w_down = (const float*)d_in[16]; a.final_g = (const float*)d_in[17];
    a.out = (float*)d_out; a.ws = (unsigned char*)d_ws;
    unsigned char* ws = (unsigned char*)d_ws;
    bf16_t* proj = (bf16_t*)(ws + WS_PROJ); bf16_t* mix = (bf16_t*)(ws + WS_MIX);
    auto launch = [&](int lo, int hi) { a.ph_lo = lo; a.ph_hi = hi; hipLaunchKernelGGL(mk_fwd, dim3(grid), dim3(NWAVES * 64), LDS_BYTES, stream, a); };
    launch(0, 8);
}
```

```cpp
#include <hip/hip_runtime.h>
#include <stdint.h>
#include <stdio.h>

typedef unsigned short bf16_t;

constexpr int BATCH = 16, SEQ = 2048, DM = 1024, MTOK = BATCH * SEQ;
constexpr int NSA_HEADS = 8, NSA_G = 2, HPG = 4, HD = 64;
constexpr int NCMP = 127, CMP_L = 32, CMP_S = 16, CMP_HID = 128;
constexpr int NSEL = 32, SELB = 64, TOPN = 8, WIN = 512;
constexpr int GH = 4, GD = 128, DFF = 2816;
constexpr int IN_W = 3360;
constexpr int PJ = 3584;
constexpr int PC_Q = 0, PC_KCMP = 512, PC_VCMP = 640, PC_KSLC = 768, PC_VSLC = 896, PC_KWIN = 1024, PC_VWIN = 1152;
constexpr int PC_GQ = 1280, PC_GK = 1792, PC_GV = 2304, PC_Z = 2816, PC_GATE = 3328, PC_B = 3352, PC_A = 3356;
constexpr float RMS_EPS = 1e-6f;
constexpr float QSCALE = 0.125f * 1.4426950408889634f;

constexpr size_t MiB = 1u << 20;
constexpr size_t WS_CTL = 0;
constexpr size_t WS_ROPE = 1 * MiB;
constexpr size_t WS_KC = 3 * MiB;
constexpr size_t WS_VC = 3 * MiB + 512 * 1024;
constexpr size_t WS_SSQN = 4 * MiB;
constexpr size_t WS_SS2 = 5 * MiB;
constexpr size_t WS_SS3 = 7 * MiB;
constexpr size_t WS_WIN = 9 * MiB;
constexpr size_t WS_WOUT = 16 * MiB;
constexpr size_t WS_WGU = 18 * MiB;
constexpr size_t WS_WDN = 29 * MiB;
constexpr size_t WS_W1T = 35 * MiB;
constexpr size_t WS_W2T = 36 * MiB;
constexpr size_t WS_GL = 37 * MiB;
constexpr size_t WS_XN = 40 * MiB;
constexpr size_t WS_MIX = 104 * MiB;
constexpr size_t WS_PROJ = 168 * MiB;
constexpr size_t WS_END = 392 * MiB;

__device__ __forceinline__ float bf2f(bf16_t v) { return __uint_as_float(((unsigned)v) << 16); }
__device__ __forceinline__ bf16_t f2bf(float f) { unsigned u = __float_as_uint(f); return (bf16_t)((u + 0x7fffu + ((u >> 16) & 1u)) >> 16); }
__device__ __forceinline__ float wave_sum(float v) {
#pragma unroll
    for (int o = 1; o < 64; o <<= 1) v += __shfl_xor(v, o);
    return v;
}
__device__ __forceinline__ float wave_max(float v) {
#pragma unroll
    for (int o = 1; o < 64; o <<= 1) v = fmaxf(v, __shfl_xor(v, o));
    return v;
}
__device__ __forceinline__ float siluf(float x) { return x * __builtin_amdgcn_rcpf(1.f + __builtin_amdgcn_exp2f(-1.4426950408889634f * x)); }
__device__ __forceinline__ float sigmf(float x) { return __builtin_amdgcn_rcpf(1.f + __builtin_amdgcn_exp2f(-1.4426950408889634f * x)); }

__host__ __device__ __forceinline__ int win_orig_col(int p) {
    if (p < 1280) return p;
    if (p < 2816) return p - 1280 + 1304;
    if (p < 3328) return p - 2816 + 2840;
    if (p < 3352) return p - 3328 + 1280;
    if (p < 3360) return p;
    return -1;
}
__global__ void __launch_bounds__(128) k_compress_naive(const bf16_t* proj, const float* cmp_pos, const float* w1, const float* w2, bf16_t* kc, bf16_t* vc) {
    int id = blockIdx.x; const int n = id & 127; id >>= 7; const int g = id & 1; id >>= 1; const int b = id & 15; const int i = id >> 4;
    const int j = threadIdx.x; __shared__ float hid[128];
    bf16_t* outp = (i == 0 ? kc : vc) + ((size_t)(b * 2 + g) * 128 + n) * 64;
    if (n == 127) { if (j < 64) outp[j] = 0; return; }
    const bf16_t* xb = proj + (size_t)(b * SEQ + 16 * n) * PJ + (i == 0 ? PC_KCMP : PC_VCMP) + g * 64;
    const float* pw = w1 + (size_t)i * 2048 * 128; const float* pp = cmp_pos + i * 2048;
    float acc = 0.f;
    for (int l = 0; l < 32; ++l)
        for (int d = 0; d < 64; ++d) acc += (bf2f(xb[(size_t)l * PJ + d]) + pp[l * 64 + d]) * pw[(size_t)(l * 64 + d) * 128 + j];
    hid[j] = siluf(acc); __syncthreads();
    if (j < 64) { float o = 0.f; const float* q = w2 + (size_t)i * 128 * 64;
        for (int jj = 0; jj < 128; ++jj) o += hid[jj] * q[jj * 64 + j];
        outp[j] = f2bf(o); }
}
__global__ void __launch_bounds__(256) k_nsa_naive(const bf16_t* proj, const bf16_t* kc, const bf16_t* vc, bf16_t* mix, float* ssqn) {
    const int m = blockIdx.x >> 1, g = blockIdx.x & 1, b = m / SEQ, t = m % SEQ;
    const int w = threadIdx.x >> 6, lane = threadIdx.x & 63, head = g * 4 + w, cur = t >> 6;
    __shared__ float sc[4][512]; __shared__ float imp[32]; __shared__ unsigned selmask; __shared__ int sellist[8];
    const float NEGB = -1e30f;
    float q[64];
    { const bf16_t* qp = proj + (size_t)m * PJ + PC_Q + head * 64;
#pragma unroll
      for (int d = 0; d < 64; ++d) q[d] = bf2f(qp[d]); }
    const size_t rowb = (size_t)b * SEQ;
    float o_cmp = 0.f;
    {
        const bf16_t* kcb = kc + (size_t)(b * 2 + g) * 128 * 64; const bf16_t* vcb = vc + (size_t)(b * 2 + g) * 128 * 64;
        float s[2]; float mx = NEGB;
#pragma unroll
        for (int i = 0; i < 2; ++i) { const int n = lane + 64 * i; float a = 0.f; const bf16_t* kp = kcb + n * 64;
#pragma unroll
            for (int d = 0; d < 64; ++d) a += q[d] * bf2f(kp[d]);
            const bool valid = (n < NCMP) && (16 * n + 31 <= t); s[i] = valid ? a : NEGB; mx = fmaxf(mx, s[i]); }
        mx = wave_max(mx); float p[2], sum = 0.f;
#pragma unroll
        for (int i = 0; i < 2; ++i) { p[i] = s[i] > -1e29f ? exp2f(s[i] - mx) : 0.f; sum += p[i]; }
        sum = wave_sum(sum); const float inv = (t >= 31 && sum > 0.f) ? 1.f / sum : 0.f;
#pragma unroll
        for (int i = 0; i < 2; ++i) sc[w][lane + 64 * i] = p[i] * inv;
        __syncthreads();
        for (int n = 0; n < NCMP; ++n) o_cmp += sc[w][n] * bf2f(vcb[n * 64 + lane]);
        if (threadIdx.x < 32) { const int s_ = threadIdx.x; float a = 0.f;
            for (int h = 0; h < 4; ++h) for (int n = 4 * s_ - 1; n <= 4 * s_ + 3; ++n) if (n >= 0 && n < NCMP) a += sc[h][n];
            imp[s_] = a; }
        __syncthreads();
        if (threadIdx.x == 0) { unsigned mask = 0u;
            for (int r = 0; r < TOPN; ++r) { float best = -3e38f; int bi = 0;
                for (int j = 0; j < NSEL; ++j) { if (mask >> j & 1u) continue;
                    const bool forced = (j == 0) || (j == cur) || (j == cur - 1);
                    const float v = forced ? 1e9f : (j <= cur ? imp[j] : NEGB);
                    if (v > best) { best = v; bi = j; } }
                mask |= 1u << bi; sellist[r] = bi; }
            selmask = mask; }
        __syncthreads();
    }
    float o_slc = 0.f;
    {
        float s[8]; float mx = NEGB;
#pragma unroll
        for (int i = 0; i < 8; ++i) { const int j = sellist[i]; const int kpos = 64 * j + lane; float a = NEGB;
            if (kpos <= t) { const bf16_t* kp = proj + (rowb + kpos) * PJ + PC_KSLC + g * 64; a = 0.f;
#pragma unroll
                for (int d = 0; d < 64; ++d) a += q[d] * bf2f(kp[d]); }
            s[i] = a; mx = fmaxf(mx, a); }
        mx = wave_max(mx); float sum = 0.f;
#pragma unroll
        for (int i = 0; i < 8; ++i) { s[i] = s[i] > -1e29f ? exp2f(s[i] - mx) : 0.f; sum += s[i]; }
        sum = wave_sum(sum); const float inv = 1.f / sum;
        __syncthreads();
#pragma unroll
        for (int i = 0; i < 8; ++i) sc[w][i * 64 + lane] = s[i] * inv;
        __syncthreads();
        for (int i = 0; i < 8; ++i) { const int j = sellist[i]; if (64 * j > t) continue;
            for (int kk = 0; kk < 64; ++kk) { const int kpos = 64 * j + kk; if (kpos > t) break;
                o_slc += sc[w][i * 64 + kk] * bf2f(proj[(rowb + kpos) * PJ + PC_VSLC + g * 64 + lane]); } }
    }
    float o_win = 0.f;
    {
        float s[8]; float mx = NEGB;
#pragma unroll
        for (int i = 0; i < 8; ++i) { const int kpos = t - 511 + lane + 64 * i; float a = NEGB;
            if (kpos >= 0) { const bf16_t* kp = proj + (rowb + kpos) * PJ + PC_KWIN + g * 64; a = 0.f;
#pragma unroll
                for (int d = 0; d < 64; ++d) a += q[d] * bf2f(kp[d]); }
            s[i] = a; mx = fmaxf(mx, a); }
        mx = wave_max(mx); float sum = 0.f;
#pragma unroll
        for (int i = 0; i < 8; ++i) { s[i] = s[i] > -1e29f ? exp2f(s[i] - mx) : 0.f; sum += s[i]; }
        sum = wave_sum(sum); const float inv = 1.f / sum;
        __syncthreads();
#pragma unroll
        for (int i = 0; i < 8; ++i) sc[w][i * 64 + lane] = s[i] * inv;
        __syncthreads();
        for (int kk = 0; kk < 512; ++kk) { const int kpos = t - 511 + kk; if (kpos < 0) continue;
            o_win += sc[w][kk] * bf2f(proj[(rowb + kpos) * PJ + PC_VWIN + g * 64 + lane]); }
    }
    const bf16_t* gp = proj + (size_t)m * PJ + PC_GATE + head * 3;
    const float o = sigmf(bf2f(gp[0])) * o_cmp + sigmf(bf2f(gp[1])) * o_slc + sigmf(bf2f(gp[2])) * o_win;
    mix[(size_t)m * DM + head * 64 + lane] = f2bf(o);
    const float ss = wave_sum(o * o);
    if (lane == 0) ssqn[m * 8 + head] = ss;
}
__global__ void __launch_bounds__(128) k_gdn_naive(const bf16_t* proj, const float* conv_w, const float* a_log, const float* dt_bias, const float* norm_g, bf16_t* mix) {
    const int b = blockIdx.x >> 2, h = blockIdx.x & 3, n = threadIdx.x, wv = n >> 6, lane = n & 63;
    __shared__ float shq[128], shk[128]; __shared__ float red[2][4];
    float S[128];
#pragma unroll
    for (int k = 0; k < 128; ++k) S[k] = 0.f;
    float wq[4], wk[4], wvv[4];
#pragma unroll
    for (int j = 0; j < 4; ++j) { wq[j] = conv_w[j * 1536 + h * 128 + n]; wk[j] = conv_w[j * 1536 + 512 + h * 128 + n]; wvv[j] = conv_w[j * 1536 + 1024 + h * 128 + n]; }
    float xq0 = 0.f, xq1 = 0.f, xq2 = 0.f, xk0 = 0.f, xk1 = 0.f, xk2 = 0.f, xv0 = 0.f, xv1 = 0.f, xv2 = 0.f;
    const float Aexp = -__expf(a_log[h]), dtb = dt_bias[h], ng = norm_g[n];
    for (int t = 0; t < SEQ; ++t) {
        const bf16_t* pr = proj + (size_t)(b * SEQ + t) * PJ;
        const float xq3 = bf2f(pr[PC_GQ + h * 128 + n]), xk3 = bf2f(pr[PC_GK + h * 128 + n]), xv3 = bf2f(pr[PC_GV + h * 128 + n]);
        float qv = siluf(wq[0] * xq0 + wq[1] * xq1 + wq[2] * xq2 + wq[3] * xq3);
        float kv = siluf(wk[0] * xk0 + wk[1] * xk1 + wk[2] * xk2 + wk[3] * xk3);
        const float vv = siluf(wvv[0] * xv0 + wvv[1] * xv1 + wvv[2] * xv2 + wvv[3] * xv3);
        xq0 = xq1; xq1 = xq2; xq2 = xq3; xk0 = xk1; xk1 = xk2; xk2 = xk3; xv0 = xv1; xv1 = xv2; xv2 = xv3;
        float sq = wave_sum(qv * qv), sk = wave_sum(kv * kv);
        if (lane == 0) { red[wv][0] = sq; red[wv][1] = sk; }
        __syncthreads();
        sq = red[0][0] + red[1][0]; sk = red[0][1] + red[1][1];
        qv *= rsqrtf(sq + RMS_EPS) * 0.08838834764831845f; kv *= rsqrtf(sk + RMS_EPS);
        shq[n] = qv; shk[n] = kv;
        __syncthreads();
        const float beta = sigmf(bf2f(pr[PC_B + h])); const float av = bf2f(pr[PC_A + h]) + dtb;
        const float sp = av > 20.f ? av : log1pf(__expf(av)); const float eg = __expf(Aexp * sp);
        float dot = 0.f;
#pragma unroll
        for (int k = 0; k < 128; ++k) dot += S[k] * shk[k];
        const float vn = beta * (vv - eg * dot);
        float o = 0.f;
#pragma unroll
        for (int k = 0; k < 128; ++k) { S[k] = eg * S[k] + shk[k] * vn; o += S[k] * shq[k]; }
        float so = wave_sum(o * o);
        if (lane == 0) red[wv][2] = so;
        __syncthreads();
        so = red[0][2] + red[1][2];
        const float z = bf2f(pr[PC_Z + h * 128 + n]);
        mix[(size_t)(b * SEQ + t) * DM + 512 + h * 128 + n] = f2bf(o * rsqrtf(so * (1.f / 128.f) + RMS_EPS) * ng * siluf(z));
    }
}

namespace pg8 {
#define PG8_LAS __attribute__((address_space(3)))
typedef unsigned short bf16_t;
typedef short bf16x8 __attribute__((ext_vector_type(8)));
typedef float f32x4 __attribute__((ext_vector_type(4)));
typedef unsigned u32x4 __attribute__((ext_vector_type(4)));
constexpr int BM = 256, BK = 64, HALF = 128, HTB = HALF * BK * 2  , STAGE_BYTES = 8 * HTB, NXCD = 8, WGM = 8;

__host__ __device__ __forceinline__ int lds_byte(int r, int c) { const int st = (r >> 4) * 2 + (c >> 5), rr = r & 15, cc = c & 31, ob = rr * 64 + cc * 2; return st * 1024 + (ob ^ (((ob >> 9) & 1) << 5)); }
__host__ __device__ __forceinline__ void stage_rc(int b, int& R, int& C) { const int st = b / 1024, sb = b % 1024, swz = sb ^ (((sb >> 9) & 1) << 5); R = (st >> 1) * 16 + swz / 64; C = (st & 1) * 32 + (swz % 64) / 2; }
__host__ __device__ __forceinline__ int perm32(int rho) { const int n = rho >> 4, i = rho & 15; return 8 * (i >> 2) + 4 * n + (i & 3); }

struct Unit { int pm, pn; };
struct Gemm { const bf16_t* A; const bf16_t* Bt; int M, N, K; };

struct StaticOrder {
    int nM, nN, nwg, G, c;
    __host__ __device__ void init(int M, int N, int G_, int c_) { nM = M / BM; nN = N / BM; nwg = nM * nN; G = G_; c = c_; }
    __host__ __device__ bool next(int i, Unit& u) const {
        const long L = (long)i * G + c; if (L >= nwg) return false;
        int wgid = (int)L; { const int q = nwg / NXCD, r = nwg % NXCD, xcd = wgid % NXCD, off = wgid / NXCD; wgid = (xcd < r ? xcd * (q + 1) : r * (q + 1) + (xcd - r) * q) + off; }
        const int nig = WGM * nN, gid = wgid / nig, fm = gid * WGM, gsz = (nM - fm) < WGM ? (nM - fm) : WGM;
        u.pm = fm + ((wgid % nig) % gsz); u.pn = (wgid % nig) / gsz; return true;
    }
    __device__ __forceinline__ void a_ready(const Unit&) const {}
    __device__ __forceinline__ void done(const Unit&) const {}
};
__device__ __forceinline__ unsigned cvt_pk_bf16(float lo, float hi) { unsigned r; asm volatile("v_cvt_pk_bf16_f32 %0, %1, %2" : "=v"(r) : "v"(lo), "v"(hi)); return r; }
typedef unsigned u32x2 __attribute__((ext_vector_type(2)));
__device__ __forceinline__ float fast_silu(float v) { return v * __builtin_amdgcn_rcpf(1.0f + __builtin_amdgcn_exp2f(-1.4426950408889634f * v)); }

struct EpiProj {
    static constexpr bool PERM = true, AFTER_DRAIN = false, MIDSCALE = false;
    bf16_t* out; const float* rope; int mid_t;
    __device__ __forceinline__ void midscale(f32x4 (&)[2][2][4][2], const Unit&, int, int) const {}
    __device__ __forceinline__ void operator()(const f32x4 (&acc)[2][2][4][2], const Unit& u, int wr, int wc, int fr, int fq) const {
        const int row0 = u.pm * BM + wr * 64 + fr, colt = u.pn * BM, lcol = wc * 32 + 8 * fq;
        const float sc = (u.pn < 2) ? QSCALE : 1.f;
        const bool wave_rope = ((wc & 1) == 0) && (u.pn < 5);
#pragma unroll
        for (int ai = 0; ai < 2; ++ai)
#pragma unroll
            for (int m = 0; m < 4; ++m) {
                const int r = row0 + ai * HALF + m * 16;
                f32x4 c0 = {1.f, 1.f, 1.f, 1.f}, c1 = c0, s0 = {0.f, 0.f, 0.f, 0.f}, s1 = s0;
                if (wave_rope) { const f32x4* tp = (const f32x4*)(rope + (size_t)r * 16); c0 = tp[0]; c1 = tp[1]; s0 = tp[2]; s1 = tp[3]; }
                bf16_t* rowp = out + (size_t)r * PJ + colt + lcol;
#pragma unroll
                for (int bj = 0; bj < 2; ++bj) {
                    f32x4 v0 = acc[ai][bj][m][0] * sc, v1 = acc[ai][bj][m][1] * sc;
                    const bool tile_rope = wave_rope && ((u.pn < 2) || (bj == 0));
                    if (tile_rope) {
                        f32x4 p0, p1;
#pragma unroll
                        for (int j = 0; j < 4; ++j) { p0[j] = __shfl_xor(v0[j], 16); p1[j] = __shfl_xor(v1[j], 16); }
                        if (fq == 0) { v0 = v0 * c0 - p0 * s0; v1 = v1 * c1 - p1 * s1; }
                        else if (fq == 1) { v0 = v0 * c0 + p0 * s0; v1 = v1 * c1 + p1 * s1; }
                    }
                    u32x4 w; w.x = cvt_pk_bf16(v0[0], v0[1]); w.y = cvt_pk_bf16(v0[2], v0[3]); w.z = cvt_pk_bf16(v1[0], v1[1]); w.w = cvt_pk_bf16(v1[2], v1[3]);
                    *(u32x4*)(rowp + bj * HALF) = w;
                }
            }
    }
};
struct EpiOut {
    static constexpr bool PERM = false, AFTER_DRAIN = false, MIDSCALE = true;
    const float* x; float* x1; bf16_t* x1b; float* ss2; const float* ssqn; int mid_t;
    __device__ __forceinline__ void midscale(f32x4 (&acc)[2][2][4][2], const Unit& u, int wr, int fr) const {
#pragma unroll
        for (int ai = 0; ai < 2; ++ai)
#pragma unroll
            for (int m = 0; m < 4; ++m) {
                const int r = u.pm * BM + ai * HALF + wr * 64 + m * 16 + fr;
                const f32x4 a = *(const f32x4*)(ssqn + (size_t)r * 8), b = *(const f32x4*)(ssqn + (size_t)r * 8 + 4);
                const float s = ((a[0] + a[1]) + (a[2] + a[3])) + ((b[0] + b[1]) + (b[2] + b[3]));
                const float rs = __builtin_amdgcn_rsqf(s * (1.0f / 512.0f) + RMS_EPS);
#pragma unroll
                for (int bj = 0; bj < 2; ++bj)
#pragma unroll
                    for (int n = 0; n < 2; ++n) acc[ai][bj][m][n] = acc[ai][bj][m][n] * rs;
            }
    }
    __device__ __forceinline__ void operator()(const f32x4 (&acc)[2][2][4][2], const Unit& u, int wr, int wc, int fr, int fq) const {
#pragma unroll
        for (int ai = 0; ai < 2; ++ai)
#pragma unroll
            for (int m = 0; m < 4; ++m) {
                const int r = u.pm * BM + ai * HALF + wr * 64 + m * 16 + fr; float ssum = 0.f;
#pragma unroll
                for (int bj = 0; bj < 2; ++bj)
#pragma unroll
                    for (int n = 0; n < 2; ++n) {
                        const size_t off = (size_t)r * DM + u.pn * BM + bj * HALF + wc * 32 + n * 16 + 4 * fq;
                        const f32x4 y = *(const f32x4*)(x + off) + acc[ai][bj][m][n];
                        *(f32x4*)(x1 + off) = y;
                        u32x2 w; w.x = cvt_pk_bf16(y[0], y[1]); w.y = cvt_pk_bf16(y[2], y[3]); *(u32x2*)(x1b + off) = w;
                        ssum += (y[0] * y[0] + y[1] * y[1]) + (y[2] * y[2] + y[3] * y[3]);
                    }
                ssum += __shfl_xor(ssum, 16); ssum += __shfl_xor(ssum, 32);
                if (fq == 0) ss2[(size_t)r * 16 + u.pn * 4 + wc] = ssum;
            }
    }
};
struct EpiGU {
    static constexpr bool PERM = true, AFTER_DRAIN = false, MIDSCALE = false;
    bf16_t* h; const float* ss2; int mid_t;
    __device__ __forceinline__ void midscale(f32x4 (&)[2][2][4][2], const Unit&, int, int) const {}
    __device__ __forceinline__ void operator()(const f32x4 (&acc)[2][2][4][2], const Unit& u, int wr, int wc, int fr, int fq) const {
#pragma unroll
        for (int ai = 0; ai < 2; ++ai)
#pragma unroll
            for (int m = 0; m < 4; ++m) {
                const int r = u.pm * BM + ai * HALF + wr * 64 + m * 16 + fr;
                const f32x4* sp = (const f32x4*)(ss2 + (size_t)r * 16); const f32x4 a = sp[0], b = sp[1], c = sp[2], d = sp[3];
                const f32x4 t = (a + b) + (c + d); const float s = (t[0] + t[1]) + (t[2] + t[3]);
                const float rs = __builtin_amdgcn_rsqf(s * (1.0f / 1024.0f) + RMS_EPS);
                const f32x4 g0 = acc[ai][0][m][0] * rs, g1 = acc[ai][0][m][1] * rs, u0 = acc[ai][1][m][0] * rs, u1 = acc[ai][1][m][1] * rs;
                float o[8];
#pragma unroll
                for (int j = 0; j < 4; ++j) { o[j] = fast_silu(g0[j]) * u0[j]; o[4 + j] = fast_silu(g1[j]) * u1[j]; }
                u32x4 w; w.x = cvt_pk_bf16(o[0], o[1]); w.y = cvt_pk_bf16(o[2], o[3]); w.z = cvt_pk_bf16(o[4], o[5]); w.w = cvt_pk_bf16(o[6], o[7]);
                *(u32x4*)(h + (size_t)r * DFF + u.pn * 128 + wc * 32 + 8 * fq) = w;
            }
    }
};
struct EpiDown {
    static constexpr bool PERM = false, AFTER_DRAIN = false, MIDSCALE = false;
    float* x1; float* ss3; int mid_t;
    __device__ __forceinline__ void midscale(f32x4 (&)[2][2][4][2], const Unit&, int, int) const {}
    __device__ __forceinline__ void operator()(const f32x4 (&acc)[2][2][4][2], const Unit& u, int wr, int wc, int fr, int fq) const {
#pragma unroll
        for (int ai = 0; ai < 2; ++ai)
#pragma unroll
            for (int m = 0; m < 4; ++m) {
                const int r = u.pm * BM + ai * HALF + wr * 64 + m * 16 + fr; float ssum = 0.f;
#pragma unroll
                for (int bj = 0; bj < 2; ++bj)
#pragma unroll
                    for (int n = 0; n < 2; ++n) {
                        const size_t off = (size_t)r * DM + u.pn * BM + bj * HALF + wc * 32 + n * 16 + 4 * fq;
                        const f32x4 y = *(const f32x4*)(x1 + off) + acc[ai][bj][m][n];
                        *(f32x4*)(x1 + off) = y;
                        ssum += (y[0] * y[0] + y[1] * y[1]) + (y[2] * y[2] + y[3] * y[3]);
                    }
                ssum += __shfl_xor(ssum, 16); ssum += __shfl_xor(ssum, 32);
                if (fq == 0) ss3[(size_t)r * 16 + u.pn * 4 + wc] = ssum;
            }
    }
};
template <class Epi, class Sched, bool ALIGN_EPI = false, bool SP2 = false>
__device__ __forceinline__ void gemm_phase(PG8_LAS unsigned char* lds, const Gemm g, const Sched& S, const Epi& E) {
    const int tid = threadIdx.x, wid = __builtin_amdgcn_readfirstlane(tid >> 6), lane = tid & 63, wr = wid >> 2, wc = wid & 3, fr = lane & 15, fq = lane >> 4;
    const int K = g.K, nt = K / BK;
    unsigned voffA[2], voffB[2];
#pragma unroll
    for (int i = 0; i < 2; ++i) { int R, C; stage_rc(tid * 16 + i * 8192, R, C); const int Rb = Epi::PERM ? ((R & ~31) + perm32(R & 31)) : R;
        voffA[i] = (unsigned)(R * K + C) * 2u; voffB[i] = (unsigned)(Rb * K + C) * 2u; }
    const size_t kstep = (size_t)(BK * 2);
    const size_t hstep = (size_t)HALF * K * 2;
    const size_t tstep = 2 * hstep;
    const unsigned ldsw = (unsigned)wid * 1024u;
    const int aoff = lds_byte(wr * 64 + fr, fq * 8), boff = lds_byte(wc * 32 + fr, fq * 8);
#define PG8_SA(b, h) (((b) * 2 + (h)) * HTB)
#define PG8_SB(b, h) ((4 + (b) * 2 + (h)) * HTB)
#define PG8_STAGE(bufoff, gbase, voff) do { _Pragma("unroll") for (int _i = 0; _i < 2; ++_i) \
        __builtin_amdgcn_global_load_lds((const unsigned*)((const char*)(gbase) + (voff)[_i]), (PG8_LAS unsigned*)(lds + (bufoff) + ldsw + _i * 8192), 16, 0, 0); } while (0)
#define PG8_LDA(dst, b, h) do { _Pragma("unroll") for (int m = 0; m < 4; ++m) _Pragma("unroll") for (int k = 0; k < 2; ++k) dst[m][k] = *(const PG8_LAS bf16x8*)(lds + PG8_SA(b, h) + aoff + m * 2048 + k * 1024); } while (0)
#define PG8_LDB(dst, b, h) do { _Pragma("unroll") for (int n = 0; n < 2; ++n) _Pragma("unroll") for (int k = 0; k < 2; ++k) dst[n][k] = *(const PG8_LAS bf16x8*)(lds + PG8_SB(b, h) + boff + n * 2048 + k * 1024); } while (0)
#define PG8_MMA(ai, bj, At, Bt) do { __builtin_amdgcn_s_setprio(1); _Pragma("unroll") for (int m = 0; m < 4; ++m) _Pragma("unroll") for (int n = 0; n < 2; ++n) _Pragma("unroll") for (int k = 0; k < 2; ++k) \
        acc[ai][bj][m][n] = __builtin_amdgcn_mfma_f32_16x16x32_bf16(Bt[n][k], At[m][k], acc[ai][bj][m][n], 0, 0, 0); __builtin_amdgcn_s_setprio(0); } while (0)
#define PG8_WAIT_V(n) asm volatile("s_waitcnt vmcnt(" #n ")" ::: "memory")
#define PG8_WAIT_L(n) asm volatile("s_waitcnt lgkmcnt(" #n ")" ::: "memory")
#define PG8_BAR __builtin_amdgcn_s_barrier()
#define PG8_SCHED __builtin_amdgcn_sched_barrier(0)
    Unit cur, nxt; int ui = 0;
    if (!S.next(0, cur)) return;
    f32x4 acc[2][2][4][2];
#pragma unroll
    for (int a = 0; a < 2; ++a)
#pragma unroll
        for (int b = 0; b < 2; ++b)
#pragma unroll
            for (int m = 0; m < 4; ++m)
#pragma unroll
                for (int n = 0; n < 2; ++n) acc[a][b][m][n] = (f32x4){0.f, 0.f, 0.f, 0.f};
    bf16x8 At[4][2], B0[2][2], B1[2][2];
    const char* cA = (const char*)g.A + (size_t)cur.pm * tstep; const char* cB = (const char*)g.Bt + (size_t)cur.pn * tstep;
    S.a_ready(cur);
    if constexpr (SP2) {
        PG8_STAGE(PG8_SB(0, 0), cB, voffB); PG8_STAGE(PG8_SB(0, 1), cB + hstep, voffB); PG8_STAGE(PG8_SA(0, 0), cA, voffA); PG8_STAGE(PG8_SA(0, 1), cA + hstep, voffA);
        if (wr == 1) PG8_BAR;
        PG8_WAIT_V(2); PG8_BAR;
        PG8_STAGE(PG8_SB(1, 0), cB + kstep, voffB); PG8_STAGE(PG8_SA(1, 0), cA + kstep, voffA); PG8_STAGE(PG8_SB(1, 1), cB + hstep + kstep, voffB);
        PG8_WAIT_V(6); PG8_BAR;
    } else {
        PG8_STAGE(PG8_SB(0, 0), cB, voffB); PG8_STAGE(PG8_SA(0, 0), cA, voffA); PG8_STAGE(PG8_SB(0, 1), cB + hstep, voffB); PG8_STAGE(PG8_SA(0, 1), cA + hstep, voffA);
        if (wr == 1) PG8_BAR;
        PG8_WAIT_V(4); PG8_BAR;
        PG8_STAGE(PG8_SB(1, 0), cB + kstep, voffB); PG8_STAGE(PG8_SA(1, 0), cA + kstep, voffA); PG8_STAGE(PG8_SB(1, 1), cB + hstep + kstep, voffB);
        PG8_WAIT_V(6); PG8_BAR;
    }
    for (;;) {
        const bool has_next = S.next(ui + 1, nxt);
        const char* nA = has_next ? (const char*)g.A + (size_t)nxt.pm * tstep : cA; const char* nB = has_next ? (const char*)g.Bt + (size_t)nxt.pn * tstep : cB;
        for (int t = 0; t < nt; t += 2) {
            const bool last = (t == nt - 2);
            if constexpr (Epi::MIDSCALE) { if (t == E.mid_t) E.midscale(acc, cur, wr, fr); }
            const char* a1 = cA + (size_t)(t + 1) * kstep;
            const char* a2 = last ? nA : cA + (size_t)(t + 2) * kstep; const char* b2 = last ? nB : cB + (size_t)(t + 2) * kstep;
            const char* a3 = a2 + kstep; const char* b3 = b2 + kstep;
            if (last && has_next) S.a_ready(nxt);
            if constexpr (SP2) {
            PG8_LDB(B0, 0, 0); PG8_LDB(B1, 0, 1); PG8_SCHED; PG8_LDA(At, 0, 0); PG8_STAGE(PG8_SA(1, 1), a1 + hstep, voffA);
            PG8_WAIT_V(8); PG8_WAIT_L(0); PG8_BAR; PG8_MMA(0, 0, At, B0); PG8_MMA(0, 1, At, B1); PG8_BAR; PG8_SCHED;
            PG8_LDA(At, 0, 1); PG8_STAGE(PG8_SB(0, 0), b2, voffB); PG8_STAGE(PG8_SB(0, 1), b2 + hstep, voffB); PG8_STAGE(PG8_SA(0, 0), a2, voffA);
            PG8_WAIT_V(8); PG8_WAIT_L(0); PG8_BAR; PG8_MMA(1, 0, At, B0); PG8_MMA(1, 1, At, B1); PG8_BAR; PG8_SCHED;
            PG8_LDB(B0, 1, 0); PG8_LDB(B1, 1, 1); PG8_SCHED; PG8_LDA(At, 1, 0); PG8_STAGE(PG8_SA(0, 1), a2 + hstep, voffA);
            PG8_WAIT_V(8); PG8_WAIT_L(0); PG8_BAR; PG8_MMA(0, 0, At, B0); PG8_MMA(0, 1, At, B1); PG8_BAR; PG8_SCHED;
            PG8_LDA(At, 1, 1); PG8_STAGE(PG8_SB(1, 0), b3, voffB); PG8_STAGE(PG8_SB(1, 1), b3 + hstep, voffB); PG8_STAGE(PG8_SA(1, 0), a3, voffA);
            PG8_WAIT_V(8); PG8_WAIT_L(0); PG8_BAR; PG8_MMA(1, 0, At, B0); PG8_MMA(1, 1, At, B1); PG8_BAR; PG8_SCHED;
            } else {
            PG8_LDB(B0, 0, 0); PG8_SCHED; PG8_LDA(At, 0, 0); PG8_STAGE(PG8_SA(1, 1), a1 + hstep, voffA);
            PG8_WAIT_L(8); PG8_BAR; PG8_WAIT_L(0); PG8_MMA(0, 0, At, B0); PG8_BAR; PG8_SCHED;
            PG8_LDB(B1, 0, 1); PG8_STAGE(PG8_SB(0, 0), b2, voffB);
            PG8_BAR; PG8_WAIT_L(0); PG8_MMA(0, 1, At, B1); PG8_BAR;
            PG8_LDA(At, 0, 1); PG8_STAGE(PG8_SA(0, 0), a2, voffA);
            PG8_BAR; PG8_WAIT_L(0); PG8_MMA(1, 0, At, B0); PG8_BAR; PG8_SCHED;
            PG8_STAGE(PG8_SB(0, 1), b2 + hstep, voffB);
            PG8_WAIT_V(6); PG8_BAR; PG8_MMA(1, 1, At, B1); PG8_BAR;
            PG8_LDB(B0, 1, 0); PG8_SCHED; PG8_LDA(At, 1, 0); PG8_STAGE(PG8_SA(0, 1), a2 + hstep, voffA);
            PG8_WAIT_L(8); PG8_BAR; PG8_WAIT_L(0); PG8_MMA(0, 0, At, B0); PG8_BAR; PG8_SCHED;
            PG8_LDB(B1, 1, 1); PG8_STAGE(PG8_SB(1, 0), b3, voffB);
            PG8_BAR; PG8_WAIT_L(0); PG8_MMA(0, 1, At, B1); PG8_BAR;
            PG8_LDA(At, 1, 1); PG8_STAGE(PG8_SA(1, 0), a3, voffA);
            PG8_BAR; PG8_WAIT_L(0); PG8_MMA(1, 0, At, B0); PG8_BAR; PG8_SCHED;
            PG8_STAGE(PG8_SB(1, 1), b3 + hstep, voffB);
            PG8_WAIT_V(6); PG8_BAR; PG8_MMA(1, 1, At, B1); PG8_BAR;
            }
        }
        if constexpr (ALIGN_EPI) { if (wr == 0) PG8_BAR; }
        if constexpr (!Epi::AFTER_DRAIN) { E(acc, cur, wr, wc, fr, fq); S.done(cur); }
        if (!has_next) break;
#pragma unroll
        for (int a = 0; a < 2; ++a)
#pragma unroll
            for (int b = 0; b < 2; ++b)
#pragma unroll
                for (int m = 0; m < 4; ++m)
#pragma unroll
                    for (int n = 0; n < 2; ++n) acc[a][b][m][n] = (f32x4){0.f, 0.f, 0.f, 0.f};
        cur = nxt; cA = nA; cB = nB; ++ui;
        if constexpr (ALIGN_EPI) { if (wr == 1) PG8_BAR; }
    }
    PG8_WAIT_V(0);
    if constexpr (!ALIGN_EPI) { if (wr == 0) PG8_BAR; }
    PG8_BAR;
    if constexpr (Epi::AFTER_DRAIN) { E.fused(acc, cur, wr, wc, fr, fq, lds, wid, lane); S.done(cur); }
#undef PG8_SA
#undef PG8_SB
#undef PG8_STAGE
#undef PG8_LDA
#undef PG8_LDB
#undef PG8_MMA
#undef PG8_WAIT_V
#undef PG8_WAIT_L
#undef PG8_BAR
#undef PG8_SCHED
}
}

#ifndef PG8_SP2
#define PG8_SP2 true
#endif

#define LAS __attribute__((address_space(3)))
#define XB_TMO      128
#define XB_XCNT(j)  (256  + 64 * (j))
#define XB_XSUB(j)  (1280 + 64 * (j))
#define XB_XGEN(j)  (2304 + 64 * (j))
#define XB_TOP      3328
#define XB_TOPGEN   3392
#define XCD_BAR_WORDS 3456
#define XB_SPIN_CAP (1u << 18)

__device__ __forceinline__ unsigned xb_ld(unsigned* p)              { return __hip_atomic_load(p, __ATOMIC_RELAXED, __HIP_MEMORY_SCOPE_AGENT); }
__device__ __forceinline__ unsigned xb_add(unsigned* p, unsigned v) { return __hip_atomic_fetch_add(p, v, __ATOMIC_RELAXED, __HIP_MEMORY_SCOPE_AGENT); }
__device__ __forceinline__ unsigned xb_xcc_id() { return (unsigned)__builtin_amdgcn_s_getreg((3 << 11) | 20) & 0xFu; }
#define XB_SPIN(cond, bar) do { unsigned _sp = 0; while (cond) { __builtin_amdgcn_s_sleep(1); \
    if ((++_sp & 255u) == 0u) { if (xb_ld(&(bar)[XB_TMO])) break; if (_sp > XB_SPIN_CAP) { atomicAdd(&(bar)[XB_TMO], 1u); break; } } } } while (0)

struct XcdBarrier {
    unsigned* bar; unsigned x;
    volatile LAS unsigned* st;
};

__device__ __forceinline__ XcdBarrier xcd_barrier_post(unsigned* bar, volatile LAS unsigned* st) {
    XcdBarrier b; b.bar = bar; b.x = xb_xcc_id(); b.st = st;
    if (threadIdx.x == 0) (void)xb_add(&bar[XB_XCNT(b.x)], 1u);
    return b;
}
__device__ __forceinline__ void xcd_barrier_complete(unsigned* bar, unsigned x, unsigned& nloc, unsigned& nx) {
    const unsigned G = gridDim.x * gridDim.y * gridDim.z;
    unsigned sum, cnt, mine, sp = 0u;
    for (;;) {
        sum = 0u; cnt = 0u; mine = 0u;
#pragma unroll
        for (unsigned j = 0; j < 16; ++j) { const unsigned c = xb_ld(&bar[XB_XCNT(j)]); sum += c; cnt += (c > 0u) ? 1u : 0u; mine = (j == x) ? c : mine; }
        if (sum == G) break;
        __builtin_amdgcn_s_sleep(1);
        if ((++sp & 255u) == 0u) { if (xb_ld(&bar[XB_TMO])) break; if (sp > XB_SPIN_CAP) { atomicAdd(&bar[XB_TMO], 1u); break; } }
    }
    nloc = mine > 0u ? mine : 1u; nx = cnt > 0u ? cnt : 1u;
}

__device__ __forceinline__ void xcd_barrier(const XcdBarrier& b) {
    asm volatile("s_waitcnt vmcnt(0)" ::: "memory");
    __syncthreads();
    if (threadIdx.x == 0) {
        unsigned* bar = b.bar;
        __builtin_amdgcn_s_waitcnt(0);
        unsigned nloc = b.st[0], nx = b.st[1];
        if (nloc == 0u) { xcd_barrier_complete(bar, b.x, nloc, nx); b.st[0] = nloc; b.st[1] = nx; }
        const unsigned old = xb_add(&bar[XB_XSUB(b.x)], 1u);
        const unsigned gen = old / nloc;
        if (old + 1u == (gen + 1u) * nloc) {
            __builtin_amdgcn_fence(__ATOMIC_RELEASE, "agent");
            asm volatile("s_waitcnt vmcnt(0)" ::: "memory");
            const unsigned og = xb_add(&bar[XB_TOP], 1u);
            const unsigned tg = og / nx;
            if (og + 1u == (tg + 1u) * nx) xb_add(&bar[XB_TOPGEN], 1u);
            else XB_SPIN(xb_ld(&bar[XB_TOPGEN]) == tg, bar);
            __builtin_amdgcn_fence(__ATOMIC_ACQUIRE, "agent");
            xb_add(&bar[XB_XGEN(b.x)], 1u);
            asm volatile("s_waitcnt vmcnt(0)" ::: "memory");
        } else {
            XB_SPIN(xb_ld(&bar[XB_XGEN(b.x)]) == gen, bar);
            __builtin_amdgcn_fence(__ATOMIC_ACQUIRE, "agent");
            asm volatile("s_waitcnt vmcnt(0)" ::: "memory");
        }
    }
    __syncthreads();
}

struct Args {
    const float* x; const int* positions; const float* norm1_g; const float* w_in; const float* cmp_pos; const float* cmp_w1; const float* cmp_w2;
    const float* nsa_norm_g; const float* conv_w; const float* a_log; const float* dt_bias; const float* gdn_norm_g; const float* w_out; const float* norm2_g;
    const float* w_gate; const float* w_up; const float* w_down; const float* final_g;
    float* out; unsigned char* ws; int ph_lo, ph_hi, flags, pad;
};

#ifndef LAS
#define LAS __attribute__((address_space(3)))
#endif
namespace nsa {
typedef float f32x16 __attribute__((ext_vector_type(16)));
typedef float f32x4 __attribute__((ext_vector_type(4)));
typedef float f32x2 __attribute__((ext_vector_type(2)));
typedef __bf16 bf16x2_t __attribute__((ext_vector_type(2)));
typedef short bf16x8 __attribute__((ext_vector_type(8)));
typedef short s16x4 __attribute__((ext_vector_type(4)));
typedef unsigned u32x4 __attribute__((ext_vector_type(4)));
typedef unsigned u32x2 __attribute__((ext_vector_type(2)));

constexpr int L_KV = 0, KV_STAGE = 16384;
constexpr int L_IMP = 32768;
constexpr int L_SELM = 65536;
constexpr int L_UNION = 65536 + 256;
constexpr int L_QUEUE = 65536 + 260;
constexpr int L_RED = 0;
constexpr int L_HT = 65536 + 512;
constexpr float NEG_INF = -__builtin_inff();

__device__ __forceinline__ int crow(int r, int hi) { return (r & 3) + 8 * (r >> 2) + 4 * hi; }
__device__ __forceinline__ unsigned cvtpk(float lo, float hi) { f32x2 v = {lo, hi}; bf16x2_t b = __builtin_convertvector(v, bf16x2_t); return __builtin_bit_cast(unsigned, b); }
__device__ __forceinline__ bf16x8 pack8(float a0, float a1, float a2, float a3, float a4, float a5, float a6, float a7) {
    u32x4 w; w.x = cvtpk(a0, a1); w.y = cvtpk(a2, a3); w.z = cvtpk(a4, a5); w.w = cvtpk(a6, a7); return __builtin_bit_cast(bf16x8, w); }
__device__ __forceinline__ void dma_tile(const unsigned char* gbase, size_t pitch, LAS unsigned char* dst, int wave, int lane) {
    const int row = wave * 8 + (lane >> 3); const int c = (lane & 7) ^ (lane >> 3);
    __builtin_amdgcn_global_load_lds((const unsigned*)(gbase + (size_t)row * pitch + c * 16), (LAS unsigned*)(dst + wave * 1024), 16, 0, 0);
}
typedef short v4i16_t __attribute__((ext_vector_type(4)));
__device__ __forceinline__ s16x4 vtr(LAS const unsigned char* p) { return __builtin_bit_cast(s16x4, __builtin_amdgcn_ds_read_tr16_b64_v4i16((LAS v4i16_t*)p)); }

__device__ __forceinline__ void qk_tile(f32x16& p0, f32x16& p1, LAS const unsigned char* kbuf, const bf16x8 (&qr)[4], int r32, int hi) {
    p0 = (f32x16){}; p1 = (f32x16){};
    LAS const unsigned char* k0 = kbuf + r32 * 128; const int sw = r32 & 7;
#pragma unroll
    for (int ds = 0; ds < 4; ++ds) {
        const int off = ((2 * ds + hi) ^ sw) << 4;
        const bf16x8 a0 = *(LAS const bf16x8*)(k0 + off), a1 = *(LAS const bf16x8*)(k0 + 4096 + off);
        p0 = __builtin_amdgcn_mfma_f32_32x32x16_bf16(a0, qr[ds], p0, 0, 0, 0);
        p1 = __builtin_amdgcn_mfma_f32_32x32x16_bf16(a1, qr[ds], p1, 0, 0, 0);
    }
}
__device__ __forceinline__ void pv_tile(f32x16 (&o)[2], LAS const unsigned char* vb0, LAS const unsigned char* vb1, const bf16x8 (&pb)[4]) {
#pragma unroll
    for (int ks = 0; ks < 4; ++ks) {
        { const s16x4 lo = vtr(vb0 + ks * 2048), hh = vtr(vb0 + ks * 2048 + 1024);
          const bf16x8 a = {lo[0], lo[1], lo[2], lo[3], hh[0], hh[1], hh[2], hh[3]};
          o[0] = __builtin_amdgcn_mfma_f32_32x32x16_bf16(a, pb[ks], o[0], 0, 0, 0); }
        { const s16x4 lo = vtr(vb1 + ks * 2048), hh = vtr(vb1 + ks * 2048 + 1024);
          const bf16x8 a = {lo[0], lo[1], lo[2], lo[3], hh[0], hh[1], hh[2], hh[3]};
          o[1] = __builtin_amdgcn_mfma_f32_32x32x16_bf16(a, pb[ks], o[1], 0, 0, 0); }
    }
}
__device__ __forceinline__ float max16(const f32x16& p) {
    float a = fmaxf(fmaxf(p[0], p[1]), fmaxf(p[2], p[3])), b = fmaxf(fmaxf(p[4], p[5]), fmaxf(p[6], p[7]));
    float c = fmaxf(fmaxf(p[8], p[9]), fmaxf(p[10], p[11])), d = fmaxf(fmaxf(p[12], p[13]), fmaxf(p[14], p[15]));
    return fmaxf(fmaxf(a, b), fmaxf(c, d));
}
__device__ __forceinline__ float sum16(const f32x16& p) {
    return (((p[0] + p[1]) + (p[2] + p[3])) + ((p[4] + p[5]) + (p[6] + p[7]))) + (((p[8] + p[9]) + (p[10] + p[11])) + ((p[12] + p[13]) + (p[14] + p[15])));
}
__device__ __forceinline__ void mask_tile(f32x16& p0, f32x16& p1, int key0, int hi, int lo, int hi_) {
#pragma unroll
    for (int r = 0; r < 16; ++r) { const int k = key0 + crow(r, hi);
        p0[r] = (k >= lo && k <= hi_) ? p0[r] : NEG_INF; p1[r] = (k + 32 >= lo && k + 32 <= hi_) ? p1[r] : NEG_INF; }
}
__device__ __forceinline__ void attn_tile(LAS const unsigned char* kbuf, LAS const unsigned char* vb0, LAS const unsigned char* vb1, const bf16x8 (&qr)[4],
                                          f32x16 (&o)[2], float& m, float& l, int key0, int lo, int hi_, bool domask, int r32, int hi) {
    f32x16 p0, p1; qk_tile(p0, p1, kbuf, qr, r32, hi);
    if (domask) mask_tile(p0, p1, key0, hi, lo, hi_);
    float mx = fmaxf(max16(p0), max16(p1)); mx = fmaxf(mx, __shfl_xor(mx, 32));
    const float mn = fmaxf(m, mx); const float alpha = __builtin_amdgcn_exp2f(m - mn); m = mn;
#pragma unroll
    for (int r = 0; r < 16; ++r) { p0[r] = __builtin_amdgcn_exp2f(p0[r] - mn); p1[r] = __builtin_amdgcn_exp2f(p1[r] - mn); }
    l = l * alpha + (sum16(p0) + sum16(p1));
    o[0] = o[0] * alpha; o[1] = o[1] * alpha;
    bf16x8 pb[4];
    pb[0] = pack8(p0[0], p0[1], p0[2], p0[3], p0[4], p0[5], p0[6], p0[7]); pb[1] = pack8(p0[8], p0[9], p0[10], p0[11], p0[12], p0[13], p0[14], p0[15]);
    pb[2] = pack8(p1[0], p1[1], p1[2], p1[3], p1[4], p1[5], p1[6], p1[7]); pb[3] = pack8(p1[8], p1[9], p1[10], p1[11], p1[12], p1[13], p1[14], p1[15]);
    pv_tile(o, vb0, vb1, pb);
}

__device__ __forceinline__ void attn_unit(unsigned char* ws, LAS unsigned char* lds, int b, int g, int qb, int wave, int lane) {
    const int tid = threadIdx.x, r32 = lane & 31, hi = lane >> 5, hh = wave >> 1, th = wave & 1, head = g * 4 + hh;
    const int tl = 32 * th + r32, t = 64 * qb + tl; const size_t m = (size_t)b * SEQ + t;
    const bf16_t* proj = (const bf16_t*)(ws + WS_PROJ);
    const unsigned char* pb_ = (const unsigned char*)(proj + (size_t)b * SEQ * PJ);
    LAS unsigned char* kv = lds + L_KV;
    LAS float* IMP = (LAS float*)(lds + L_IMP); LAS unsigned* SELM = (LAS unsigned*)(lds + L_SELM); LAS unsigned* UNI = (LAS unsigned*)(lds + L_UNION);
    const int gq = (lane & 15) >> 2, gp = lane & 3, x7 = 4 * hi + gq, clow = 2 * ((lane >> 4) & 1) + (gp >> 1);
    const int vo0 = x7 * 128 + (((0 + clow) ^ x7) << 4) + (gp & 1) * 8, vo1 = x7 * 128 + (((4 + clow) ^ x7) << 4) + (gp & 1) * 8;
    bf16x8 qr[4];
    { const bf16_t* qp = proj + m * PJ + PC_Q + head * 64 + 8 * hi;
#pragma unroll
      for (int ds = 0; ds < 4; ++ds) qr[ds] = *(const bf16x8*)(qp + 16 * ds); }
    const bf16_t* gp_ = proj + m * PJ + PC_GATE + head * 3;
    const float g_cmp = sigmf(bf2f(gp_[0])), g_slc = sigmf(bf2f(gp_[1])), g_win = sigmf(bf2f(gp_[2]));
    f32x16 outa[2]; outa[0] = (f32x16){}; outa[1] = (f32x16){};
    if (tid == 0) *UNI = 0u;
    {
        const bool two = qb >= 16;
        const unsigned char* kcb = ws + WS_KC + (size_t)(b * 2 + g) * 128 * 128; const unsigned char* vcb = ws + WS_VC + (size_t)(b * 2 + g) * 128 * 128;
        dma_tile(kcb, 128, kv, wave, lane); dma_tile(vcb, 128, kv + 8192, wave, lane);
        if (two) { dma_tile(kcb + 64 * 128, 128, kv + KV_STAGE, wave, lane); dma_tile(vcb + 64 * 128, 128, kv + KV_STAGE + 8192, wave, lane); }
        asm volatile("s_waitcnt vmcnt(0)" ::: "memory"); __syncthreads();
        f32x16 c00, c01, c10, c11;
        qk_tile(c00, c01, kv, qr, r32, hi);
        const int nmax = t >= 31 ? (((t - 31) >> 4) < 126 ? ((t - 31) >> 4) : 126) : -1;
        mask_tile(c00, c01, 0, hi, 0, nmax);
        if (two) { qk_tile(c10, c11, kv + KV_STAGE, qr, r32, hi); mask_tile(c10, c11, 64, hi, 0, nmax); }
        else { c10 = (f32x16){}; c11 = (f32x16){};
#pragma unroll
            for (int r = 0; r < 16; ++r) { c10[r] = NEG_INF; c11[r] = NEG_INF; } }
        float mx = fmaxf(fmaxf(max16(c00), max16(c01)), fmaxf(max16(c10), max16(c11))); mx = fmaxf(mx, __shfl_xor(mx, 32));
        mx = fmaxf(mx, -1e30f);
#pragma unroll
        for (int r = 0; r < 16; ++r) { c00[r] = __builtin_amdgcn_exp2f(c00[r] - mx); c01[r] = __builtin_amdgcn_exp2f(c01[r] - mx);
            c10[r] = __builtin_amdgcn_exp2f(c10[r] - mx); c11[r] = __builtin_amdgcn_exp2f(c11[r] - mx); }
        float ls = (sum16(c00) + sum16(c01)) + (sum16(c10) + sum16(c11)); ls += __shfl_xor(ls, 32);
        const float inv = ls > 0.f ? 1.0f / ls : 0.f;
        c00 = c00 * inv; c01 = c01 * inv; c10 = c10 * inv; c11 = c11 * inv;
        float Gv[16], Ev[16];
#pragma unroll
        for (int a = 0; a < 4; ++a) {
            Gv[a] = (c00[4 * a] + c00[4 * a + 1]) + (c00[4 * a + 2] + c00[4 * a + 3]); Ev[a] = c00[4 * a + 3];
            Gv[4 + a] = (c01[4 * a] + c01[4 * a + 1]) + (c01[4 * a + 2] + c01[4 * a + 3]); Ev[4 + a] = c01[4 * a + 3];
            Gv[8 + a] = (c10[4 * a] + c10[4 * a + 1]) + (c10[4 * a + 2] + c10[4 * a + 3]); Ev[8 + a] = c10[4 * a + 3];
            Gv[12 + a] = (c11[4 * a] + c11[4 * a + 1]) + (c11[4 * a + 2] + c11[4 * a + 3]); Ev[12 + a] = c11[4 * a + 3];
        }
        LAS float* ip = IMP + ((hh * 64 + tl) * 32) + hi;
#pragma unroll
        for (int a = 0; a < 16; ++a) {
            const float eprev = a > 0 ? Ev[a > 0 ? a - 1 : 0] : 0.f;
            const float send = hi ? eprev : Ev[a];
            const float recv = __shfl_xor(send, 32);
            ip[2 * a] = Gv[a] + recv;
        }
        f32x16 oc[2]; oc[0] = (f32x16){}; oc[1] = (f32x16){};
        { bf16x8 pb[4];
          pb[0] = pack8(c00[0], c00[1], c00[2], c00[3], c00[4], c00[5], c00[6], c00[7]); pb[1] = pack8(c00[8], c00[9], c00[10], c00[11], c00[12], c00[13], c00[14], c00[15]);
          pb[2] = pack8(c01[0], c01[1], c01[2], c01[3], c01[4], c01[5], c01[6], c01[7]); pb[3] = pack8(c01[8], c01[9], c01[10], c01[11], c01[12], c01[13], c01[14], c01[15]);
          pv_tile(oc, kv + 8192 + vo0, kv + 8192 + vo1, pb); }
        if (two) { bf16x8 pb[4];
          pb[0] = pack8(c10[0], c10[1], c10[2], c10[3], c10[4], c10[5], c10[6], c10[7]); pb[1] = pack8(c10[8], c10[9], c10[10], c10[11], c10[12], c10[13], c10[14], c10[15]);
          pb[2] = pack8(c11[0], c11[1], c11[2], c11[3], c11[4], c11[5], c11[6], c11[7]); pb[3] = pack8(c11[8], c11[9], c11[10], c11[11], c11[12], c11[13], c11[14], c11[15]);
          pv_tile(oc, kv + KV_STAGE + 8192 + vo0, kv + KV_STAGE + 8192 + vo1, pb); }
        outa[0] = oc[0] * g_cmp; outa[1] = oc[1] * g_cmp;
    }
    __syncthreads();
    {
        const int tok = 8 * wave + (lane >> 3), sub = lane & 7;
        f32x4 v = *(LAS const f32x4*)(IMP + (0 * 64 + tok) * 32 + 4 * sub);
        v = v + *(LAS const f32x4*)(IMP + (1 * 64 + tok) * 32 + 4 * sub);
        v = v + *(LAS const f32x4*)(IMP + (2 * 64 + tok) * 32 + 4 * sub);
        v = v + *(LAS const f32x4*)(IMP + (3 * 64 + tok) * 32 + 4 * sub);
        float sc[4];
#pragma unroll
        for (int i = 0; i < 4; ++i) { const int s = 4 * sub + i; const bool forced = (s == 0) || (s == qb) || (s == qb - 1);
            sc[i] = forced ? 1e9f : (s <= qb ? v[i] : -1e30f); }
        unsigned taken = 0u, mask = 0u;
#pragma unroll 1
        for (int round = 0; round < TOPN; ++round) {
            float bv = -3e38f; int bi = 64;
#pragma unroll
            for (int i = 0; i < 4; ++i) { const bool ok = !((taken >> i) & 1u) && sc[i] > bv; bv = ok ? sc[i] : bv; bi = ok ? 4 * sub + i : bi; }
#pragma unroll
            for (int off = 1; off < 8; off <<= 1) { const float ov = __shfl_xor(bv, off); const int oi = __shfl_xor(bi, off);
                const bool take = (ov > bv) || (ov == bv && oi < bi); bv = take ? ov : bv; bi = take ? oi : bi; }
            mask |= 1u << bi; if ((bi >> 2) == sub) taken |= 1u << (bi & 3);
        }
        if (sub == 0) SELM[tok] = mask;
        unsigned um = mask; um |= __shfl_xor(um, 8); um |= __shfl_xor(um, 16); um |= __shfl_xor(um, 32);
        if (lane == 0) atomicOr((unsigned*)UNI, um);
    }
    __syncthreads();
    const unsigned mysel = SELM[tl]; const unsigned uni = *UNI;
    {
        const int wlo = qb > 8 ? qb - 8 : 0;
        unsigned wrem = ((2u << qb) - 1u) & ~((1u << wlo) - 1u);
        unsigned srem = uni & ((2u << qb) - 1u);
        const unsigned char* kwin = pb_ + (size_t)(PC_KWIN + g * 64) * 2; const unsigned char* vwin = pb_ + (size_t)(PC_VWIN + g * 64) * 2;
        const unsigned char* kslc = pb_ + (size_t)(PC_KSLC + g * 64) * 2; const unsigned char* vslc = pb_ + (size_t)(PC_VSLC + g * 64) * 2;
        const size_t pitch = (size_t)PJ * 2;
        int cb = 0, cj = 0;
        if (wrem) { cb = 1; cj = __builtin_ctz(wrem); wrem &= wrem - 1; } else if (srem) { cb = 2; cj = __builtin_ctz(srem); srem &= srem - 1; }
        int st = 0;
        if (cb) { dma_tile((cb == 1 ? kwin : kslc) + (size_t)cj * 64 * pitch, pitch, kv, wave, lane); dma_tile((cb == 1 ? vwin : vslc) + (size_t)cj * 64 * pitch, pitch, kv + 8192, wave, lane); }
        f32x16 o[2]; o[0] = (f32x16){}; o[1] = (f32x16){}; float mrun = -1e30f, lrun = 0.f; int prevb = cb;
        while (cb) {
            int nb_ = 0, nj = 0;
            if (wrem) { nb_ = 1; nj = __builtin_ctz(wrem); wrem &= wrem - 1; } else if (srem) { nb_ = 2; nj = __builtin_ctz(srem); srem &= srem - 1; }
            asm volatile("s_waitcnt vmcnt(0)" ::: "memory"); __syncthreads();
            if (nb_) { LAS unsigned char* d = kv + (st ^ 1) * KV_STAGE;
                dma_tile((nb_ == 1 ? kwin : kslc) + (size_t)nj * 64 * pitch, pitch, d, wave, lane); dma_tile((nb_ == 1 ? vwin : vslc) + (size_t)nj * 64 * pitch, pitch, d + 8192, wave, lane); }
            if (cb != prevb) {
                float lt = lrun + __shfl_xor(lrun, 32); const float f = g_win / lt;
                outa[0] = outa[0] + o[0] * f; outa[1] = outa[1] + o[1] * f;
                o[0] = (f32x16){}; o[1] = (f32x16){}; mrun = -1e30f; lrun = 0.f; prevb = cb;
            }
            LAS const unsigned char* kb = kv + st * KV_STAGE; LAS const unsigned char* vb = kb + 8192;
            {
                bool run = true, domask; int lo_, hi2 = t;
                if (cb == 1) { domask = !((cj >= qb - 7) && (cj <= qb - 1)); lo_ = t - (WIN - 1); }
                else { const bool sel = (mysel >> cj) & 1u; const unsigned long long bal = __ballot(sel);
                    run = bal != 0ull; domask = !((cj < qb) && (bal == ~0ull)); lo_ = sel ? 0 : (1 << 30); }
                if (run) attn_tile(kb, vb + vo0, vb + vo1, qr, o, mrun, lrun, 64 * cj, lo_, hi2, domask, r32, hi);
            }
            cb = nb_; cj = nj; st ^= 1;
        }
        { float lt = lrun + __shfl_xor(lrun, 32); const float f = (prevb == 1 ? g_win : g_slc) / lt;
          outa[0] = outa[0] + o[0] * f; outa[1] = outa[1] + o[1] * f; }
    }
    {
        bf16_t* mp = (bf16_t*)(ws + WS_MIX) + m * DM + head * 64; float ss = 0.f;
#pragma unroll
        for (int dt = 0; dt < 2; ++dt)
#pragma unroll
            for (int a = 0; a < 4; ++a) {
                const float y0 = outa[dt][4 * a], y1 = outa[dt][4 * a + 1], y2 = outa[dt][4 * a + 2], y3 = outa[dt][4 * a + 3];
                ss += (y0 * y0 + y1 * y1) + (y2 * y2 + y3 * y3);
                u32x2 w; w.x = cvtpk(y0, y1); w.y = cvtpk(y2, y3);
                *(u32x2*)(mp + 32 * dt + 8 * a + 4 * hi) = w;
            }
        ss += __shfl_xor(ss, 32);
        if (hi == 0) ((float*)(ws + WS_SSQN))[m * 8 + head] = ss;
    }
    __syncthreads();
}

__device__ __forceinline__ void compress_unit(unsigned char* ws, const float* cmp_pos, LAS unsigned char* lds, int unit, int wave, int lane) {
    const int nt = unit & 7, g = (unit >> 3) & 1, b = (unit >> 4) & 15, i = unit >> 8;
    const int c = lane & 15, q = lane >> 4, n = 16 * nt + c;
    const bf16_t* proj = (const bf16_t*)(ws + WS_PROJ); const bf16_t* w1t = (const bf16_t*)(ws + WS_W1T) + (size_t)i * 128 * 2048;
    const bf16_t* w2t = (const bf16_t*)(ws + WS_W2T) + (size_t)i * 64 * 128;
    f32x4 acc[8];
#pragma unroll
    for (int jt = 0; jt < 8; ++jt) acc[jt] = (f32x4){0.f, 0.f, 0.f, 0.f};
#pragma unroll 2
    for (int s = 0; s < 8; ++s) {
        const int ks = 8 * wave + s, l = ks >> 1, d0 = (ks & 1) * 32 + 8 * q;
        const u32x4 xv = *(const u32x4*)(proj + (size_t)(b * SEQ + 16 * n + l) * PJ + (i ? PC_VCMP : PC_KCMP) + g * 64 + d0);
        const f32x4 pA = *(const f32x4*)(cmp_pos + i * 2048 + l * 64 + d0), pB = *(const f32x4*)(cmp_pos + i * 2048 + l * 64 + d0 + 4);
        const bf16x8 bfrag = pack8(__uint_as_float(xv.x << 16) + pA[0], __uint_as_float(xv.x & 0xffff0000u) + pA[1], __uint_as_float(xv.y << 16) + pA[2], __uint_as_float(xv.y & 0xffff0000u) + pA[3],
                                   __uint_as_float(xv.z << 16) + pB[0], __uint_as_float(xv.z & 0xffff0000u) + pB[1], __uint_as_float(xv.w << 16) + pB[2], __uint_as_float(xv.w & 0xffff0000u) + pB[3]);
#pragma unroll
        for (int jt = 0; jt < 8; ++jt) { const bf16x8 af = *(const bf16x8*)(w1t + (size_t)(16 * jt + c) * 2048 + 32 * ks + 8 * q);
            acc[jt] = __builtin_amdgcn_mfma_f32_16x16x32_bf16(af, bfrag, acc[jt], 0, 0, 0); }
    }
    LAS f32x4* RED = (LAS f32x4*)(lds + L_RED);
#pragma unroll
    for (int jt = 0; jt < 8; ++jt) RED[(wave * 8 + jt) * 64 + lane] = acc[jt];
    __syncthreads();
    f32x4 h = RED[(0 * 8 + wave) * 64 + lane];
#pragma unroll
    for (int w2 = 1; w2 < 8; ++w2) h = h + RED[(w2 * 8 + wave) * 64 + lane];
    LAS unsigned char* HT = lds + L_HT;
    { u32x2 w; w.x = cvtpk(siluf(h[0]), siluf(h[1])); w.y = cvtpk(siluf(h[2]), siluf(h[3])); *(LAS u32x2*)(HT + c * 256 + (16 * wave + 4 * q) * 2) = w; }
    __syncthreads();
    if (wave < 4) {
        f32x4 o2 = {0.f, 0.f, 0.f, 0.f};
#pragma unroll
        for (int s = 0; s < 4; ++s) { const bf16x8 bf = *(LAS const bf16x8*)(HT + c * 256 + (32 * s + 8 * q) * 2);
            const bf16x8 af = *(const bf16x8*)(w2t + (size_t)(16 * wave + c) * 128 + 32 * s + 8 * q);
            o2 = __builtin_amdgcn_mfma_f32_16x16x32_bf16(af, bf, o2, 0, 0, 0); }
        bf16_t* outp = (bf16_t*)(ws + (i ? WS_VC : WS_KC)) + ((size_t)(b * 2 + g) * 128 + n) * 64 + 16 * wave + 4 * q;
        u32x2 w; w.x = cvtpk(o2[0], o2[1]); w.y = cvtpk(o2[2], o2[3]); if (n == 127) { w.x = 0u; w.y = 0u; }
        *(u32x2*)outp = w;
    }
    __syncthreads();
}
}

namespace gdn {
typedef float f32x4 __attribute__((ext_vector_type(4)));
typedef short bf16x8 __attribute__((ext_vector_type(8)));
typedef unsigned u32x4 __attribute__((ext_vector_type(4)));
typedef unsigned u32x2 __attribute__((ext_vector_type(2)));
using nsa::cvtpk; using nsa::pack8;

constexpr int REC_W = 0, REC_QG = 16384, REC_KD = 32768, REC_QK = 49152, REC_BYTES = 57344;
constexpr int UREC_BYTES = 32768;
constexpr int NCHUNK = SEQ / 64;
constexpr int P_KR = 0, P_QR = 16384, P_STG = 32768, P_AT = 32768, P_QKI = 49152, P_SC = 67584, P_HALF = 69632;
constexpr int SLAB = 17408;
constexpr int SC_BETA = 0, SC_GC = 64, SC_EGC = 128, SC_EKD = 192, SC_RK2 = 256, SC_RQ2 = 320;
constexpr int S_BUF = 0, S_SSQ = 2 * REC_BYTES;

__device__ __forceinline__ int perm32pos(int kl) { return 8 * ((kl & 15) >> 2) + 4 * (kl >> 4) + (kl & 3); }
__device__ __forceinline__ int off256(int i, int k) { const int pos = perm32pos(k & 31), ch = 4 * (k >> 5) + (pos >> 3); return i * 256 + ((ch ^ (i & 15)) << 4) + (pos & 7) * 2; }
__device__ __forceinline__ int off128(int row, int j) { const int pos = perm32pos(j & 31), ch = 4 * (j >> 5) + (pos >> 3); return row * 128 + ((ch ^ (row & 7)) << 4) + (pos & 7) * 2; }
__device__ __forceinline__ float softplusf(float x) { return x > 20.f ? x : log1pf(__expf(x)); }

__device__ __forceinline__ void conv64(float (&y)[64], LAS const bf16_t* sp, const float* cw, int ch1536, bool first) {
    const float w0 = cw[ch1536], w1 = cw[1536 + ch1536], w2 = cw[2 * 1536 + ch1536], w3 = cw[3 * 1536 + ch1536];
    float x0 = first ? 0.f : bf2f(sp[0]), x1 = first ? 0.f : bf2f(sp[128]), x2 = first ? 0.f : bf2f(sp[256]);
#pragma unroll
    for (int i = 0; i < 64; ++i) { const float x3 = bf2f(sp[(i + 3) * 128]); y[i] = siluf(w0 * x0 + w1 * x1 + w2 * x2 + w3 * x3); x0 = x1; x1 = x2; x2 = x3; }
}
__device__ __forceinline__ void slab_dma(const bf16_t* projrow, const int* cols, int nmat, LAS unsigned char* stg, int w4, int lane) {
    for (int p = w4; p < 17 * nmat; p += 4) { const int mat = p / 17, pr = p % 17;
        __builtin_amdgcn_global_load_lds((const unsigned*)(projrow + (size_t)(4 * pr + (lane >> 4)) * PJ + cols[mat] + (lane & 15) * 8), (LAS unsigned*)(stg + mat * SLAB + pr * 1024), 16, 0, 0); }
}

__device__ __forceinline__ void prep_unit(const Args& a, LAS unsigned char* lds, int u, int wave, int lane) {
    unsigned char* ws = a.ws;
    int tid = threadIdx.x; asm volatile("" : "+v"(tid));
    lane = tid & 63;
    const int half = tid >> 8, c = tid & 255, w4 = wave & 3, fr = lane & 15, fq = lane >> 4;
    const int bh = u >> 4, b = bh >> 2, h = bh & 3, chunk = 2 * (u & 15) + half;
    LAS unsigned char* L = lds + half * P_HALF; LAS float* SC = (LAS float*)(L + P_SC); LAS float* AT = (LAS float*)(L + P_AT);
    const bf16_t* proj = (const bf16_t*)(ws + WS_PROJ); const size_t row0 = (size_t)b * SEQ + 64 * chunk;
    unsigned char* rec = (unsigned char*)a.out + (size_t)(bh * NCHUNK + chunk) * REC_BYTES;
    unsigned char* urec = ws + WS_XN + (size_t)(bh * NCHUNK + chunk) * UREC_BYTES;
    if (w4 == 0) {
        const bf16_t* pr = proj + (row0 + lane) * PJ;
        const float beta = sigmf(bf2f(pr[PC_B + h])); const float av = bf2f(pr[PC_A + h]) + a.dt_bias[h];
        float g = -__expf(a.a_log[h]) * softplusf(av);
#pragma unroll
        for (int o = 1; o < 64; o <<= 1) { const float up = __shfl_up(g, o); if (lane >= o) g += up; }
        const float glast = __shfl(g, 63);
        SC[SC_BETA + lane] = beta; SC[SC_GC + lane] = g; SC[SC_EGC + lane] = __expf(g); SC[SC_EKD + lane] = __expf(glast - g);
        if (lane == 63) ((float*)(ws + WS_GL))[bh * NCHUNK + chunk] = __expf(g);
    }
    float x[64];
    const int kc = c & 127;
    { const bf16_t* prow = proj + (row0 - 3) * PJ + h * 128; const int cols_qk[2] = {PC_GQ, PC_GK}; const int cols_v[2] = {PC_GV, PC_GV};
      slab_dma(prow, cols_qk, 2, L + P_STG, w4, lane);
      asm volatile("s_waitcnt vmcnt(0)" ::: "memory"); __syncthreads();
      const int pos = perm32pos(kc & 31), ch = 4 * (kc >> 5) + (pos >> 3), jb = (pos & 7) * 2;
      if (c < 128) { conv64(x, (LAS const bf16_t*)(L + P_STG) + kc, a.conv_w, h * 128 + kc, chunk == 0);
#pragma unroll
          for (int i = 0; i < 64; ++i) *(LAS bf16_t*)(L + P_QR + i * 256 + ((ch ^ (i & 15)) << 4) + jb) = f2bf(x[i]);
      } else { conv64(x, (LAS const bf16_t*)(L + P_STG + SLAB) + kc, a.conv_w, 512 + h * 128 + kc, chunk == 0);
#pragma unroll
          for (int i = 0; i < 64; ++i) { const bf16_t kb = f2bf(x[i]); *(LAS bf16_t*)(L + P_KR + i * 256 + ((ch ^ (i & 15)) << 4) + jb) = kb; x[i] = bf2f(kb); }
      }
      __syncthreads();
      slab_dma(prow, cols_v, 1, L + P_STG, w4, lane);
      asm volatile("s_waitcnt vmcnt(0)" ::: "memory"); __syncthreads();
      if (c < 128) conv64(x, (LAS const bf16_t*)(L + P_STG) + kc, a.conv_w, 1024 + h * 128 + kc, chunk == 0);
    }
    __syncthreads();
    f32x4 kk[4], qk[4], qq;
    {
        bf16x8 ak[4], aq[4];
        const int ri = 16 * w4 + fr;
#pragma unroll
        for (int s = 0; s < 4; ++s) { const int o = ri * 256 + (((4 * s + fq) ^ fr) << 4); ak[s] = *(LAS const bf16x8*)(L + P_KR + o); aq[s] = *(LAS const bf16x8*)(L + P_QR + o); }
        qq = (f32x4){0.f, 0.f, 0.f, 0.f};
#pragma unroll
        for (int s = 0; s < 4; ++s) qq = __builtin_amdgcn_mfma_f32_16x16x32_bf16(aq[s], aq[s], qq, 0, 0, 0);
#pragma unroll
        for (int nt = 0; nt < 4; ++nt) {
            kk[nt] = (f32x4){0.f, 0.f, 0.f, 0.f}; qk[nt] = (f32x4){0.f, 0.f, 0.f, 0.f};
            if (nt <= w4) {
                const int rj = 16 * nt + fr;
#pragma unroll
                for (int s = 0; s < 4; ++s) { const bf16x8 bk = *(LAS const bf16x8*)(L + P_KR + rj * 256 + (((4 * s + fq) ^ fr) << 4));
                    kk[nt] = __builtin_amdgcn_mfma_f32_16x16x32_bf16(ak[s], bk, kk[nt], 0, 0, 0);
                    qk[nt] = __builtin_amdgcn_mfma_f32_16x16x32_bf16(aq[s], bk, qk[nt], 0, 0, 0); }
            }
        }
#pragma unroll
        for (int nt = 0; nt < 4; ++nt) if (nt == w4) {
#pragma unroll
            for (int r = 0; r < 4; ++r) if (fr == 4 * fq + r) { SC[SC_RK2 + 16 * w4 + fr] = kk[nt][r]; SC[SC_RQ2 + 16 * w4 + fr] = qq[r]; } }
    }
    __syncthreads();
    {
#pragma unroll
        for (int nt = 0; nt < 4; ++nt) {
            const int j = 16 * nt + fr; const float rkj = rsqrtf(SC[SC_RK2 + j] + RMS_EPS), gcj = SC[SC_GC + j];
            f32x4 av; float qv[4];
#pragma unroll
            for (int r = 0; r < 4; ++r) { const int i = 16 * w4 + 4 * fq + r; const float gci = SC[SC_GC + i];
                const float dec = __expf(fminf(gci - gcj, 0.f));
                const float rki = rsqrtf(SC[SC_RK2 + i] + RMS_EPS), rqi = rsqrtf(SC[SC_RQ2 + i] + RMS_EPS);
                av[r] = (nt <= w4 && j < i) ? SC[SC_BETA + i] * kk[nt][r] * rki * rkj * dec : 0.f;
                qv[r] = (nt <= w4 && j <= i) ? qk[nt][r] * rqi * rkj * 0.08838834764831845f * dec : 0.f; }
            *(LAS f32x4*)(AT + j * 64 + 16 * w4 + 4 * fq) = av;
#pragma unroll
            for (int r = 0; r < 4; ++r) { const int i = 16 * w4 + 4 * fq + r; *(LAS bf16_t*)(L + P_QKI + off128(i, j)) = f2bf(qv[r]); }
        }
        if (c >= 128) {
#define KDV(j) (x[j] * SC[SC_EKD + (j)] * rsqrtf(SC[SC_RK2 + (j)] + RMS_EPS))
#pragma unroll
            for (int ch = 0; ch < 8; ++ch) { const int j0 = 32 * (ch >> 2) + 4 * (ch & 3);
                const bf16x8 v = pack8(KDV(j0), KDV(j0 + 1), KDV(j0 + 2), KDV(j0 + 3), KDV(j0 + 16), KDV(j0 + 17), KDV(j0 + 18), KDV(j0 + 19));
                *(bf16x8*)(rec + REC_KD + kc * 128 + ((ch ^ (kc & 7)) << 4)) = v; }
#undef KDV
#pragma unroll
            for (int i = 0; i < 64; ++i) x[i] = x[i] * SC[SC_BETA + i] * SC[SC_EGC + i] * rsqrtf(SC[SC_RK2 + i] + RMS_EPS);
        } else {
#pragma unroll
            for (int i = 0; i < 64; ++i) x[i] = x[i] * SC[SC_BETA + i];
        }
        { const int i = c >> 2; const float f = rsqrtf(SC[SC_RQ2 + i] + RMS_EPS) * 0.08838834764831845f * SC[SC_EGC + i];
#pragma unroll
          for (int cc = 0; cc < 4; ++cc) { const int o = i * 256 + ((4 * (c & 3) + cc) << 4);
              const u32x4 v = *(LAS const u32x4*)(L + P_QR + o);
              const bf16x8 w = pack8(__uint_as_float(v.x << 16) * f, __uint_as_float(v.x & 0xffff0000u) * f, __uint_as_float(v.y << 16) * f, __uint_as_float(v.y & 0xffff0000u) * f,
                                     __uint_as_float(v.z << 16) * f, __uint_as_float(v.z & 0xffff0000u) * f, __uint_as_float(v.w << 16) * f, __uint_as_float(v.w & 0xffff0000u) * f);
              *(bf16x8*)(rec + REC_QG + o) = w; } }
    }
    __syncthreads();
    {
        const LAS f32x4* AT4 = (const LAS f32x4*)AT;
#pragma unroll
        for (int j = 0; j < 63; ++j) {
            const float xj = x[j];
#pragma unroll
            for (int i4 = (j + 1) / 4; i4 < 16; ++i4) { const f32x4 av = AT4[j * 16 + i4];
#pragma unroll
                for (int r = 0; r < 4; ++r) if (4 * i4 + r > j) x[4 * i4 + r] -= av[r] * xj; }
            __builtin_amdgcn_sched_barrier(0);
        }
#pragma unroll
        for (int cc = 0; cc < 2; ++cc) { const int o = (c * 2 + cc) * 16; *(u32x4*)(rec + REC_QK + o) = *(LAS const u32x4*)(L + P_QKI + o); }
        if (c < 128) {
            const int wv = kc >> 4, cc = kc & 15;
#pragma unroll
            for (int it = 0; it < 4; ++it)
#pragma unroll
                for (int q = 0; q < 4; ++q) { const int i0 = 16 * it + 4 * q;
                    *(f32x4*)(urec + (size_t)(((wv * 4 + it) * 64) + q * 16 + cc) * 16) = (f32x4){x[i0], x[i0 + 1], x[i0 + 2], x[i0 + 3]}; }
        } else {
            const int pos = perm32pos(kc & 31), ch = 4 * (kc >> 5) + (pos >> 3), jb = (pos & 7) * 2;
#pragma unroll
            for (int i = 0; i < 64; ++i) *(LAS bf16_t*)(L + P_KR + i * 256 + ((ch ^ (i & 15)) << 4) + jb) = f2bf(-x[i]);
        }
    }
    __syncthreads();
#pragma unroll
    for (int cc = 0; cc < 4; ++cc) { const int o = (c * 4 + cc) * 16; *(u32x4*)(rec + REC_W + o) = *(LAS const u32x4*)(L + P_KR + o); }
    __syncthreads();
}

__device__ __forceinline__ void scan_unit(const Args& a, LAS unsigned char* lds, int bh, int wave, int lane) {
    unsigned char* ws = a.ws;
    const int b = bh >> 2, h = bh & 3, fr = lane & 15, fq = lane >> 4;
    const unsigned char* recb = (const unsigned char*)a.out + (size_t)bh * NCHUNK * REC_BYTES;
    const unsigned char* urecb = ws + WS_XN + (size_t)bh * NCHUNK * UREC_BYTES;
    const float* gl = (const float*)(ws + WS_GL) + bh * NCHUNK;
    const bf16_t* proj = (const bf16_t*)(ws + WS_PROJ); bf16_t* mix = (bf16_t*)(ws + WS_MIX);
    const float ng = a.gdn_norm_g[16 * wave + fr];
    f32x4 S[8];
#pragma unroll
    for (int kt = 0; kt < 8; ++kt) S[kt] = (f32x4){0.f, 0.f, 0.f, 0.f};
#pragma unroll
    for (int p = 0; p < 7; ++p) __builtin_amdgcn_global_load_lds((const unsigned*)(recb + (size_t)(wave + 8 * p) * 1024 + lane * 16), (LAS unsigned*)(lds + S_BUF + (wave + 8 * p) * 1024), 16, 0, 0);
    for (int ck = 0; ck < NCHUNK; ++ck) {
        LAS const unsigned char* buf = lds + S_BUF + (ck & 1) * REC_BYTES;
        asm volatile("s_waitcnt vmcnt(0)" ::: "memory"); __syncthreads();
        if (ck + 1 < NCHUNK) { const unsigned char* src = recb + (size_t)(ck + 1) * REC_BYTES; LAS unsigned char* dst = lds + S_BUF + ((ck + 1) & 1) * REC_BYTES;
#pragma unroll
            for (int p = 0; p < 7; ++p) __builtin_amdgcn_global_load_lds((const unsigned*)(src + (size_t)(wave + 8 * p) * 1024 + lane * 16), (LAS unsigned*)(dst + (wave + 8 * p) * 1024), 16, 0, 0); }
        const f32x4* up = (const f32x4*)(urecb + (size_t)ck * UREC_BYTES) + (wave * 4) * 64 + lane;
        f32x4 av[4], ao[4];
#pragma unroll
        for (int it = 0; it < 4; ++it) { av[it] = up[it * 64]; ao[it] = (f32x4){0.f, 0.f, 0.f, 0.f}; }
        const float egl = gl[ck];
        float zv[16];
        { const bf16_t* zp = proj + ((size_t)b * SEQ + 64 * ck) * PJ + PC_Z + h * 128 + 16 * wave + fr;
#pragma unroll
          for (int it = 0; it < 4; ++it)
#pragma unroll
              for (int r = 0; r < 4; ++r) zv[4 * it + r] = bf2f(zp[(size_t)(16 * it + 4 * fq + r) * PJ]); }
        bf16x8 Sb[4];
#pragma unroll
        for (int s = 0; s < 4; ++s) Sb[s] = pack8(S[2 * s][0], S[2 * s][1], S[2 * s][2], S[2 * s][3], S[2 * s + 1][0], S[2 * s + 1][1], S[2 * s + 1][2], S[2 * s + 1][3]);
#pragma unroll
        for (int it = 0; it < 4; ++it) { const int o = (16 * it + fr) * 256;
#pragma unroll
            for (int s = 0; s < 4; ++s) { const int co = ((4 * s + fq) ^ fr) << 4;
                av[it] = __builtin_amdgcn_mfma_f32_16x16x32_bf16(*(LAS const bf16x8*)(buf + REC_W + o + co), Sb[s], av[it], 0, 0, 0);
                ao[it] = __builtin_amdgcn_mfma_f32_16x16x32_bf16(*(LAS const bf16x8*)(buf + REC_QG + o + co), Sb[s], ao[it], 0, 0, 0); } }
        bf16x8 vb[2];
#pragma unroll
        for (int s = 0; s < 2; ++s) vb[s] = pack8(av[2 * s][0], av[2 * s][1], av[2 * s][2], av[2 * s][3], av[2 * s + 1][0], av[2 * s + 1][1], av[2 * s + 1][2], av[2 * s + 1][3]);
#pragma unroll
        for (int it = 0; it < 4; ++it) { const int o = (16 * it + fr) * 128;
#pragma unroll
            for (int s = 0; s < 2; ++s) ao[it] = __builtin_amdgcn_mfma_f32_16x16x32_bf16(*(LAS const bf16x8*)(buf + REC_QK + o + (((4 * s + fq) ^ (fr & 7)) << 4)), vb[s], ao[it], 0, 0, 0); }
#pragma unroll
        for (int kt = 0; kt < 8; ++kt) { S[kt] = S[kt] * egl; const int o = (16 * kt + fr) * 128;
#pragma unroll
            for (int s = 0; s < 2; ++s) S[kt] = __builtin_amdgcn_mfma_f32_16x16x32_bf16(*(LAS const bf16x8*)(buf + REC_KD + o + (((4 * s + fq) ^ (fr & 7)) << 4)), vb[s], S[kt], 0, 0, 0); }
        LAS float* SSQ = (LAS float*)(lds + S_SSQ) + (ck & 1) * 512;
#pragma unroll
        for (int it = 0; it < 4; ++it)
#pragma unroll
            for (int r = 0; r < 4; ++r) { float s2 = ao[it][r] * ao[it][r]; s2 += __shfl_xor(s2, 1); s2 += __shfl_xor(s2, 2); s2 += __shfl_xor(s2, 4); s2 += __shfl_xor(s2, 8);
                if (fr == 0) SSQ[(16 * it + 4 * fq + r) * 8 + wave] = s2; }
        __syncthreads();
#pragma unroll
        for (int it = 0; it < 4; ++it)
#pragma unroll
            for (int r = 0; r < 4; ++r) { const int i = 16 * it + 4 * fq + r; const f32x4 p0 = *(LAS const f32x4*)(SSQ + i * 8), p1 = *(LAS const f32x4*)(SSQ + i * 8 + 4);
                const float tot = ((p0[0] + p0[1]) + (p0[2] + p0[3])) + ((p1[0] + p1[1]) + (p1[2] + p1[3]));
                const float rs = rsqrtf(tot * (1.f / 128.f) + RMS_EPS);
                mix[((size_t)b * SEQ + 64 * ck + i) * DM + 512 + h * 128 + 16 * wave + fr] = f2bf(ao[it][r] * rs * ng * siluf(zv[4 * it + r])); }
    }
    __syncthreads();
}
}

#ifndef PG8_ALIGN
#define PG8_ALIGN true
#endif
constexpr int NWAVES = 8;
constexpr int RING_BYTES = 131072;
constexpr int MISC_OFF = 147456 - 512;
constexpr int LDS_BYTES = 147456;
#ifndef LAS
#define LAS __attribute__((address_space(3)))
#endif
#define GAS __attribute__((address_space(1)))
typedef unsigned v4u __attribute__((ext_vector_type(4)));
typedef float f32x4 __attribute__((ext_vector_type(4)));
#define LDS_WAIT() asm volatile("s_waitcnt lgkmcnt(0)" ::: "memory")
#define VM_WAIT() asm volatile("s_waitcnt vmcnt(0)" ::: "memory")
constexpr int CW_BAR = 4096, CW_QUEUE = 8192;


__device__ __forceinline__ unsigned pk2(float lo, float hi) { return (unsigned)f2bf(lo) | ((unsigned)f2bf(hi) << 16); }
__device__ __forceinline__ void p0_transpose_item(const float* colp, int ld, const float* gain, int gain_n, int K, bf16_t* WT, LAS float* scr, int k0, int n0, int lane) {
#pragma unroll 8
    for (int i = 0; i < 32; ++i) { const int kk = 2 * i + (lane >> 5); float v = 0.f;
        if (colp) { v = colp[(size_t)(k0 + kk) * ld]; if (gain && (k0 + kk) < gain_n) v *= gain[k0 + kk]; }
        scr[kk * 33 + (lane & 31)] = v; }
    LDS_WAIT(); asm volatile("" ::: "memory");
    const int c = lane & 7;
#pragma unroll
    for (int j = 0; j < 4; ++j) { const int n = (lane >> 3) + 8 * j; const LAS float* s = scr + (8 * c) * 33 + n;
        v4u o; o.x = pk2(s[0 * 33], s[1 * 33]); o.y = pk2(s[2 * 33], s[3 * 33]); o.z = pk2(s[4 * 33], s[5 * 33]); o.w = pk2(s[6 * 33], s[7 * 33]);
        *(v4u*)(WT + (size_t)(n0 + n) * K + k0 + 8 * c) = o; }
    LDS_WAIT(); asm volatile("" ::: "memory");
}
__device__ __forceinline__ void p0_prologue(const Args& a, LAS unsigned char* lds, int vcu, int G, int wave, int lane) {
    unsigned char* ws = a.ws;
    LAS float* scr = (LAS float*)(lds + wave * 16384);
    const int gw = vcu * NWAVES + wave, NGW = G * NWAVES;
    constexpr int I_IN = 16 * (PJ / 32), I_OUT = 16 * 32, I_GU = 16 * (2 * DFF / 32), I_DN = (DFF / 64) * 32, I_W1 = 2 * 32 * 4, I_W2 = 2 * 2 * 2;
    constexpr int NITEMS = I_IN + I_OUT + I_GU + I_DN + I_W1 + I_W2;
    for (int it = gw; it < NITEMS; it += NGW) {
        int r = it;
        if (r < I_IN) { const int nblk = PJ / 32, kb = r / nblk, nb = r % nblk; const int n = nb * 32 + (lane & 31); const int oc = win_orig_col(n);
            p0_transpose_item(oc < 0 ? nullptr : a.w_in + oc, IN_W, nullptr, 0, DM, (bf16_t*)(ws + WS_WIN), scr, kb * 64, nb * 32, lane); continue; } r -= I_IN;
        if (r < I_OUT) { const int kb = r / 32, nb = r % 32; const int n = nb * 32 + (lane & 31);
            p0_transpose_item(a.w_out + n, DM, a.nsa_norm_g, 512, DM, (bf16_t*)(ws + WS_WOUT), scr, kb * 64, nb * 32, lane); continue; } r -= I_OUT;
        if (r < I_GU) { const int nblk = 2 * DFF / 32, kb = r / nblk, nb = r % nblk; const int n = nb * 32 + (lane & 31); const int pn = n >> 8, wi = n & 255;
            const float* W = (wi < 128) ? a.w_gate : a.w_up;
            p0_transpose_item(W + pn * 128 + (wi & 127), DFF, a.norm2_g, DM, DM, (bf16_t*)(ws + WS_WGU), scr, kb * 64, nb * 32, lane); continue; } r -= I_GU;
        if (r < I_DN) { const int kb = r / 32, nb = r % 32; const int n = nb * 32 + (lane & 31);
            p0_transpose_item(a.w_down + n, DM, nullptr, 0, DFF, (bf16_t*)(ws + WS_WDN), scr, kb * 64, nb * 32, lane); continue; } r -= I_DN;
        if (r < I_W1) { const int i = r / 128, rr = r % 128, kb = rr / 4, nb = rr % 4; const int n = nb * 32 + (lane & 31);
            p0_transpose_item(a.cmp_w1 + (size_t)i * 2048 * 128 + n, 128, nullptr, 0, 2048, (bf16_t*)(ws + WS_W1T) + (size_t)i * 128 * 2048, scr, kb * 64, nb * 32, lane); continue; } r -= I_W1;
        { const int i = r / 4, rr = r % 4, kb = rr / 2, nb = rr % 2; const int n = nb * 32 + (lane & 31);
            p0_transpose_item(a.cmp_w2 + (size_t)i * 128 * 64 + n, 64, nullptr, 0, 128, (bf16_t*)(ws + WS_W2T) + (size_t)i * 64 * 128, scr, kb * 64, nb * 32, lane); }
    }
    bf16_t* xn = (bf16_t*)(ws + WS_XN);
    for (int m = gw; m < MTOK; m += NGW) {
        const f32x4* xr = (const f32x4*)(a.x + (size_t)m * DM) + lane;
        f32x4 v[4]; float s = 0.f;
#pragma unroll
        for (int j = 0; j < 4; ++j) { v[j] = xr[64 * j]; s += (v[j].x * v[j].x + v[j].y * v[j].y) + (v[j].z * v[j].z + v[j].w * v[j].w); }
        s = wave_sum(s); const float rstd = rsqrtf(s * (1.f / DM) + RMS_EPS);
        unsigned long long* o8 = (unsigned long long*)(xn + (size_t)m * DM) + lane;
#pragma unroll
        for (int j = 0; j < 4; ++j) { const f32x4 gg = *((const f32x4*)a.norm1_g + lane + 64 * j);
            o8[64 * j] = (unsigned long long)pk2(v[j].x * rstd * gg.x, v[j].y * rstd * gg.y) | ((unsigned long long)pk2(v[j].z * rstd * gg.z, v[j].w * rstd * gg.w) << 32); }
    }
    float* tab = (float*)(ws + WS_ROPE);
    for (int i = gw * 64 + lane; i < MTOK * 8; i += NGW * 64) {
        const int m = i >> 3, f = i & 7;
        const float inv = powf(500000.0f, -(float)f * (2.0f / 16.0f));
        const float ang = (float)a.positions[m] * inv;
        tab[m * 16 + f] = cosf(ang); tab[m * 16 + 8 + f] = sinf(ang);
    }
}
__device__ __forceinline__ void p7_final(const Args& a, int vcu, int G, int wave, int lane) {
    const int gw = vcu * NWAVES + wave, NGW = G * NWAVES; const float* ss = (const float*)(a.ws + WS_SS3);
    for (int m = gw; m < MTOK; m += NGW) {
        const f32x4* sp = (const f32x4*)(ss + (size_t)m * 16); const f32x4 t = (sp[0] + sp[1]) + (sp[2] + sp[3]);
        const float rstd = rsqrtf(((t[0] + t[1]) + (t[2] + t[3])) * (1.f / DM) + RMS_EPS);
        f32x4* xr = (f32x4*)(a.out + (size_t)m * DM) + lane;
#pragma unroll
        for (int j = 0; j < 4; ++j) { const f32x4 gg = *((const f32x4*)a.final_g + lane + 64 * j); xr[64 * j] = xr[64 * j] * rstd * gg; }
    }
}

__global__ void __launch_bounds__(NWAVES * 64, 2) mk_fwd(Args args) {
    extern __shared__ __attribute__((aligned(16))) unsigned char lds_raw[];
    LAS unsigned char* lds = (LAS unsigned char*)lds_raw;
    volatile LAS unsigned* MISC = (volatile LAS unsigned*)(lds + MISC_OFF);
    const int tid = threadIdx.x, lane = tid & 63, wave = __builtin_amdgcn_readfirstlane(tid >> 6);
    const int G = gridDim.x; const int bx = blockIdx.x; const int vcu = (G % 8 == 0) ? (bx % 8) * (G / 8) + bx / 8 : bx;
    unsigned char* ws = args.ws;
    for (int u = tid; u < (LDS_BYTES - MISC_OFF) / 4; u += NWAVES * 64) ((LAS unsigned*)(lds + MISC_OFF))[u] = 0u;
    __syncthreads();
    const int lo = args.ph_lo, hi = args.ph_hi;
    const bool multi = (hi - lo) > 1;
    XcdBarrier bar; bar.bar = (unsigned*)(ws + WS_CTL) + CW_BAR; bar.x = 0; bar.st = nullptr;
    if (multi) bar = xcd_barrier_post((unsigned*)(ws + WS_CTL) + CW_BAR, MISC + 8);
#define IN(k) (lo <= (k) && (k) < hi)
#define REPB(k)
#define REPE
#define SEAM(k) do { if (IN(k) && IN((k) + 1)) xcd_barrier(bar); } while (0)
    if (IN(0)) { REPB(0) p0_prologue(args, lds, vcu, G, wave, lane); REPE SEAM(0); }
    if (IN(1)) { REPB(1)
        pg8::Gemm g{(const bf16_t*)(ws + WS_XN), (const bf16_t*)(ws + WS_WIN), MTOK, PJ, DM}; pg8::StaticOrder S; S.init(MTOK, PJ, G, bx);
        pg8::EpiProj E{(bf16_t*)(ws + WS_PROJ), (const float*)(ws + WS_ROPE), -1};
        pg8::gemm_phase<pg8::EpiProj, pg8::StaticOrder, PG8_ALIGN, PG8_SP2>(lds, g, S, E);
        REPE SEAM(1);
    }
    if (IN(2)) { REPB(2)
        if (!(args.flags & 1)) for (int u = vcu; u < 512; u += G) nsa::compress_unit(ws, args.cmp_pos, lds, u, wave, lane);
        if (!(args.flags & 2)) for (int u = vcu; u < 1024; u += G) gdn::prep_unit(args, lds, u, wave, lane);
        REPE SEAM(2);
    }
    if (IN(3)) { REPB(3)
        if (vcu < BATCH * GH) gdn::scan_unit(args, lds, vcu, wave, lane);
        unsigned* qctr = (unsigned*)(ws + WS_CTL) + CW_QUEUE; LAS int* QW = (LAS int*)(lds + nsa::L_QUEUE);
        for (;;) {
            if (tid == 0) *QW = (int)atomicAdd(qctr, 1u);
            __syncthreads();
            const int u = *QW;
            if (u >= 1024) break;
            nsa::attn_unit(ws, lds, (u & 31) >> 1, u & 1, 31 - (u >> 5), wave, lane);
        }
        REPE SEAM(3);
    }
    if (IN(4)) { REPB(4)
        pg8::Gemm g{(const bf16_t*)(ws + WS_MIX), (const bf16_t*)(ws + WS_WOUT), MTOK, DM, DM}; pg8::StaticOrder S; S.init(MTOK, DM, G, bx);
        pg8::EpiOut E{args.x, args.out, (bf16_t*)(ws + WS_XN), (float*)(ws + WS_SS2), (const float*)(ws + WS_SSQN), 8};
        pg8::gemm_phase<pg8::EpiOut, pg8::StaticOrder, PG8_ALIGN, PG8_SP2>(lds, g, S, E);
        REPE SEAM(4);
    }
    if (IN(5)) { REPB(5)
        pg8::Gemm g{(const bf16_t*)(ws + WS_XN), (const bf16_t*)(ws + WS_WGU), MTOK, 2 * DFF, DM}; pg8::StaticOrder S; S.init(MTOK, 2 * DFF, G, bx);
        pg8::EpiGU E{(bf16_t*)(ws + WS_PROJ), (const float*)(ws + WS_SS2), -1};
        pg8::gemm_phase<pg8::EpiGU, pg8::StaticOrder, PG8_ALIGN, PG8_SP2>(lds, g, S, E);
        REPE SEAM(5);
    }
    if (IN(6)) {
        pg8::Gemm g{(const bf16_t*)(ws + WS_PROJ), (const bf16_t*)(ws + WS_WDN), MTOK, DM, DFF}; pg8::StaticOrder S; S.init(MTOK, DM, G, bx);
        pg8::EpiDown E{args.out, (float*)(ws + WS_SS3), -1};
        pg8::gemm_phase<pg8::EpiDown, pg8::StaticOrder, PG8_ALIGN, PG8_SP2>(lds, g, S, E);
        SEAM(6);
    }
    if (IN(7)) p7_final(args, vcu, G, wave, lane);
#undef IN
#undef SEAM
}

extern "C" void kernel_launch(void* const* d_in, const int* in_sizes, int n_in, void* d_out, int out_size, void* d_ws, size_t ws_size, hipStream_t stream) {
    static int grid = 0;
    if (grid == 0) {
        if (n_in != 18 || ws_size < WS_END) { fprintf(stderr, "kernel_launch: unexpected inputs / workspace (%d, %zu)\n", n_in, ws_size); grid = -1; return; }
        int dev = 0, cus = 0;
        if (hipGetDevice(&dev) != hipSuccess || hipDeviceGetAttribute(&cus, hipDeviceAttributeMultiprocessorCount, dev) != hipSuccess) { grid = -1; return; }
        if (hipFuncSetAttribute((const void*)mk_fwd, hipFuncAttributeMaxDynamicSharedMemorySize, LDS_BYTES) != hipSuccess) { fprintf(stderr, "kernel_launch: hipFuncSetAttribute failed\n"); grid = -1; return; }
        (void)hipGetLastError();
        grid = cus;
    }
    if (grid < 0) return;
    (void)hipMemsetAsync((char*)d_ws + WS_CTL, 0, 1 * MiB, stream);
    Args a{};
    a.x = (const float*)d_in[0]; a.positions = (const int*)d_in[1]; a.norm1_g = (const float*)d_in[2]; a.w_in = (const float*)d_in[3]; a.cmp_pos = (const float*)d_in[4];
    a.cmp_w1 = (const float*)d_in[5]; a.cmp_w2 = (const float*)d_in[6]; a.nsa_norm_g = (const float*)d_in[7]; a.conv_w = (const float*)d_in[8]; a.a_log = (const float*)d_in[9];
    a.dt_bias = (const float*)d_in[10]; a.gdn_norm_g = (const float*)d_in[11]; a.w_out = (const float*)d_in[12]; a.norm2_g = (const float*)d_in[13]; a.w_gate = (const float*)d_in[14];
    a.w_up = (const float*)d_in[15]; a.w_down = (const float*)d_in[16]; a.final_g = (const float*)d_in[17];
    a.out = (float*)d_out; a.ws = (unsigned char*)d_ws;
    unsigned char* ws = (unsigned char*)d_ws;
    bf16_t* proj = (bf16_t*)(ws + WS_PROJ); bf16_t* mix = (bf16_t*)(ws + WS_MIX);
    auto launch = [&](int lo, int hi) { a.ph_lo = lo; a.ph_hi = hi; hipLaunchKernelGGL(mk_fwd, dim3(grid), dim3(NWAVES * 64), LDS_BYTES, stream, a); };
#if defined(PROBE_SUB)
    launch(0, 3); a.flags = PROBE_SUB; launch(2, 3); a.flags = 0; (void)hipMemsetAsync((char*)d_ws + WS_CTL, 0, 1 * MiB, stream); launch(3, 8);
#elif defined(PROBE_DUP)
    launch(0, PROBE_DUP + 1); (void)hipMemsetAsync((char*)d_ws + WS_CTL, 0, 1 * MiB, stream); launch(PROBE_DUP, 8);
#else
    launch(0, 8);
#endif
}
```

```cpp
#include <hip/hip_runtime.h>
#include <stdint.h>
#include <stdio.h>

typedef unsigned short bf16_t;

constexpr int BATCH = 16, SEQ = 2048, DM = 1024, MTOK = BATCH * SEQ;
constexpr int NSA_HEADS = 8, NSA_G = 2, HPG = 4, HD = 64;
constexpr int NCMP = 127, CMP_L = 32, CMP_S = 16, CMP_HID = 128;
constexpr int NSEL = 32, SELB = 64, TOPN = 8, WIN = 512;
constexpr int GH = 4, GD = 128, DFF = 2816;
constexpr int IN_W = 3360;
constexpr int PJ = 3584;
constexpr int PC_Q = 0, PC_KCMP = 512, PC_VCMP = 640, PC_KSLC = 768, PC_VSLC = 896, PC_KWIN = 1024, PC_VWIN = 1152;
constexpr int PC_GQ = 1280, PC_GK = 1792, PC_GV = 2304, PC_Z = 2816, PC_GATE = 3328, PC_B = 3352, PC_A = 3356;
constexpr float RMS_EPS = 1e-6f;
constexpr float QSCALE = 0.125f * 1.4426950408889634f;

constexpr size_t MiB = 1u << 20;
constexpr size_t WS_CTL = 0;
constexpr size_t WS_ROPE = 1 * MiB;
constexpr size_t WS_KC = 3 * MiB;
constexpr size_t WS_VC = 3 * MiB + 512 * 1024;
constexpr size_t WS_SSQN = 4 * MiB;
constexpr size_t WS_SS2 = 5 * MiB;
constexpr size_t WS_SS3 = 7 * MiB;
constexpr size_t WS_WIN = 9 * MiB;
constexpr size_t WS_WOUT = 16 * MiB;
constexpr size_t WS_WGU = 18 * MiB;
constexpr size_t WS_WDN = 29 * MiB;
constexpr size_t WS_W1T = 35 * MiB;
constexpr size_t WS_W2T = 36 * MiB;
constexpr size_t WS_GL = 37 * MiB;
constexpr size_t WS_XN = 40 * MiB;
constexpr size_t WS_MIX = 104 * MiB;
constexpr size_t WS_PROJ = 168 * MiB;
constexpr size_t WS_END = 392 * MiB;

__device__ __forceinline__ float bf2f(bf16_t v) { return __uint_as_float(((unsigned)v) << 16); }
__device__ __forceinline__ bf16_t f2bf(float f) { unsigned u = __float_as_uint(f); return (bf16_t)((u + 0x7fffu + ((u >> 16) & 1u)) >> 16); }
__device__ __forceinline__ float wave_sum(float v) {
#pragma unroll
    for (int o = 1; o < 64; o <<= 1) v += __shfl_xor(v, o);
    return v;
}
__device__ __forceinline__ float wave_max(float v) {
#pragma unroll
    for (int o = 1; o < 64; o <<= 1) v = fmaxf(v, __shfl_xor(v, o));
    return v;
}
__device__ __forceinline__ float siluf(float x) { return x * __builtin_amdgcn_rcpf(1.f + __builtin_amdgcn_exp2f(-1.4426950408889634f * x)); }
__device__ __forceinline__ float sigmf(float x) { return __builtin_amdgcn_rcpf(1.f + __builtin_amdgcn_exp2f(-1.4426950408889634f * x)); }

__host__ __device__ __forceinline__ int win_orig_col(int p) {
    if (p < 1280) return p;
    if (p < 2816) return p - 1280 + 1304;
    if (p < 3328) return p - 2816 + 2840;
    if (p < 3352) return p - 3328 + 1280;
    if (p < 3360) return p;
    return -1;
}
__global__ void __launch_bounds__(128) k_compress_naive(const bf16_t* proj, const float* cmp_pos, const float* w1, const float* w2, bf16_t* kc, bf16_t* vc) {
    int id = blockIdx.x; const int n = id & 127; id >>= 7; const int g = id & 1; id >>= 1; const int b = id & 15; const int i = id >> 4;
    const int j = threadIdx.x; __shared__ float hid[128];
    bf16_t* outp = (i == 0 ? kc : vc) + ((size_t)(b * 2 + g) * 128 + n) * 64;
    if (n == 127) { if (j < 64) outp[j] = 0; return; }
    const bf16_t* xb = proj + (size_t)(b * SEQ + 16 * n) * PJ + (i == 0 ? PC_KCMP : PC_VCMP) + g * 64;
    const float* pw = w1 + (size_t)i * 2048 * 128; const float* pp = cmp_pos + i * 2048;
    float acc = 0.f;
    for (int l = 0; l < 32; ++l)
        for (int d = 0; d < 64; ++d) acc += (bf2f(xb[(size_t)l * PJ + d]) + pp[l * 64 + d]) * pw[(size_t)(l * 64 + d) * 128 + j];
    hid[j] = siluf(acc); __syncthreads();
    if (j < 64) { float o = 0.f; const float* q = w2 + (size_t)i * 128 * 64;
        for (int jj = 0; jj < 128; ++jj) o += hid[jj] * q[jj * 64 + j];
        outp[j] = f2bf(o); }
}
__global__ void __launch_bounds__(256) k_nsa_naive(const bf16_t* proj, const bf16_t* kc, const bf16_t* vc, bf16_t* mix, float* ssqn) {
    const int m = blockIdx.x >> 1, g = blockIdx.x & 1, b = m / SEQ, t = m % SEQ;
    const int w = threadIdx.x >> 6, lane = threadIdx.x & 63, head = g * 4 + w, cur = t >> 6;
    __shared__ float sc[4][512]; __shared__ float imp[32]; __shared__ unsigned selmask; __shared__ int sellist[8];
    const float NEGB = -1e30f;
    float q[64];
    { const bf16_t* qp = proj + (size_t)m * PJ + PC_Q + head * 64;
#pragma unroll
      for (int d = 0; d < 64; ++d) q[d] = bf2f(qp[d]); }
    const size_t rowb = (size_t)b * SEQ;
    float o_cmp = 0.f;
    {
        const bf16_t* kcb = kc + (size_t)(b * 2 + g) * 128 * 64; const bf16_t* vcb = vc + (size_t)(b * 2 + g) * 128 * 64;
        float s[2]; float mx = NEGB;
#pragma unroll
        for (int i = 0; i < 2; ++i) { const int n = lane + 64 * i; float a = 0.f; const bf16_t* kp = kcb + n * 64;
#pragma unroll
            for (int d = 0; d < 64; ++d) a += q[d] * bf2f(kp[d]);
            const bool valid = (n < NCMP) && (16 * n + 31 <= t); s[i] = valid ? a : NEGB; mx = fmaxf(mx, s[i]); }
        mx = wave_max(mx); float p[2], sum = 0.f;
#pragma unroll
        for (int i = 0; i < 2; ++i) { p[i] = s[i] > -1e29f ? exp2f(s[i] - mx) : 0.f; sum += p[i]; }
        sum = wave_sum(sum); const float inv = (t >= 31 && sum > 0.f) ? 1.f / sum : 0.f;
#pragma unroll
        for (int i = 0; i < 2; ++i) sc[w][lane + 64 * i] = p[i] * inv;
        __syncthreads();
        for (int n = 0; n < NCMP; ++n) o_cmp += sc[w][n] * bf2f(vcb[n * 64 + lane]);
        if (threadIdx.x < 32) { const int s_ = threadIdx.x; float a = 0.f;
            for (int h = 0; h < 4; ++h) for (int n = 4 * s_ - 1; n <= 4 * s_ + 3; ++n) if (n >= 0 && n < NCMP) a += sc[h][n];
            imp[s_] = a; }
        __syncthreads();
        if (threadIdx.x == 0) { unsigned mask = 0u;
            for (int r = 0; r < TOPN; ++r) { float best = -3e38f; int bi = 0;
                for (int j = 0; j < NSEL; ++j) { if (mask >> j & 1u) continue;
                    const bool forced = (j == 0) || (j == cur) || (j == cur - 1);
                    const float v = forced ? 1e9f : (j <= cur ? imp[j] : NEGB);
                    if (v > best) { best = v; bi = j; } }
                mask |= 1u << bi; sellist[r] = bi; }
            selmask = mask; }
        __syncthreads();
    }
    float o_slc = 0.f;
    {
        float s[8]; float mx = NEGB;
#pragma unroll
        for (int i = 0; i < 8; ++i) { const int j = sellist[i]; const int kpos = 64 * j + lane; float a = NEGB;
            if (kpos <= t) { const bf16_t* kp = proj + (rowb + kpos) * PJ + PC_KSLC + g * 64; a = 0.f;
#pragma unroll
                for (int d = 0; d < 64; ++d) a += q[d] * bf2f(kp[d]); }
            s[i] = a; mx = fmaxf(mx, a); }
        mx = wave_max(mx); float sum = 0.f;
#pragma unroll
        for (int i = 0; i < 8; ++i) { s[i] = s[i] > -1e29f ? exp2f(s[i] - mx) : 0.f; sum += s[i]; }
        sum = wave_sum(sum); const float inv = 1.f / sum;
        __syncthreads();
#pragma unroll
        for (int i = 0; i < 8; ++i) sc[w][i * 64 + lane] = s[i] * inv;
        __syncthreads();
        for (int i = 0; i < 8; ++i) { const int j = sellist[i]; if (64 * j > t) continue;
            for (int kk = 0; kk < 64; ++kk) { const int kpos = 64 * j + kk; if (kpos > t) break;
                o_slc += sc[w][i * 64 + kk] * bf2f(proj[(rowb + kpos) * PJ + PC_VSLC + g * 64 + lane]); } }
    }
    float o_win = 0.f;
    {
        float s[8]; float mx = NEGB;
#pragma unroll
        for (int i = 0; i < 8; ++i) { const int kpos = t - 511 + lane + 64 * i; float a = NEGB;
            if (kpos >= 0) { const bf16_t* kp = proj + (rowb + kpos) * PJ + PC_KWIN + g * 64; a = 0.f;
#pragma unroll
                for (int d = 0; d < 64; ++d) a += q[d] * bf2f(kp[d]); }
            s[i] = a; mx = fmaxf(mx, a); }
        mx = wave_max(mx); float sum = 0.f;
#pragma unroll
        for (int i = 0; i < 8; ++i) { s[i] = s[i] > -1e29f ? exp2f(s[i] - mx) : 0.f; sum += s[i]; }
        sum = wave_sum(sum); const float inv = 1.f / sum;
        __syncthreads();
#pragma unroll
        for (int i = 0; i < 8; ++i) sc[w][i * 64 + lane] = s[i] * inv;
        __syncthreads();
        for (int kk = 0; kk < 512; ++kk) { const int kpos = t - 511 + kk; if (kpos < 0) continue;
            o_win += sc[w][kk] * bf2f(proj[(rowb + kpos) * PJ + PC_VWIN + g * 64 + lane]); }
    }
    const bf16_t* gp = proj + (size_t)m * PJ + PC_GATE + head * 3;
    const float o = sigmf(bf2f(gp[0])) * o_cmp + sigmf(bf2f(gp[1])) * o_slc + sigmf(bf2f(gp[2])) * o_win;
    mix[(size_t)m * DM + head * 64 + lane] = f2bf(o);
    const float ss = wave_sum(o * o);
    if (lane == 0) ssqn[m * 8 + head] = ss;
}
__global__ void __launch_bounds__(128) k_gdn_naive(const bf16_t* proj, const float* conv_w, const float* a_log, const float* dt_bias, const float* norm_g, bf16_t* mix) {
    const int b = blockIdx.x >> 2, h = blockIdx.x & 3, n = threadIdx.x, wv = n >> 6, lane = n & 63;
    __shared__ float shq[128], shk[128]; __shared__ float red[2][4];
    float S[128];
#pragma unroll
    for (int k = 0; k < 128; ++k) S[k] = 0.f;
    float wq[4], wk[4], wvv[4];
#pragma unroll
    for (int j = 0; j < 4; ++j) { wq[j] = conv_w[j * 1536 + h * 128 + n]; wk[j] = conv_w[j * 1536 + 512 + h * 128 + n]; wvv[j] = conv_w[j * 1536 + 1024 + h * 128 + n]; }
    float xq0 = 0.f, xq1 = 0.f, xq2 = 0.f, xk0 = 0.f, xk1 = 0.f, xk2 = 0.f, xv0 = 0.f, xv1 = 0.f, xv2 = 0.f;
    const float Aexp = -__expf(a_log[h]), dtb = dt_bias[h], ng = norm_g[n];
    for (int t = 0; t < SEQ; ++t) {
        const bf16_t* pr = proj + (size_t)(b * SEQ + t) * PJ;
        const float xq3 = bf2f(pr[PC_GQ + h * 128 + n]), xk3 = bf2f(pr[PC_GK + h * 128 + n]), xv3 = bf2f(pr[PC_GV + h * 128 + n]);
        float qv = siluf(wq[0] * xq0 + wq[1] * xq1 + wq[2] * xq2 + wq[3] * xq3);
        float kv = siluf(wk[0] * xk0 + wk[1] * xk1 + wk[2] * xk2 + wk[3] * xk3);
        const float vv = siluf(wvv[0] * xv0 + wvv[1] * xv1 + wvv[2] * xv2 + wvv[3] * xv3);
        xq0 = xq1; xq1 = xq2; xq2 = xq3; xk0 = xk1; xk1 = xk2; xk2 = xk3; xv0 = xv1; xv1 = xv2; xv2 = xv3;
        float sq = wave_sum(qv * qv), sk = wave_sum(kv * kv);
        if (lane == 0) { red[wv][0] = sq; red[wv][1] = sk; }
        __syncthreads();
        sq = red[0][0] + red[1][0]; sk = red[0][1] + red[1][1];
        qv *= rsqrtf(sq + RMS_EPS) * 0.08838834764831845f; kv *= rsqrtf(sk + RMS_EPS);
        shq[n] = qv; shk[n] = kv;
        __syncthreads();
        const float beta = sigmf(bf2f(pr[PC_B + h])); const float av = bf2f(pr[PC_A + h]) + dtb;
        const float sp = av > 20.f ? av : log1pf(__expf(av)); const float eg = __expf(Aexp * sp);
        float dot = 0.f;
#pragma unroll
        for (int k = 0; k < 128; ++k) dot += S[k] * shk[k];
        const float vn = beta * (vv - eg * dot);
        float o = 0.f;
#pragma unroll
        for (int k = 0; k < 128; ++k) { S[k] = eg * S[k] + shk[k] * vn; o += S[k] * shq[k]; }
        float so = wave_sum(o * o);
        if (lane == 0) red[wv][2] = so;
        __syncthreads();
        so = red[0][2] + red[1][2];
        const float z = bf2f(pr[PC_Z + h * 128 + n]);
        mix[(size_t)(b * SEQ + t) * DM + 512 + h * 128 + n] = f2bf(o * rsqrtf(so * (1.f / 128.f) + RMS_EPS) * ng * siluf(z));
    }
}

namespace pg8 {
#define PG8_LAS __attribute__((address_space(3)))
typedef unsigned short bf16_t;
typedef short bf16x8 __attribute__((ext_vector_type(8)));
typedef float f32x4 __attribute__((ext_vector_type(4)));
typedef unsigned u32x4 __attribute__((ext_vector_type(4)));
constexpr int BM = 256, BK = 64, HALF = 128, HTB = HALF * BK * 2  , STAGE_BYTES = 8 * HTB, NXCD = 8, WGM = 8;

__host__ __device__ __forceinline__ int lds_byte(int r, int c) { const int st = (r >> 4) * 2 + (c >> 5), rr = r & 15, cc = c & 31, ob = rr * 64 + cc * 2; return st * 1024 + (ob ^ (((ob >> 9) & 1) << 5)); }
__host__ __device__ __forceinline__ void stage_rc(int b, int& R, int& C) { const int st = b / 1024, sb = b % 1024, swz = sb ^ (((sb >> 9) & 1) << 5); R = (st >> 1) * 16 + swz / 64; C = (st & 1) * 32 + (swz % 64) / 2; }
__host__ __device__ __forceinline__ int perm32(int rho) { const int n = rho >> 4, i = rho & 15; return 8 * (i >> 2) + 4 * n + (i & 3); }

struct Unit { int pm, pn; };
struct Gemm { const bf16_t* A; const bf16_t* Bt; int M, N, K; };

struct StaticOrder {
    int nM, nN, nwg, G, c;
    __host__ __device__ void init(int M, int N, int G_, int c_) { nM = M / BM; nN = N / BM; nwg = nM * nN; G = G_; c = c_; }
    __host__ __device__ bool next(int i, Unit& u) const {
        const long L = (long)i * G + c; if (L >= nwg) return false;
        int wgid = (int)L; { const int q = nwg / NXCD, r = nwg % NXCD, xcd = wgid % NXCD, off = wgid / NXCD; wgid = (xcd < r ? xcd * (q + 1) : r * (q + 1) + (xcd - r) * q) + off; }
        const int nig = WGM * nN, gid = wgid / nig, fm = gid * WGM, gsz = (nM - fm) < WGM ? (nM - fm) : WGM;
        u.pm = fm + ((wgid % nig) % gsz); u.pn = (wgid % nig) / gsz; return true;
    }
    __device__ __forceinline__ void a_ready(const Unit&) const {}
    __device__ __forceinline__ void done(const Unit&) const {}
};
__device__ __forceinline__ unsigned cvt_pk_bf16(float lo, float hi) { unsigned r; asm volatile("v_cvt_pk_bf16_f32 %0, %1, %2" : "=v"(r) : "v"(lo), "v"(hi)); return r; }
typedef unsigned u32x2 __attribute__((ext_vector_type(2)));
__device__ __forceinline__ float fast_silu(float v) { return v * __builtin_amdgcn_rcpf(1.0f + __builtin_amdgcn_exp2f(-1.4426950408889634f * v)); }

struct EpiProj {
    static constexpr bool PERM = true, AFTER_DRAIN = false, MIDSCALE = false;
    bf16_t* out; const float* rope; int mid_t;
    __device__ __forceinline__ void midscale(f32x4 (&)[2][2][4][2], const Unit&, int, int) const {}
    __device__ __forceinline__ void operator()(const f32x4 (&acc)[2][2][4][2], const Unit& u, int wr, int wc, int fr, int fq) const {
        const int row0 = u.pm * BM + wr * 64 + fr, colt = u.pn * BM, lcol = wc * 32 + 8 * fq;
        const float sc = (u.pn < 2) ? QSCALE : 1.f;
        const bool wave_rope = ((wc & 1) == 0) && (u.pn < 5);
#pragma unroll
        for (int ai = 0; ai < 2; ++ai)
#pragma unroll
            for (int m = 0; m < 4; ++m) {
                const int r = row0 + ai * HALF + m * 16;
                f32x4 c0 = {1.f, 1.f, 1.f, 1.f}, c1 = c0, s0 = {0.f, 0.f, 0.f, 0.f}, s1 = s0;
                if (wave_rope) { const f32x4* tp = (const f32x4*)(rope + (size_t)r * 16); c0 = tp[0]; c1 = tp[1]; s0 = tp[2]; s1 = tp[3]; }
                bf16_t* rowp = out + (size_t)r * PJ + colt + lcol;
#pragma unroll
                for (int bj = 0; bj < 2; ++bj) {
                    f32x4 v0 = acc[ai][bj][m][0] * sc, v1 = acc[ai][bj][m][1] * sc;
                    const bool tile_rope = wave_rope && ((u.pn < 2) || (bj == 0));
                    if (tile_rope) {
                        f32x4 p0, p1;
#pragma unroll
                        for (int j = 0; j < 4; ++j) { p0[j] = __shfl_xor(v0[j], 16); p1[j] = __shfl_xor(v1[j], 16); }
                        if (fq == 0) { v0 = v0 * c0 - p0 * s0; v1 = v1 * c1 - p1 * s1; }
                        else if (fq == 1) { v0 = v0 * c0 + p0 * s0; v1 = v1 * c1 + p1 * s1; }
                    }
                    u32x4 w; w.x = cvt_pk_bf16(v0[0], v0[1]); w.y = cvt_pk_bf16(v0[2], v0[3]); w.z = cvt_pk_bf16(v1[0], v1[1]); w.w = cvt_pk_bf16(v1[2], v1[3]);
                    *(u32x4*)(rowp + bj * HALF) = w;
                }
            }
    }
};
struct EpiOut {
    static constexpr bool PERM = false, AFTER_DRAIN = false, MIDSCALE = true;
    const float* x; float* x1; bf16_t* x1b; float* ss2; const float* ssqn; int mid_t;
    __device__ __forceinline__ void midscale(f32x4 (&acc)[2][2][4][2], const Unit& u, int wr, int fr) const {
#pragma unroll
        for (int ai = 0; ai < 2; ++ai)
#pragma unroll
            for (int m = 0; m < 4; ++m) {
                const int r = u.pm * BM + ai * HALF + wr * 64 + m * 16 + fr;
                const f32x4 a = *(const f32x4*)(ssqn + (size_t)r * 8), b = *(const f32x4*)(ssqn + (size_t)r * 8 + 4);
                const float s = ((a[0] + a[1]) + (a[2] + a[3])) + ((b[0] + b[1]) + (b[2] + b[3]));
                const float rs = __builtin_amdgcn_rsqf(s * (1.0f / 512.0f) + RMS_EPS);
#pragma unroll
                for (int bj = 0; bj < 2; ++bj)
#pragma unroll
                    for (int n = 0; n < 2; ++n) acc[ai][bj][m][n] = acc[ai][bj][m][n] * rs;
            }
    }
    __device__ __forceinline__ void operator()(const f32x4 (&acc)[2][2][4][2], const Unit& u, int wr, int wc, int fr, int fq) const {
#pragma unroll
        for (int ai = 0; ai < 2; ++ai)
#pragma unroll
            for (int m = 0; m < 4; ++m) {
                const int r = u.pm * BM + ai * HALF + wr * 64 + m * 16 + fr; float ssum = 0.f;
#pragma unroll
                for (int bj = 0; bj < 2; ++bj)
#pragma unroll
                    for (int n = 0; n < 2; ++n) {
                        const size_t off = (size_t)r * DM + u.pn * BM + bj * HALF + wc * 32 + n * 16 + 4 * fq;
                        const f32x4 y = *(const f32x4*)(x + off) + acc[ai][bj][m][n];
                        *(f32x4*)(x1 + off) = y;
                        u32x2 w; w.x = cvt_pk_bf16(y[0], y[1]); w.y = cvt_pk_bf16(y[2], y[3]); *(u32x2*)(x1b + off) = w;
                        ssum += (y[0] * y[0] + y[1] * y[1]) + (y[2] * y[2] + y[3] * y[3]);
                    }
                ssum += __shfl_xor(ssum, 16); ssum += __shfl_xor(ssum, 32);
                if (fq == 0) ss2[(size_t)r * 16 + u.pn * 4 + wc] = ssum;
            }
    }
};
struct EpiGU {
    static constexpr bool PERM = true, AFTER_DRAIN = false, MIDSCALE = false;
    bf16_t* h; const float* ss2; int mid_t;
    __device__ __forceinline__ void midscale(f32x4 (&)[2][2][4][2], const Unit&, int, int) const {}
    __device__ __forceinline__ void operator()(const f32x4 (&acc)[2][2][4][2], const Unit& u, int wr, int wc, int fr, int fq) const {
#pragma unroll
        for (int ai = 0; ai < 2; ++ai)
#pragma unroll
            for (int m = 0; m < 4; ++m) {
                const int r = u.pm * BM + ai * HALF + wr * 64 + m * 16 + fr;
                const f32x4* sp = (const f32x4*)(ss2 + (size_t)r * 16); const f32x4 a = sp[0], b = sp[1], c = sp[2], d = sp[3];
                const f32x4 t = (a + b) + (c + d); const float s = (t[0] + t[1]) + (t[2] + t[3]);
                const float rs = __builtin_amdgcn_rsqf(s * (1.0f / 1024.0f) + RMS_EPS);
                const f32x4 g0 = acc[ai][0][m][0] * rs, g1 = acc[ai][0][m][1] * rs, u0 = acc[ai][1][m][0] * rs, u1 = acc[ai][1][m][1] * rs;
                float o[8];
#pragma unroll
                for (int j = 0; j < 4; ++j) { o[j] = fast_silu(g0[j]) * u0[j]; o[4 + j] = fast_silu(g1[j]) * u1[j]; }
                u32x4 w; w.x = cvt_pk_bf16(o[0], o[1]); w.y = cvt_pk_bf16(o[2], o[3]); w.z = cvt_pk_bf16(o[4], o[5]); w.w = cvt_pk_bf16(o[6], o[7]);
                *(u32x4*)(h + (size_t)r * DFF + u.pn * 128 + wc * 32 + 8 * fq) = w;
            }
    }
};
struct EpiDown {
    static constexpr bool PERM = false, AFTER_DRAIN = false, MIDSCALE = false;
    float* x1; float* ss3; int mid_t;
    __device__ __forceinline__ void midscale(f32x4 (&)[2][2][4][2], const Unit&, int, int) const {}
    __device__ __forceinline__ void operator()(const f32x4 (&acc)[2][2][4][2], const Unit& u, int wr, int wc, int fr, int fq) const {
#pragma unroll
        for (int ai = 0; ai < 2; ++ai)
#pragma unroll
            for (int m = 0; m < 4; ++m) {
                const int r = u.pm * BM + ai * HALF + wr * 64 + m * 16 + fr; float ssum = 0.f;
#pragma unroll
                for (int bj = 0; bj < 2; ++bj)
#pragma unroll
                    for (int n = 0; n < 2; ++n) {
                        const size_t off = (size_t)r * DM + u.pn * BM + bj * HALF + wc * 32 + n * 16 + 4 * fq;
                        const f32x4 y = *(const f32x4*)(x1 + off) + acc[ai][bj][m][n];
                        *(f32x4*)(x1 + off) = y;
                        ssum += (y[0] * y[0] + y[1] * y[1]) + (y[2] * y[2] + y[3] * y[3]);
                    }
                ssum += __shfl_xor(ssum, 16); ssum += __shfl_xor(ssum, 32);
                if (fq == 0) ss3[(size_t)r * 16 + u.pn * 4 + wc] = ssum;
            }
    }
};
template <class Epi, class Sched, bool ALIGN_EPI = false, bool SP2 = false>
__device__ __forceinline__ void gemm_phase(PG8_LAS unsigned char* lds, const Gemm g, const Sched& S, const Epi& E) {
    const int tid = threadIdx.x, wid = __builtin_amdgcn_readfirstlane(tid >> 6), lane = tid & 63, wr = wid >> 2, wc = wid & 3, fr = lane & 15, fq = lane >> 4;
    const int K = g.K, nt = K / BK;
    unsigned voffA[2], voffB[2];
#pragma unroll
    for (int i = 0; i < 2; ++i) { int R, C; stage_rc(tid * 16 + i * 8192, R, C); const int Rb = Epi::PERM ? ((R & ~31) + perm32(R & 31)) : R;
        voffA[i] = (unsigned)(R * K + C) * 2u; voffB[i] = (unsigned)(Rb * K + C) * 2u; }
    const size_t kstep = (size_t)(BK * 2);
    const size_t hstep = (size_t)HALF * K * 2;
    const size_t tstep = 2 * hstep;
    const unsigned ldsw = (unsigned)wid * 1024u;
    const int aoff = lds_byte(wr * 64 + fr, fq * 8), boff = lds_byte(wc * 32 + fr, fq * 8);
#define PG8_SA(b, h) (((b) * 2 + (h)) * HTB)
#define PG8_SB(b, h) ((4 + (b) * 2 + (h)) * HTB)
#define PG8_STAGE(bufoff, gbase, voff) do { _Pragma("unroll") for (int _i = 0; _i < 2; ++_i) \
        __builtin_amdgcn_global_load_lds((const unsigned*)((const char*)(gbase) + (voff)[_i]), (PG8_LAS unsigned*)(lds + (bufoff) + ldsw + _i * 8192), 16, 0, 0); } while (0)
#define PG8_LDA(dst, b, h) do { _Pragma("unroll") for (int m = 0; m < 4; ++m) _Pragma("unroll") for (int k = 0; k < 2; ++k) dst[m][k] = *(const PG8_LAS bf16x8*)(lds + PG8_SA(b, h) + aoff + m * 2048 + k * 1024); } while (0)
#define PG8_LDB(dst, b, h) do { _Pragma("unroll") for (int n = 0; n < 2; ++n) _Pragma("unroll") for (int k = 0; k < 2; ++k) dst[n][k] = *(const PG8_LAS bf16x8*)(lds + PG8_SB(b, h) + boff + n * 2048 + k * 1024); } while (0)
#define PG8_MMA(ai, bj, At, Bt) do { __builtin_amdgcn_s_setprio(1); _Pragma("unroll") for (int m = 0; m < 4; ++m) _Pragma("unroll") for (int n = 0; n < 2; ++n) _Pragma("unroll") for (int k = 0; k < 2; ++k) \
        acc[ai][bj][m][n] = __builtin_amdgcn_mfma_f32_16x16x32_bf16(Bt[n][k], At[m][k], acc[ai][bj][m][n], 0, 0, 0); __builtin_amdgcn_s_setprio(0); } while (0)
#define PG8_WAIT_V(n) asm volatile("s_waitcnt vmcnt(" #n ")" ::: "memory")
#define PG8_WAIT_L(n) asm volatile("s_waitcnt lgkmcnt(" #n ")" ::: "memory")
#define PG8_BAR __builtin_amdgcn_s_barrier()
#define PG8_SCHED __builtin_amdgcn_sched_barrier(0)
    Unit cur, nxt; int ui = 0;
    if (!S.next(0, cur)) return;
    f32x4 acc[2][2][4][2];
#pragma unroll
    for (int a = 0; a < 2; ++a)
#pragma unroll
        for (int b = 0; b < 2; ++b)
#pragma unroll
            for (int m = 0; m < 4; ++m)
#pragma unroll
                for (int n = 0; n < 2; ++n) acc[a][b][m][n] = (f32x4){0.f, 0.f, 0.f, 0.f};
    bf16x8 At[4][2], B0[2][2], B1[2][2];
    const char* cA = (const char*)g.A + (size_t)cur.pm * tstep; const char* cB = (const char*)g.Bt + (size_t)cur.pn * tstep;
    S.a_ready(cur);
    if constexpr (SP2) {
        PG8_STAGE(PG8_SB(0, 0), cB, voffB); PG8_STAGE(PG8_SB(0, 1), cB + hstep, voffB); PG8_STAGE(PG8_SA(0, 0), cA, voffA); PG8_STAGE(PG8_SA(0, 1), cA + hstep, voffA);
        if (wr == 1) PG8_BAR;
        PG8_WAIT_V(2); PG8_BAR;
        PG8_STAGE(PG8_SB(1, 0), cB + kstep, voffB); PG8_STAGE(PG8_SA(1, 0), cA + kstep, voffA); PG8_STAGE(PG8_SB(1, 1), cB + hstep + kstep, voffB);
        PG8_WAIT_V(6); PG8_BAR;
    } else {
        PG8_STAGE(PG8_SB(0, 0), cB, voffB); PG8_STAGE(PG8_SA(0, 0), cA, voffA); PG8_STAGE(PG8_SB(0, 1), cB + hstep, voffB); PG8_STAGE(PG8_SA(0, 1), cA + hstep, voffA);
        if (wr == 1) PG8_BAR;
        PG8_WAIT_V(4); PG8_BAR;
        PG8_STAGE(PG8_SB(1, 0), cB + kstep, voffB); PG8_STAGE(PG8_SA(1, 0), cA + kstep, voffA); PG8_STAGE(PG8_SB(1, 1), cB + hstep + kstep, voffB);
        PG8_WAIT_V(6); PG8_BAR;
    }
    for (;;) {
        const bool has_next = S.next(ui + 1, nxt);
        const char* nA = has_next ? (const char*)g.A + (size_t)nxt.pm * tstep : cA; const char* nB = has_next ? (const char*)g.Bt + (size_t)nxt.pn * tstep : cB;
        for (int t = 0; t < nt; t += 2) {
            const bool last = (t == nt - 2);
            if constexpr (Epi::MIDSCALE) { if (t == E.mid_t) E.midscale(acc, cur, wr, fr); }
            const char* a1 = cA + (size_t)(t + 1) * kstep;
            const char* a2 = last ? nA : cA + (size_t)(t + 2) * kstep; const char* b2 = last ? nB : cB + (size_t)(t + 2) * kstep;
            const char* a3 = a2 + kstep; const char* b3 = b2 + kstep;
            if (last && has_next) S.a_ready(nxt);
            if constexpr (SP2) {
            PG8_LDB(B0, 0, 0); PG8_LDB(B1, 0, 1); PG8_SCHED; PG8_LDA(At, 0, 0); PG8_STAGE(PG8_SA(1, 1), a1 + hstep, voffA);
            PG8_WAIT_V(8); PG8_WAIT_L(0); PG8_BAR; PG8_MMA(0, 0, At, B0); PG8_MMA(0, 1, At, B1); PG8_BAR; PG8_SCHED;
            PG8_LDA(At, 0, 1); PG8_STAGE(PG8_SB(0, 0), b2, voffB); PG8_STAGE(PG8_SB(0, 1), b2 + hstep, voffB); PG8_STAGE(PG8_SA(0, 0), a2, voffA);
            PG8_WAIT_V(8); PG8_WAIT_L(0); PG8_BAR; PG8_MMA(1, 0, At, B0); PG8_MMA(1, 1, At, B1); PG8_BAR; PG8_SCHED;
            PG8_LDB(B0, 1, 0); PG8_LDB(B1, 1, 1); PG8_SCHED; PG8_LDA(At, 1, 0); PG8_STAGE(PG8_SA(0, 1), a2 + hstep, voffA);
            PG8_WAIT_V(8); PG8_WAIT_L(0); PG8_BAR; PG8_MMA(0, 0, At, B0); PG8_MMA(0, 1, At, B1); PG8_BAR; PG8_SCHED;
            PG8_LDA(At, 1, 1); PG8_STAGE(PG8_SB(1, 0), b3, voffB); PG8_STAGE(PG8_SB(1, 1), b3 + hstep, voffB); PG8_STAGE(PG8_SA(1, 0), a3, voffA);
            PG8_WAIT_V(8); PG8_WAIT_L(0); PG8_BAR; PG8_MMA(1, 0, At, B0); PG8_MMA(1, 1, At, B1); PG8_BAR; PG8_SCHED;
            } else {
            PG8_LDB(B0, 0, 0); PG8_SCHED; PG8_LDA(At, 0, 0); PG8_STAGE(PG8_SA(1, 1), a1 + hstep, voffA);
            PG8_WAIT_L(8); PG8_BAR; PG8_WAIT_L(0); PG8_MMA(0, 0, At, B0); PG8_BAR; PG8_SCHED;
            PG8_LDB(B1, 0, 1); PG8_STAGE(PG8_SB(0, 0), b2, voffB);
            PG8_BAR; PG8_WAIT_L(0); PG8_MMA(0, 1, At, B1); PG8_BAR;
            PG8_LDA(At, 0, 1); PG8_STAGE(PG8_SA(0, 0), a2, voffA);
            PG8_BAR; PG8_WAIT_L(0); PG8_MMA(1, 0, At, B0); PG8_BAR; PG8_SCHED;
            PG8_STAGE(PG8_SB(0, 1), b2 + hstep, voffB);
            PG8_WAIT_V(6); PG8_BAR; PG8_MMA(1, 1, At, B1); PG8_BAR;
            PG8_LDB(B0, 1, 0); PG8_SCHED; PG8_LDA(At, 1, 0); PG8_STAGE(PG8_SA(0, 1), a2 + hstep, voffA);
            PG8_WAIT_L(8); PG8_BAR; PG8_WAIT_L(0); PG8_MMA(0, 0, At, B0); PG8_BAR; PG8_SCHED;
            PG8_LDB(B1, 1, 1); PG8_STAGE(PG8_SB(1, 0), b3, voffB);
            PG8_BAR; PG8_WAIT_L(0); PG8_MMA(0, 1, At, B1); PG8_BAR;
            PG8_LDA(At, 1, 1); PG8_STAGE(PG8_SA(1, 0), a3, voffA);
            PG8_BAR; PG8_WAIT_L(0); PG8_MMA(1, 0, At, B0); PG8_BAR; PG8_SCHED;
            PG8_STAGE(PG8_SB(1, 1), b3 + hstep, voffB);
            PG8_WAIT_V(6); PG8_BAR; PG8_MMA(1, 1, At, B1); PG8_BAR;
            }
        }
        if constexpr (ALIGN_EPI) { if (wr == 0) PG8_BAR; }
        if constexpr (!Epi::AFTER_DRAIN) { E(acc, cur, wr, wc, fr, fq); S.done(cur); }
        if (!has_next) break;
#pragma unroll
        for (int a = 0; a < 2; ++a)
#pragma unroll
            for (int b = 0; b < 2; ++b)
#pragma unroll
                for (int m = 0; m < 4; ++m)
#pragma unroll
                    for (int n = 0; n < 2; ++n) acc[a][b][m][n] = (f32x4){0.f, 0.f, 0.f, 0.f};
        cur = nxt; cA = nA; cB = nB; ++ui;
        if constexpr (ALIGN_EPI) { if (wr == 1) PG8_BAR; }
    }
    PG8_WAIT_V(0);
    if constexpr (!ALIGN_EPI) { if (wr == 0) PG8_BAR; }
    PG8_BAR;
    if constexpr (Epi::AFTER_DRAIN) { E.fused(acc, cur, wr, wc, fr, fq, lds, wid, lane); S.done(cur); }
#undef PG8_SA
#undef PG8_SB
#undef PG8_STAGE
#undef PG8_LDA
#undef PG8_LDB
#undef PG8_MMA
#undef PG8_WAIT_V
#undef PG8_WAIT_L
#undef PG8_BAR
#undef PG8_SCHED
}
}

#ifndef PG8_SP2
#define PG8_SP2 true
#endif

#define LAS __attribute__((address_space(3)))
#define XB_TMO      128
#define XB_XCNT(j)  (256  + 64 * (j))
#define XB_XSUB(j)  (1280 + 64 * (j))
#define XB_XGEN(j)  (2304 + 64 * (j))
#define XB_TOP      3328
#define XB_TOPGEN   3392
#define XCD_BAR_WORDS 3456
#define XB_SPIN_CAP (1u << 18)

__device__ __forceinline__ unsigned xb_ld(unsigned* p)              { return __hip_atomic_load(p, __ATOMIC_RELAXED, __HIP_MEMORY_SCOPE_AGENT); }
__device__ __forceinline__ unsigned xb_add(unsigned* p, unsigned v) { return __hip_atomic_fetch_add(p, v, __ATOMIC_RELAXED, __HIP_MEMORY_SCOPE_AGENT); }
__device__ __forceinline__ unsigned xb_xcc_id() { return (unsigned)__builtin_amdgcn_s_getreg((3 << 11) | 20) & 0xFu; }
#define XB_SPIN(cond, bar) do { unsigned _sp = 0; while (cond) { __builtin_amdgcn_s_sleep(1); \
    if ((++_sp & 255u) == 0u) { if (xb_ld(&(bar)[XB_TMO])) break; if (_sp > XB_SPIN_CAP) { atomicAdd(&(bar)[XB_TMO], 1u); break; } } } } while (0)

struct XcdBarrier {
    unsigned* bar; unsigned x;
    volatile LAS unsigned* st;
};

__device__ __forceinline__ XcdBarrier xcd_barrier_post(unsigned* bar, volatile LAS unsigned* st) {
    XcdBarrier b; b.bar = bar; b.x = xb_xcc_id(); b.st = st;
    if (threadIdx.x == 0) (void)xb_add(&bar[XB_XCNT(b.x)], 1u);
    return b;
}
__device__ __forceinline__ void xcd_barrier_complete(unsigned* bar, unsigned x, unsigned& nloc, unsigned& nx) {
    const unsigned G = gridDim.x * gridDim.y * gridDim.z;
    unsigned sum, cnt, mine, sp = 0u;
    for (;;) {
        sum = 0u; cnt = 0u; mine = 0u;
#pragma unroll
        for (unsigned j = 0; j < 16; ++j) { const unsigned c = xb_ld(&bar[XB_XCNT(j)]); sum += c; cnt += (c > 0u) ? 1u : 0u; mine = (j == x) ? c : mine; }
        if (sum == G) break;
        __builtin_amdgcn_s_sleep(1);
        if ((++sp & 255u) == 0u) { if (xb_ld(&bar[XB_TMO])) break; if (sp > XB_SPIN_CAP) { atomicAdd(&bar[XB_TMO], 1u); break; } }
    }
    nloc = mine > 0u ? mine : 1u; nx = cnt > 0u ? cnt : 1u;
}

__device__ __forceinline__ void xcd_barrier(const XcdBarrier& b) {
    asm volatile("s_waitcnt vmcnt(0)" ::: "memory");
    __syncthreads();
    if (threadIdx.x == 0) {
        unsigned* bar = b.bar;
        __builtin_amdgcn_s_waitcnt(0);
        unsigned nloc = b.st[0], nx = b.st[1];
        if (nloc == 0u) { xcd_barrier_complete(bar, b.x, nloc, nx); b.st[0] = nloc; b.st[1] = nx; }
        const unsigned old = xb_add(&bar[XB_XSUB(b.x)], 1u);
        const unsigned gen = old / nloc;
        if (old + 1u == (gen + 1u) * nloc) {
            __builtin_amdgcn_fence(__ATOMIC_RELEASE, "agent");
            asm volatile("s_waitcnt vmcnt(0)" ::: "memory");
            const unsigned og = xb_add(&bar[XB_TOP], 1u);
            const unsigned tg = og / nx;
            if (og + 1u == (tg + 1u) * nx) xb_add(&bar[XB_TOPGEN], 1u);
            else XB_SPIN(xb_ld(&bar[XB_TOPGEN]) == tg, bar);
            __builtin_amdgcn_fence(__ATOMIC_ACQUIRE, "agent");
            xb_add(&bar[XB_XGEN(b.x)], 1u);
            asm volatile("s_waitcnt vmcnt(0)" ::: "memory");
        } else {
            XB_SPIN(xb_ld(&bar[XB_XGEN(b.x)]) == gen, bar);
            __builtin_amdgcn_fence(__ATOMIC_ACQUIRE, "agent");
            asm volatile("s_waitcnt vmcnt(0)" ::: "memory");
        }
    }
    __syncthreads();
}

struct Args {
    const float* x; const int* positions; const float* norm1_g; const float* w_in; const float* cmp_pos; const float* cmp_w1; const float* cmp_w2;
    const float* nsa_norm_g; const float* conv_w; const float* a_log; const float* dt_bias; const float* gdn_norm_g; const float* w_out; const float* norm2_g;
    const float* w_gate; const float* w_up; const float* w_down; const float* final_g;
    float* out; unsigned char* ws; int ph_lo, ph_hi, flags, pad;
};

#ifndef LAS
#define LAS __attribute__((address_space(3)))
#endif
namespace nsa {
typedef float f32x16 __attribute__((ext_vector_type(16)));
typedef float f32x4 __attribute__((ext_vector_type(4)));
typedef float f32x2 __attribute__((ext_vector_type(2)));
typedef __bf16 bf16x2_t __attribute__((ext_vector_type(2)));
typedef short bf16x8 __attribute__((ext_vector_type(8)));
typedef short s16x4 __attribute__((ext_vector_type(4)));
typedef unsigned u32x4 __attribute__((ext_vector_type(4)));
typedef unsigned u32x2 __attribute__((ext_vector_type(2)));

constexpr int L_KV = 0, KV_STAGE = 16384;
constexpr int L_IMP = 49152;
constexpr int L_SELM = 81920;
constexpr int L_UNION = 81920 + 256;
constexpr int L_QUEUE = 81920 + 260;
constexpr int L_RED = 0;
constexpr int L_HT = 81920 + 512;
constexpr float THR = 8.0f;
constexpr float NEG_INF = -__builtin_inff();

__device__ __forceinline__ int crow(int r, int hi) { return (r & 3) + 8 * (r >> 2) + 4 * hi; }
__device__ __forceinline__ unsigned cvtpk(float lo, float hi) { f32x2 v = {lo, hi}; bf16x2_t b = __builtin_convertvector(v, bf16x2_t); return __builtin_bit_cast(unsigned, b); }
__device__ __forceinline__ bf16x8 pack8(float a0, float a1, float a2, float a3, float a4, float a5, float a6, float a7) {
    u32x4 w; w.x = cvtpk(a0, a1); w.y = cvtpk(a2, a3); w.z = cvtpk(a4, a5); w.w = cvtpk(a6, a7); return __builtin_bit_cast(bf16x8, w); }
__device__ __forceinline__ void dma_tile(const unsigned char* gbase, size_t pitch, LAS unsigned char* dst, int wave, int lane) {
    const int row = wave * 8 + (lane >> 3); const int c = (lane & 7) ^ (lane >> 3);
    __builtin_amdgcn_global_load_lds((const unsigned*)(gbase + (size_t)row * pitch + c * 16), (LAS unsigned*)(dst + wave * 1024), 16, 0, 0);
}
typedef short v4i16_t __attribute__((ext_vector_type(4)));
__device__ __forceinline__ s16x4 vtr(LAS const unsigned char* p) { return __builtin_bit_cast(s16x4, __builtin_amdgcn_ds_read_tr16_b64_v4i16((LAS v4i16_t*)p)); }

__device__ __forceinline__ void qk_tile(f32x16& p0, f32x16& p1, LAS const unsigned char* kbuf, const bf16x8 (&qr)[4], int r32, int hi, const f32x16& cinit) {
    LAS const unsigned char* k0 = kbuf + r32 * 128; const int sw = r32 & 7;
    { const int off = ((0 + hi) ^ sw) << 4;
      p0 = __builtin_amdgcn_mfma_f32_32x32x16_bf16(*(LAS const bf16x8*)(k0 + off), qr[0], cinit, 0, 0, 0);
      p1 = __builtin_amdgcn_mfma_f32_32x32x16_bf16(*(LAS const bf16x8*)(k0 + 4096 + off), qr[0], cinit, 0, 0, 0); }
#pragma unroll
    for (int ds = 1; ds < 4; ++ds) {
        const int off = ((2 * ds + hi) ^ sw) << 4;
        const bf16x8 a0 = *(LAS const bf16x8*)(k0 + off), a1 = *(LAS const bf16x8*)(k0 + 4096 + off);
        p0 = __builtin_amdgcn_mfma_f32_32x32x16_bf16(a0, qr[ds], p0, 0, 0, 0);
        p1 = __builtin_amdgcn_mfma_f32_32x32x16_bf16(a1, qr[ds], p1, 0, 0, 0);
    }
}
#define NSA_TR(dst, addr, off) asm volatile("ds_read_b64_tr_b16 %0, %1 offset:%c2" : "=&v"(dst) : "v"(addr), "i"(off) : "memory")
__device__ __forceinline__ void pv_tile(f32x16 (&o)[2], unsigned va0, unsigned va1, const bf16x8 (&pb)[4]) {
    s16x4 lo[4], hh[4];
    NSA_TR(lo[0], va0, 0); NSA_TR(hh[0], va0, 1024); NSA_TR(lo[1], va0, 2048); NSA_TR(hh[1], va0, 3072);
    NSA_TR(lo[2], va0, 4096); NSA_TR(hh[2], va0, 5120); NSA_TR(lo[3], va0, 6144); NSA_TR(hh[3], va0, 7168);
    asm volatile("s_waitcnt lgkmcnt(0)" ::: "memory"); __builtin_amdgcn_sched_barrier(0);
#pragma unroll
    for (int ks = 0; ks < 4; ++ks) { const bf16x8 a = {lo[ks][0], lo[ks][1], lo[ks][2], lo[ks][3], hh[ks][0], hh[ks][1], hh[ks][2], hh[ks][3]};
        o[0] = __builtin_amdgcn_mfma_f32_32x32x16_bf16(a, pb[ks], o[0], 0, 0, 0); }
    s16x4 lo2[4], hh2[4];
    NSA_TR(lo2[0], va1, 0); NSA_TR(hh2[0], va1, 1024); NSA_TR(lo2[1], va1, 2048); NSA_TR(hh2[1], va1, 3072);
    NSA_TR(lo2[2], va1, 4096); NSA_TR(hh2[2], va1, 5120); NSA_TR(lo2[3], va1, 6144); NSA_TR(hh2[3], va1, 7168);
    asm volatile("s_waitcnt lgkmcnt(0)" ::: "memory"); __builtin_amdgcn_sched_barrier(0);
#pragma unroll
    for (int ks = 0; ks < 4; ++ks) { const bf16x8 a = {lo2[ks][0], lo2[ks][1], lo2[ks][2], lo2[ks][3], hh2[ks][0], hh2[ks][1], hh2[ks][2], hh2[ks][3]};
        o[1] = __builtin_amdgcn_mfma_f32_32x32x16_bf16(a, pb[ks], o[1], 0, 0, 0); }
}
__device__ __forceinline__ float max3f(float a, float b, float c) { return __builtin_fmaxf(__builtin_fmaxf(a, b), c); }
__device__ __forceinline__ float max32(const f32x16& p, const f32x16& q) {
    float a = max3f(p[0], p[1], p[2]), b = max3f(q[0], q[1], q[2]);
    a = max3f(a, p[3], p[4]); b = max3f(b, q[3], q[4]); a = max3f(a, p[5], p[6]); b = max3f(b, q[5], q[6]);
    a = max3f(a, p[7], p[8]); b = max3f(b, q[7], q[8]); a = max3f(a, p[9], p[10]); b = max3f(b, q[9], q[10]);
    a = max3f(a, p[11], p[12]); b = max3f(b, q[11], q[12]); a = max3f(a, p[13], p[14]); b = max3f(b, q[13], q[14]);
    return max3f(a, b, __builtin_fmaxf(p[15], q[15]));
}
__device__ __forceinline__ float max16(const f32x16& p) {
    float a = max3f(p[0], p[1], p[2]), b = max3f(p[3], p[4], p[5]); a = max3f(a, p[6], p[7]); b = max3f(b, p[8], p[9]);
    a = max3f(a, p[10], p[11]); b = max3f(b, p[12], p[13]); return max3f(a, b, __builtin_fmaxf(p[14], p[15]));
}
__device__ __forceinline__ float sum16(const f32x16& p) {
    return (((p[0] + p[1]) + (p[2] + p[3])) + ((p[4] + p[5]) + (p[6] + p[7]))) + (((p[8] + p[9]) + (p[10] + p[11])) + ((p[12] + p[13]) + (p[14] + p[15])));
}
__device__ __forceinline__ void mask_tile(f32x16& p0, f32x16& p1, int key0, int hi, int lo, int hi_) {
    const int rlo = lo - key0 - 4 * hi, rhi = hi_ - key0 - 4 * hi;
#pragma unroll
    for (int r = 0; r < 16; ++r) { const int k = (r & 3) + 8 * (r >> 2);
        p0[r] = (k >= rlo && k <= rhi) ? p0[r] : NEG_INF; p1[r] = (k + 32 >= rlo && k + 32 <= rhi) ? p1[r] : NEG_INF; }
}
__device__ __forceinline__ void attn_tile(LAS const unsigned char* kbuf, unsigned vb0, unsigned vb1, const bf16x8 (&qr)[4],
                                          f32x16 (&o)[2], f32x16& negm, float& mref, float& l, bool& seen, int key0, int lo, int hi_, int mode, bool lanesel, int r32, int hi) {
    f32x16 p0, p1;
    if (mode == 0) qk_tile(p0, p1, kbuf, qr, r32, hi, negm);
    else { f32x16 ci;
#pragma unroll
        for (int r = 0; r < 16; ++r) ci[r] = lanesel ? negm[r] : NEG_INF;
        qk_tile(p0, p1, kbuf, qr, r32, hi, ci);
        if (mode == 2) mask_tile(p0, p1, key0, hi, lo, hi_); }
    float mx = max32(p0, p1); mx = fmaxf(mx, __shfl_xor(mx, 32));
    const bool fin = mx > -1e29f;
    const float d = seen ? (mx > THR ? mx : 0.f) : (fin ? mx : 0.f);
    if (__any(d != 0.f)) {
        const float f = seen ? __builtin_amdgcn_exp2f(-d) : 1.f;
        mref += d; l *= f; o[0] = o[0] * f; o[1] = o[1] * f;
#pragma unroll
        for (int r = 0; r < 16; ++r) { p0[r] -= d; p1[r] -= d; negm[r] = -mref; }
    }
    seen = seen || fin;
#pragma unroll
    for (int r = 0; r < 16; ++r) { p0[r] = __builtin_amdgcn_exp2f(p0[r]); p1[r] = __builtin_amdgcn_exp2f(p1[r]); }
    l += sum16(p0) + sum16(p1);
    bf16x8 pb[4];
    pb[0] = pack8(p0[0], p0[1], p0[2], p0[3], p0[4], p0[5], p0[6], p0[7]); pb[1] = pack8(p0[8], p0[9], p0[10], p0[11], p0[12], p0[13], p0[14], p0[15]);
    pb[2] = pack8(p1[0], p1[1], p1[2], p1[3], p1[4], p1[5], p1[6], p1[7]); pb[3] = pack8(p1[8], p1[9], p1[10], p1[11], p1[12], p1[13], p1[14], p1[15]);
    pv_tile(o, vb0, vb1, pb);
}

__device__ __forceinline__ void attn_unit(unsigned char* ws, LAS unsigned char* lds, int b, int g, int qb, int wave, int lane) {
    const int tid = threadIdx.x, r32 = lane & 31, hi = lane >> 5, hh = wave >> 1, th = wave & 1, head = g * 4 + hh;
    const int tl = 32 * th + r32, t = 64 * qb + tl; const size_t m = (size_t)b * SEQ + t;
    const bf16_t* proj = (const bf16_t*)(ws + WS_PROJ);
    const unsigned char* pb_ = (const unsigned char*)(proj + (size_t)b * SEQ * PJ);
    LAS unsigned char* kv = lds + L_KV; const unsigned kva = (unsigned)(uintptr_t)kv;
    LAS float* IMP = (LAS float*)(lds + L_IMP); LAS unsigned* SELM = (LAS unsigned*)(lds + L_SELM); LAS unsigned* UNI = (LAS unsigned*)(lds + L_UNION);
    const int gq = (lane & 15) >> 2, gp = lane & 3, x7 = 4 * hi + gq, clow = 2 * ((lane >> 4) & 1) + (gp >> 1);
    const int vo0 = x7 * 128 + (((0 + clow) ^ x7) << 4) + (gp & 1) * 8, vo1 = x7 * 128 + (((4 + clow) ^ x7) << 4) + (gp & 1) * 8;
    bf16x8 qr[4];
    { const bf16_t* qp = proj + m * PJ + PC_Q + head * 64 + 8 * hi;
#pragma unroll
      for (int ds = 0; ds < 4; ++ds) qr[ds] = *(const bf16x8*)(qp + 16 * ds); }
    const bf16_t* gp_ = proj + m * PJ + PC_GATE + head * 3;
    const float g_cmp = sigmf(bf2f(gp_[0])), g_slc = sigmf(bf2f(gp_[1])), g_win = sigmf(bf2f(gp_[2]));
    f32x16 outa[2]; outa[0] = (f32x16){}; outa[1] = (f32x16){};
    if (tid == 0) *UNI = 0u;
    {
        const bool two = qb >= 16;
        const unsigned char* kcb = ws + WS_KC + (size_t)(b * 2 + g) * 128 * 128; const unsigned char* vcb = ws + WS_VC + (size_t)(b * 2 + g) * 128 * 128;
        dma_tile(kcb, 128, kv, wave, lane); dma_tile(vcb, 128, kv + 8192, wave, lane);
        if (two) { dma_tile(kcb + 64 * 128, 128, kv + KV_STAGE, wave, lane); dma_tile(vcb + 64 * 128, 128, kv + KV_STAGE + 8192, wave, lane); }
        asm volatile("s_waitcnt vmcnt(0)" ::: "memory"); __syncthreads();
        f32x16 c00, c01, c10, c11;
        const f32x16 zc = (f32x16){};
        qk_tile(c00, c01, kv, qr, r32, hi, zc);
        const int nmax = t >= 31 ? (((t - 31) >> 4) < 126 ? ((t - 31) >> 4) : 126) : -1;
        mask_tile(c00, c01, 0, hi, 0, nmax);
        if (two) { qk_tile(c10, c11, kv + KV_STAGE, qr, r32, hi, zc); mask_tile(c10, c11, 64, hi, 0, nmax); }
        else { c10 = (f32x16){}; c11 = (f32x16){};
#pragma unroll
            for (int r = 0; r < 16; ++r) { c10[r] = NEG_INF; c11[r] = NEG_INF; } }
        float mx = fmaxf(fmaxf(max16(c00), max16(c01)), fmaxf(max16(c10), max16(c11))); mx = fmaxf(mx, __shfl_xor(mx, 32));
        mx = fmaxf(mx, -1e30f);
#pragma unroll
        for (int r = 0; r < 16; ++r) { c00[r] = __builtin_amdgcn_exp2f(c00[r] - mx); c01[r] = __builtin_amdgcn_exp2f(c01[r] - mx);
            c10[r] = __builtin_amdgcn_exp2f(c10[r] - mx); c11[r] = __builtin_amdgcn_exp2f(c11[r] - mx); }
        float ls = (sum16(c00) + sum16(c01)) + (sum16(c10) + sum16(c11)); ls += __shfl_xor(ls, 32);
        const float inv = ls > 0.f ? 1.0f / ls : 0.f;
        c00 = c00 * inv; c01 = c01 * inv; c10 = c10 * inv; c11 = c11 * inv;
        float Gv[16], Ev[16];
#pragma unroll
        for (int a = 0; a < 4; ++a) {
            Gv[a] = (c00[4 * a] + c00[4 * a + 1]) + (c00[4 * a + 2] + c00[4 * a + 3]); Ev[a] = c00[4 * a + 3];
            Gv[4 + a] = (c01[4 * a] + c01[4 * a + 1]) + (c01[4 * a + 2] + c01[4 * a + 3]); Ev[4 + a] = c01[4 * a + 3];
            Gv[8 + a] = (c10[4 * a] + c10[4 * a + 1]) + (c10[4 * a + 2] + c10[4 * a + 3]); Ev[8 + a] = c10[4 * a + 3];
            Gv[12 + a] = (c11[4 * a] + c11[4 * a + 1]) + (c11[4 * a + 2] + c11[4 * a + 3]); Ev[12 + a] = c11[4 * a + 3];
        }
        LAS float* ip = IMP + ((hh * 64 + tl) * 32) + hi;
#pragma unroll
        for (int a = 0; a < 16; ++a) {
            const float eprev = a > 0 ? Ev[a > 0 ? a - 1 : 0] : 0.f;
            const float send = hi ? eprev : Ev[a];
            const float recv = __shfl_xor(send, 32);
            ip[2 * a] = Gv[a] + recv;
        }
        f32x16 oc[2]; oc[0] = (f32x16){}; oc[1] = (f32x16){};
        { bf16x8 pb[4];
          pb[0] = pack8(c00[0], c00[1], c00[2], c00[3], c00[4], c00[5], c00[6], c00[7]); pb[1] = pack8(c00[8], c00[9], c00[10], c00[11], c00[12], c00[13], c00[14], c00[15]);
          pb[2] = pack8(c01[0], c01[1], c01[2], c01[3], c01[4], c01[5], c01[6], c01[7]); pb[3] = pack8(c01[8], c01[9], c01[10], c01[11], c01[12], c01[13], c01[14], c01[15]);
          pv_tile(oc, kva + 8192 + vo0, kva + 8192 + vo1, pb); }
        if (two) { bf16x8 pb[4];
          pb[0] = pack8(c10[0], c10[1], c10[2], c10[3], c10[4], c10[5], c10[6], c10[7]); pb[1] = pack8(c10[8], c10[9], c10[10], c10[11], c10[12], c10[13], c10[14], c10[15]);
          pb[2] = pack8(c11[0], c11[1], c11[2], c11[3], c11[4], c11[5], c11[6], c11[7]); pb[3] = pack8(c11[8], c11[9], c11[10], c11[11], c11[12], c11[13], c11[14], c11[15]);
          pv_tile(oc, kva + KV_STAGE + 8192 + vo0, kva + KV_STAGE + 8192 + vo1, pb); }
        outa[0] = oc[0] * g_cmp; outa[1] = oc[1] * g_cmp;
    }
    __syncthreads();
    {
        const int tok = 8 * wave + (lane >> 3), sub = lane & 7;
        f32x4 v = *(LAS const f32x4*)(IMP + (0 * 64 + tok) * 32 + 4 * sub);
        v = v + *(LAS const f32x4*)(IMP + (1 * 64 + tok) * 32 + 4 * sub);
        v = v + *(LAS const f32x4*)(IMP + (2 * 64 + tok) * 32 + 4 * sub);
        v = v + *(LAS const f32x4*)(IMP + (3 * 64 + tok) * 32 + 4 * sub);
        float sc[4];
#pragma unroll
        for (int i = 0; i < 4; ++i) { const int s = 4 * sub + i; const bool forced = (s == 0) || (s == qb) || (s == qb - 1);
            sc[i] = forced ? 1e9f : (s <= qb ? v[i] : -1e30f); }
        unsigned taken = 0u, mask = 0u;
#pragma unroll 1
        for (int round = 0; round < TOPN; ++round) {
            float bv = -3e38f; int bi = 64;
#pragma unroll
            for (int i = 0; i < 4; ++i) { const bool ok = !((taken >> i) & 1u) && sc[i] > bv; bv = ok ? sc[i] : bv; bi = ok ? 4 * sub + i : bi; }
#pragma unroll
            for (int off = 1; off < 8; off <<= 1) { const float ov = __shfl_xor(bv, off); const int oi = __shfl_xor(bi, off);
                const bool take = (ov > bv) || (ov == bv && oi < bi); bv = take ? ov : bv; bi = take ? oi : bi; }
            mask |= 1u << bi; if ((bi >> 2) == sub) taken |= 1u << (bi & 3);
        }
        if (sub == 0) SELM[tok] = mask;
        unsigned um = mask; um |= __shfl_xor(um, 8); um |= __shfl_xor(um, 16); um |= __shfl_xor(um, 32);
        if (lane == 0) atomicOr((unsigned*)UNI, um);
    }
    __syncthreads();
    const unsigned mysel = SELM[tl]; const unsigned uni = *UNI;
    {
        const int wlo = qb > 8 ? qb - 8 : 0;
        unsigned wrem = ((2u << qb) - 1u) & ~((1u << wlo) - 1u);
        unsigned srem = uni & ((2u << qb) - 1u);
        const unsigned char* kwin = pb_ + (size_t)(PC_KWIN + g * 64) * 2; const unsigned char* vwin = pb_ + (size_t)(PC_VWIN + g * 64) * 2;
        const unsigned char* kslc = pb_ + (size_t)(PC_KSLC + g * 64) * 2; const unsigned char* vslc = pb_ + (size_t)(PC_VSLC + g * 64) * 2;
        const size_t pitch = (size_t)PJ * 2;
#define NEXT_TILE(B, J) do { if (wrem) { B = 1; J = __builtin_ctz(wrem); wrem &= wrem - 1; } else if (srem) { B = 2; J = __builtin_ctz(srem); srem &= srem - 1; } else { B = 0; J = 0; } } while (0)
#define ISSUE_TILE(B, J, ST) do { LAS unsigned char* d_ = kv + (ST) * KV_STAGE; \
            dma_tile(((B) == 1 ? kwin : kslc) + (size_t)(J) * 64 * pitch, pitch, d_, wave, lane); dma_tile(((B) == 1 ? vwin : vslc) + (size_t)(J) * 64 * pitch, pitch, d_ + 8192, wave, lane); } while (0)
        int cb, cj, nb_, nj, n2b, n2j;
        NEXT_TILE(cb, cj); NEXT_TILE(nb_, nj);
        ISSUE_TILE(cb, cj, 0); if (nb_) ISSUE_TILE(nb_, nj, 1);
        int st = 0;
        f32x16 o[2]; o[0] = (f32x16){}; o[1] = (f32x16){}; f32x16 negm = (f32x16){}; float mref = 0.f, lrun = 0.f; bool seen = false; int prevb = cb;
        while (cb) {
            NEXT_TILE(n2b, n2j);
            if (nb_) asm volatile("s_waitcnt vmcnt(2)" ::: "memory"); else asm volatile("s_waitcnt vmcnt(0)" ::: "memory");
            __builtin_amdgcn_s_barrier(); asm volatile("" ::: "memory");
            { const int st2 = st >= 1 ? st - 1 : 2;
              if (n2b) ISSUE_TILE(n2b, n2j, st2); }
            if (cb != prevb) {
                float lt = lrun + __shfl_xor(lrun, 32); const float f = g_win / lt;
                outa[0] = outa[0] + o[0] * f; outa[1] = outa[1] + o[1] * f;
                o[0] = (f32x16){}; o[1] = (f32x16){}; negm = (f32x16){}; mref = 0.f; lrun = 0.f; seen = false; prevb = cb;
            }
            LAS const unsigned char* kb = kv + st * KV_STAGE;
            {
                bool run = true, lsel = true; int mode, lo_ = 0, hi2 = t;
                if (cb == 1) { mode = ((cj >= qb - 7) && (cj <= qb - 1)) ? 0 : 2; lo_ = t - (WIN - 1); }
                else { lsel = (mysel >> cj) & 1u; const unsigned long long bal = __ballot(lsel);
                    run = bal != 0ull; mode = (cj == qb) ? 2 : ((bal == ~0ull) ? 0 : 1); }
                if (run) attn_tile(kb, kva + st * KV_STAGE + 8192 + vo0, kva + st * KV_STAGE + 8192 + vo1, qr, o, negm, mref, lrun, seen, 64 * cj, lo_, hi2, mode, lsel, r32, hi);
            }
            cb = nb_; cj = nj; nb_ = n2b; nj = n2j; st = st == 2 ? 0 : st + 1;
        }
#undef NEXT_TILE
#undef ISSUE_TILE
        { float lt = lrun + __shfl_xor(lrun, 32); const float f = (prevb == 1 ? g_win : g_slc) / lt;
          outa[0] = outa[0] + o[0] * f; outa[1] = outa[1] + o[1] * f; }
    }
    {
        bf16_t* mp = (bf16_t*)(ws + WS_MIX) + m * DM + head * 64; float ss = 0.f;
#pragma unroll
        for (int dt = 0; dt < 2; ++dt)
#pragma unroll
            for (int a = 0; a < 4; ++a) {
                const float y0 = outa[dt][4 * a], y1 = outa[dt][4 * a + 1], y2 = outa[dt][4 * a + 2], y3 = outa[dt][4 * a + 3];
                ss += (y0 * y0 + y1 * y1) + (y2 * y2 + y3 * y3);
                u32x2 w; w.x = cvtpk(y0, y1); w.y = cvtpk(y2, y3);
                *(u32x2*)(mp + 32 * dt + 8 * a + 4 * hi) = w;
            }
        ss += __shfl_xor(ss, 32);
        if (hi == 0) ((float*)(ws + WS_SSQN))[m * 8 + head] = ss;
    }
    __syncthreads();
}

__device__ __forceinline__ void compress_unit(unsigned char* ws, const float* cmp_pos, LAS unsigned char* lds, int unit, int wave, int lane) {
    const int nt = unit & 7, g = (unit >> 3) & 1, b = (unit >> 4) & 15, i = unit >> 8;
    const int c = lane & 15, q = lane >> 4, n = 16 * nt + c;
    const bf16_t* proj = (const bf16_t*)(ws + WS_PROJ); const bf16_t* w1t = (const bf16_t*)(ws + WS_W1T) + (size_t)i * 128 * 2048;
    const bf16_t* w2t = (const bf16_t*)(ws + WS_W2T) + (size_t)i * 64 * 128;
    f32x4 acc[8];
#pragma unroll
    for (int jt = 0; jt < 8; ++jt) acc[jt] = (f32x4){0.f, 0.f, 0.f, 0.f};
#pragma unroll 2
    for (int s = 0; s < 8; ++s) {
        const int ks = 8 * wave + s, l = ks >> 1, d0 = (ks & 1) * 32 + 8 * q;
        const u32x4 xv = *(const u32x4*)(proj + (size_t)(b * SEQ + 16 * n + l) * PJ + (i ? PC_VCMP : PC_KCMP) + g * 64 + d0);
        const f32x4 pA = *(const f32x4*)(cmp_pos + i * 2048 + l * 64 + d0), pB = *(const f32x4*)(cmp_pos + i * 2048 + l * 64 + d0 + 4);
        const bf16x8 bfrag = pack8(__uint_as_float(xv.x << 16) + pA[0], __uint_as_float(xv.x & 0xffff0000u) + pA[1], __uint_as_float(xv.y << 16) + pA[2], __uint_as_float(xv.y & 0xffff0000u) + pA[3],
                                   __uint_as_float(xv.z << 16) + pB[0], __uint_as_float(xv.z & 0xffff0000u) + pB[1], __uint_as_float(xv.w << 16) + pB[2], __uint_as_float(xv.w & 0xffff0000u) + pB[3]);
#pragma unroll
        for (int jt = 0; jt < 8; ++jt) { const bf16x8 af = *(const bf16x8*)(w1t + (size_t)(16 * jt + c) * 2048 + 32 * ks + 8 * q);
            acc[jt] = __builtin_amdgcn_mfma_f32_16x16x32_bf16(af, bfrag, acc[jt], 0, 0, 0); }
    }
    LAS f32x4* RED = (LAS f32x4*)(lds + L_RED);
#pragma unroll
    for (int jt = 0; jt < 8; ++jt) RED[(wave * 8 + jt) * 64 + lane] = acc[jt];
    __syncthreads();
    f32x4 h = RED[(0 * 8 + wave) * 64 + lane];
#pragma unroll
    for (int w2 = 1; w2 < 8; ++w2) h = h + RED[(w2 * 8 + wave) * 64 + lane];
    LAS unsigned char* HT = lds + L_HT;
    { u32x2 w; w.x = cvtpk(siluf(h[0]), siluf(h[1])); w.y = cvtpk(siluf(h[2]), siluf(h[3])); *(LAS u32x2*)(HT + c * 256 + (16 * wave + 4 * q) * 2) = w; }
    __syncthreads();
    if (wave < 4) {
        f32x4 o2 = {0.f, 0.f, 0.f, 0.f};
#pragma unroll
        for (int s = 0; s < 4; ++s) { const bf16x8 bf = *(LAS const bf16x8*)(HT + c * 256 + (32 * s + 8 * q) * 2);
            const bf16x8 af = *(const bf16x8*)(w2t + (size_t)(16 * wave + c) * 128 + 32 * s + 8 * q);
            o2 = __builtin_amdgcn_mfma_f32_16x16x32_bf16(af, bf, o2, 0, 0, 0); }
        bf16_t* outp = (bf16_t*)(ws + (i ? WS_VC : WS_KC)) + ((size_t)(b * 2 + g) * 128 + n) * 64 + 16 * wave + 4 * q;
        u32x2 w; w.x = cvtpk(o2[0], o2[1]); w.y = cvtpk(o2[2], o2[3]); if (n == 127) { w.x = 0u; w.y = 0u; }
        *(u32x2*)outp = w;
    }
    __syncthreads();
}
}

namespace gdn {
typedef float f32x4 __attribute__((ext_vector_type(4)));
typedef short bf16x8 __attribute__((ext_vector_type(8)));
typedef unsigned u32x4 __attribute__((ext_vector_type(4)));
typedef unsigned u32x2 __attribute__((ext_vector_type(2)));
using nsa::cvtpk; using nsa::pack8;

constexpr int REC_W = 0, REC_QG = 16384, REC_KD = 32768, REC_QK = 49152, REC_BYTES = 57344;
constexpr int UREC_BYTES = 32768;
constexpr int NCHUNK = SEQ / 64;
constexpr int P_KR = 0, P_QR = 16384, P_STG = 32768, P_AT = 32768, P_QKI = 49152, P_SC = 67584, P_HALF = 69632;
constexpr int SLAB = 17408;
constexpr int SC_BETA = 0, SC_GC = 64, SC_EGC = 128, SC_EKD = 192, SC_RK2 = 256, SC_RQ2 = 320;
constexpr int S_BUF = 0, S_SSQ = 2 * REC_BYTES;

__device__ __forceinline__ int perm32pos(int kl) { return 8 * ((kl & 15) >> 2) + 4 * (kl >> 4) + (kl & 3); }
__device__ __forceinline__ int off256(int i, int k) { const int pos = perm32pos(k & 31), ch = 4 * (k >> 5) + (pos >> 3); return i * 256 + ((ch ^ (i & 15)) << 4) + (pos & 7) * 2; }
__device__ __forceinline__ int off128(int row, int j) { const int pos = perm32pos(j & 31), ch = 4 * (j >> 5) + (pos >> 3); return row * 128 + ((ch ^ (row & 7)) << 4) + (pos & 7) * 2; }
__device__ __forceinline__ float softplusf(float x) { return x > 20.f ? x : log1pf(__expf(x)); }

__device__ __forceinline__ void conv64(float (&y)[64], LAS const bf16_t* sp, const float* cw, int ch1536, bool first) {
    const float w0 = cw[ch1536], w1 = cw[1536 + ch1536], w2 = cw[2 * 1536 + ch1536], w3 = cw[3 * 1536 + ch1536];
    float x0 = first ? 0.f : bf2f(sp[0]), x1 = first ? 0.f : bf2f(sp[128]), x2 = first ? 0.f : bf2f(sp[256]);
#pragma unroll
    for (int i = 0; i < 64; ++i) { const float x3 = bf2f(sp[(i + 3) * 128]); y[i] = siluf(w0 * x0 + w1 * x1 + w2 * x2 + w3 * x3); x0 = x1; x1 = x2; x2 = x3; }
}
__device__ __forceinline__ void slab_dma(const bf16_t* projrow, const int* cols, int nmat, LAS unsigned char* stg, int w4, int lane) {
    for (int p = w4; p < 17 * nmat; p += 4) { const int mat = p / 17, pr = p % 17;
        __builtin_amdgcn_global_load_lds((const unsigned*)(projrow + (size_t)(4 * pr + (lane >> 4)) * PJ + cols[mat] + (lane & 15) * 8), (LAS unsigned*)(stg + mat * SLAB + pr * 1024), 16, 0, 0); }
}

__device__ __forceinline__ void prep_unit(const Args& a, LAS unsigned char* lds, int u, int wave, int lane) {
    unsigned char* ws = a.ws;
    int tid = threadIdx.x; asm volatile("" : "+v"(tid));
    lane = tid & 63;
    const int half = tid >> 8, c = tid & 255, w4 = wave & 3, fr = lane & 15, fq = lane >> 4;
    const int bh = u >> 4, b = bh >> 2, h = bh & 3, chunk = 2 * (u & 15) + half;
    LAS unsigned char* L = lds + half * P_HALF; LAS float* SC = (LAS float*)(L + P_SC); LAS float* AT = (LAS float*)(L + P_AT);
    const bf16_t* proj = (const bf16_t*)(ws + WS_PROJ); const size_t row0 = (size_t)b * SEQ + 64 * chunk;
    unsigned char* rec = (unsigned char*)a.out + (size_t)(bh * NCHUNK + chunk) * REC_BYTES;
    unsigned char* urec = ws + WS_XN + (size_t)(bh * NCHUNK + chunk) * UREC_BYTES;
    if (w4 == 0) {
        const bf16_t* pr = proj + (row0 + lane) * PJ;
        const float beta = sigmf(bf2f(pr[PC_B + h])); const float av = bf2f(pr[PC_A + h]) + a.dt_bias[h];
        float g = -__expf(a.a_log[h]) * softplusf(av);
#pragma unroll
        for (int o = 1; o < 64; o <<= 1) { const float up = __shfl_up(g, o); if (lane >= o) g += up; }
        const float glast = __shfl(g, 63);
        SC[SC_BETA + lane] = beta; SC[SC_GC + lane] = g; SC[SC_EGC + lane] = __expf(g); SC[SC_EKD + lane] = __expf(glast - g);
        if (lane == 63) ((float*)(ws + WS_GL))[bh * NCHUNK + chunk] = __expf(g);
    }
    float x[64];
    const int kc = c & 127;
    { const bf16_t* prow = proj + (row0 - 3) * PJ + h * 128; const int cols_qk[2] = {PC_GQ, PC_GK}; const int cols_v[2] = {PC_GV, PC_GV};
      slab_dma(prow, cols_qk, 2, L + P_STG, w4, lane);
      asm volatile("s_waitcnt vmcnt(0)" ::: "memory"); __syncthreads();
      const int pos = perm32pos(kc & 31), ch = 4 * (kc >> 5) + (pos >> 3), jb = (pos & 7) * 2;
      if (c < 128) { conv64(x, (LAS const bf16_t*)(L + P_STG) + kc, a.conv_w, h * 128 + kc, chunk == 0);
#pragma unroll
          for (int i = 0; i < 64; ++i) *(LAS bf16_t*)(L + P_QR + i * 256 + ((ch ^ (i & 15)) << 4) + jb) = f2bf(x[i]);
      } else { conv64(x, (LAS const bf16_t*)(L + P_STG + SLAB) + kc, a.conv_w, 512 + h * 128 + kc, chunk == 0);
#pragma unroll
          for (int i = 0; i < 64; ++i) { const bf16_t kb = f2bf(x[i]); *(LAS bf16_t*)(L + P_KR + i * 256 + ((ch ^ (i & 15)) << 4) + jb) = kb; x[i] = bf2f(kb); }
      }
      __syncthreads();
      slab_dma(prow, cols_v, 1, L + P_STG, w4, lane);
      asm volatile("s_waitcnt vmcnt(0)" ::: "memory"); __syncthreads();
      if (c < 128) conv64(x, (LAS const bf16_t*)(L + P_STG) + kc, a.conv_w, 1024 + h * 128 + kc, chunk == 0);
    }
    __syncthreads();
    f32x4 kk[4], qk[4], qq;
    {
        bf16x8 ak[4], aq[4];
        const int ri = 16 * w4 + fr;
#pragma unroll
        for (int s = 0; s < 4; ++s) { const int o = ri * 256 + (((4 * s + fq) ^ fr) << 4); ak[s] = *(LAS const bf16x8*)(L + P_KR + o); aq[s] = *(LAS const bf16x8*)(L + P_QR + o); }
        qq = (f32x4){0.f, 0.f, 0.f, 0.f};
#pragma unroll
        for (int s = 0; s < 4; ++s) qq = __builtin_amdgcn_mfma_f32_16x16x32_bf16(aq[s], aq[s], qq, 0, 0, 0);
#pragma unroll
        for (int nt = 0; nt < 4; ++nt) {
            kk[nt] = (f32x4){0.f, 0.f, 0.f, 0.f}; qk[nt] = (f32x4){0.f, 0.f, 0.f, 0.f};
            if (nt <= w4) {
                const int rj = 16 * nt + fr;
#pragma unroll
                for (int s = 0; s < 4; ++s) { const bf16x8 bk = *(LAS const bf16x8*)(L + P_KR + rj * 256 + (((4 * s + fq) ^ fr) << 4));
                    kk[nt] = __builtin_amdgcn_mfma_f32_16x16x32_bf16(ak[s], bk, kk[nt], 0, 0, 0);
                    qk[nt] = __builtin_amdgcn_mfma_f32_16x16x32_bf16(aq[s], bk, qk[nt], 0, 0, 0); }
            }
        }
#pragma unroll
        for (int nt = 0; nt < 4; ++nt) if (nt == w4) {
#pragma unroll
            for (int r = 0; r < 4; ++r) if (fr == 4 * fq + r) { SC[SC_RK2 + 16 * w4 + fr] = kk[nt][r]; SC[SC_RQ2 + 16 * w4 + fr] = qq[r]; } }
    }
    __syncthreads();
    {
#pragma unroll
        for (int nt = 0; nt < 4; ++nt) {
            const int j = 16 * nt + fr; const float rkj = rsqrtf(SC[SC_RK2 + j] + RMS_EPS), gcj = SC[SC_GC + j];
            f32x4 av; float qv[4];
#pragma unroll
            for (int r = 0; r < 4; ++r) { const int i = 16 * w4 + 4 * fq + r; const float gci = SC[SC_GC + i];
                const float dec = __expf(fminf(gci - gcj, 0.f));
                const float rki = rsqrtf(SC[SC_RK2 + i] + RMS_EPS), rqi = rsqrtf(SC[SC_RQ2 + i] + RMS_EPS);
                av[r] = (nt <= w4 && j < i) ? SC[SC_BETA + i] * kk[nt][r] * rki * rkj * dec : 0.f;
                qv[r] = (nt <= w4 && j <= i) ? qk[nt][r] * rqi * rkj * 0.08838834764831845f * dec : 0.f; }
            *(LAS f32x4*)(AT + j * 64 + 16 * w4 + 4 * fq) = av;
#pragma unroll
            for (int r = 0; r < 4; ++r) { const int i = 16 * w4 + 4 * fq + r; *(LAS bf16_t*)(L + P_QKI + off128(i, j)) = f2bf(qv[r]); }
        }
        if (c >= 128) {
#define KDV(j) (x[j] * SC[SC_EKD + (j)] * rsqrtf(SC[SC_RK2 + (j)] + RMS_EPS))
#pragma unroll
            for (int ch = 0; ch < 8; ++ch) { const int j0 = 32 * (ch >> 2) + 4 * (ch & 3);
                const bf16x8 v = pack8(KDV(j0), KDV(j0 + 1), KDV(j0 + 2), KDV(j0 + 3), KDV(j0 + 16), KDV(j0 + 17), KDV(j0 + 18), KDV(j0 + 19));
                *(bf16x8*)(rec + REC_KD + kc * 128 + ((ch ^ (kc & 7)) << 4)) = v; }
#undef KDV
#pragma unroll
            for (int i = 0; i < 64; ++i) x[i] = x[i] * SC[SC_BETA + i] * SC[SC_EGC + i] * rsqrtf(SC[SC_RK2 + i] + RMS_EPS);
        } else {
#pragma unroll
            for (int i = 0; i < 64; ++i) x[i] = x[i] * SC[SC_BETA + i];
        }
        { const int i = c >> 2; const float f = rsqrtf(SC[SC_RQ2 + i] + RMS_EPS) * 0.08838834764831845f * SC[SC_EGC + i];
#pragma unroll
          for (int cc = 0; cc < 4; ++cc) { const int o = i * 256 + ((4 * (c & 3) + cc) << 4);
              const u32x4 v = *(LAS const u32x4*)(L + P_QR + o);
              const bf16x8 w = pack8(__uint_as_float(v.x << 16) * f, __uint_as_float(v.x & 0xffff0000u) * f, __uint_as_float(v.y << 16) * f, __uint_as_float(v.y & 0xffff0000u) * f,
                                     __uint_as_float(v.z << 16) * f, __uint_as_float(v.z & 0xffff0000u) * f, __uint_as_float(v.w << 16) * f, __uint_as_float(v.w & 0xffff0000u) * f);
              *(bf16x8*)(rec + REC_QG + o) = w; } }
    }
    __syncthreads();
    {
        const LAS f32x4* AT4 = (const LAS f32x4*)AT;
#pragma unroll
        for (int j = 0; j < 63; ++j) {
            const float xj = x[j];
#pragma unroll
            for (int i4 = (j + 1) / 4; i4 < 16; ++i4) { const f32x4 av = AT4[j * 16 + i4];
#pragma unroll
                for (int r = 0; r < 4; ++r) if (4 * i4 + r > j) x[4 * i4 + r] -= av[r] * xj; }
            __builtin_amdgcn_sched_barrier(0);
        }
#pragma unroll
        for (int cc = 0; cc < 2; ++cc) { const int o = (c * 2 + cc) * 16; *(u32x4*)(rec + REC_QK + o) = *(LAS const u32x4*)(L + P_QKI + o); }
        if (c < 128) {
            const int wv = kc >> 4, cc = kc & 15;
#pragma unroll
            for (int it = 0; it < 4; ++it)
#pragma unroll
                for (int q = 0; q < 4; ++q) { const int i0 = 16 * it + 4 * q;
                    *(f32x4*)(urec + (size_t)(((wv * 4 + it) * 64) + q * 16 + cc) * 16) = (f32x4){x[i0], x[i0 + 1], x[i0 + 2], x[i0 + 3]}; }
        } else {
            const int pos = perm32pos(kc & 31), ch = 4 * (kc >> 5) + (pos >> 3), jb = (pos & 7) * 2;
#pragma unroll
            for (int i = 0; i < 64; ++i) *(LAS bf16_t*)(L + P_KR + i * 256 + ((ch ^ (i & 15)) << 4) + jb) = f2bf(-x[i]);
        }
    }
    __syncthreads();
#pragma unroll
    for (int cc = 0; cc < 4; ++cc) { const int o = (c * 4 + cc) * 16; *(u32x4*)(rec + REC_W + o) = *(LAS const u32x4*)(L + P_KR + o); }
    __syncthreads();
}

__device__ __forceinline__ float row_sum16(float v) {
    v += __builtin_bit_cast(float, __builtin_amdgcn_update_dpp(0, __builtin_bit_cast(int, v), 0x128, 0xf, 0xf, false));
    v += __builtin_bit_cast(float, __builtin_amdgcn_update_dpp(0, __builtin_bit_cast(int, v), 0x124, 0xf, 0xf, false));
    v += __builtin_bit_cast(float, __builtin_amdgcn_update_dpp(0, __builtin_bit_cast(int, v), 0x122, 0xf, 0xf, false));
    v += __builtin_bit_cast(float, __builtin_amdgcn_update_dpp(0, __builtin_bit_cast(int, v), 0x121, 0xf, 0xf, false));
    return v;
}
__device__ __forceinline__ void scan_unit(const Args& a, LAS unsigned char* lds, int bh, int wave, int lane) {
    unsigned char* ws = a.ws;
    const int b = bh >> 2, h = bh & 3, fr = lane & 15, fq = lane >> 4;
    const unsigned char* recb = (const unsigned char*)a.out + (size_t)bh * NCHUNK * REC_BYTES;
    const unsigned char* urecb = ws + WS_XN + (size_t)bh * NCHUNK * UREC_BYTES;
    const float* gl = (const float*)(ws + WS_GL) + bh * NCHUNK;
    const bf16_t* zbase = (const bf16_t*)(ws + WS_PROJ) + (size_t)b * SEQ * PJ + PC_Z + h * 128 + 16 * wave + fr;
    bf16_t* mbase = (bf16_t*)(ws + WS_MIX) + (size_t)b * SEQ * DM + 512 + h * 128 + 16 * wave + fr;
    const float ng = a.gdn_norm_g[16 * wave + fr];
    f32x4 S[8];
#pragma unroll
    for (int kt = 0; kt < 8; ++kt) S[kt] = (f32x4){0.f, 0.f, 0.f, 0.f};
#pragma unroll
    for (int p = 0; p < 7; ++p) __builtin_amdgcn_global_load_lds((const unsigned*)(recb + (size_t)(wave + 8 * p) * 1024 + lane * 16), (LAS unsigned*)(lds + S_BUF + (wave + 8 * p) * 1024), 16, 0, 0);
    f32x4 un[4]; unsigned short zn[16]; float egn; bf16_t pend[16];
    { const f32x4* up = (const f32x4*)urecb + (wave * 4) * 64 + lane;
#pragma unroll
      for (int it = 0; it < 4; ++it) un[it] = up[it * 64];
#pragma unroll
      for (int it = 0; it < 4; ++it)
#pragma unroll
          for (int r = 0; r < 4; ++r) zn[4 * it + r] = zbase[(size_t)(16 * it + 4 * fq + r) * PJ];
      egn = gl[0];
#pragma unroll
      for (int i = 0; i < 16; ++i) pend[i] = 0; }
    for (int ck = 0; ck < NCHUNK; ++ck) {
        LAS const unsigned char* buf = lds + S_BUF + (ck & 1) * REC_BYTES;
        asm volatile("s_waitcnt vmcnt(0)" ::: "memory"); __syncthreads();
        if (ck + 1 < NCHUNK) { const unsigned char* src = recb + (size_t)(ck + 1) * REC_BYTES; LAS unsigned char* dst = lds + S_BUF + ((ck + 1) & 1) * REC_BYTES;
#pragma unroll
            for (int p = 0; p < 7; ++p) __builtin_amdgcn_global_load_lds((const unsigned*)(src + (size_t)(wave + 8 * p) * 1024 + lane * 16), (LAS unsigned*)(dst + (wave + 8 * p) * 1024), 16, 0, 0); }
        if (ck > 0) {
#pragma unroll
            for (int it = 0; it < 4; ++it)
#pragma unroll
                for (int r = 0; r < 4; ++r) mbase[(size_t)(64 * (ck - 1) + 16 * it + 4 * fq + r) * DM] = pend[4 * it + r]; }
        f32x4 av[4], ao[4]; float zv[16];
#pragma unroll
        for (int it = 0; it < 4; ++it) { av[it] = un[it]; ao[it] = (f32x4){0.f, 0.f, 0.f, 0.f}; }
#pragma unroll
        for (int i = 0; i < 16; ++i) zv[i] = bf2f(zn[i]);
        const float egl = egn;
        { const int cn = ck + 1 < NCHUNK ? ck + 1 : ck;
          const f32x4* up = (const f32x4*)(urecb + (size_t)cn * UREC_BYTES) + (wave * 4) * 64 + lane;
#pragma unroll
          for (int it = 0; it < 4; ++it) un[it] = up[it * 64];
#pragma unroll
          for (int it = 0; it < 4; ++it)
#pragma unroll
              for (int r = 0; r < 4; ++r) zn[4 * it + r] = zbase[(size_t)(64 * cn + 16 * it + 4 * fq + r) * PJ];
          egn = gl[cn]; }
        bf16x8 Sb[4];
#pragma unroll
        for (int s = 0; s < 4; ++s) Sb[s] = pack8(S[2 * s][0], S[2 * s][1], S[2 * s][2], S[2 * s][3], S[2 * s + 1][0], S[2 * s + 1][1], S[2 * s + 1][2], S[2 * s + 1][3]);
#pragma unroll
        for (int it = 0; it < 4; ++it) { const int o = (16 * it + fr) * 256;
#pragma unroll
            for (int s = 0; s < 4; ++s) { const int co = ((4 * s + fq) ^ fr) << 4;
                av[it] = __builtin_amdgcn_mfma_f32_16x16x32_bf16(*(LAS const bf16x8*)(buf + REC_W + o + co), Sb[s], av[it], 0, 0, 0);
                ao[it] = __builtin_amdgcn_mfma_f32_16x16x32_bf16(*(LAS const bf16x8*)(buf + REC_QG + o + co), Sb[s], ao[it], 0, 0, 0); } }
        bf16x8 vb[2];
#pragma unroll
        for (int s = 0; s < 2; ++s) vb[s] = pack8(av[2 * s][0], av[2 * s][1], av[2 * s][2], av[2 * s][3], av[2 * s + 1][0], av[2 * s + 1][1], av[2 * s + 1][2], av[2 * s + 1][3]);
#pragma unroll
        for (int it = 0; it < 4; ++it) { const int o = (16 * it + fr) * 128;
#pragma unroll
            for (int s = 0; s < 2; ++s) ao[it] = __builtin_amdgcn_mfma_f32_16x16x32_bf16(*(LAS const bf16x8*)(buf + REC_QK + o + (((4 * s + fq) ^ (fr & 7)) << 4)), vb[s], ao[it], 0, 0, 0); }
        LAS float* SSQ = (LAS float*)(lds + S_SSQ) + (ck & 1) * 512;
#pragma unroll
        for (int it = 0; it < 4; ++it)
#pragma unroll
            for (int r = 0; r < 4; ++r) { const float s2 = row_sum16(ao[it][r] * ao[it][r]);
                if (fr == 0) SSQ[(16 * it + 4 * fq + r) * 8 + wave] = s2; }
#pragma unroll
        for (int kt = 0; kt < 8; ++kt) { S[kt] = S[kt] * egl; const int o = (16 * kt + fr) * 128;
#pragma unroll
            for (int s = 0; s < 2; ++s) S[kt] = __builtin_amdgcn_mfma_f32_16x16x32_bf16(*(LAS const bf16x8*)(buf + REC_KD + o + (((4 * s + fq) ^ (fr & 7)) << 4)), vb[s], S[kt], 0, 0, 0); }
        asm volatile("s_waitcnt lgkmcnt(0)" ::: "memory"); __builtin_amdgcn_s_barrier(); asm volatile("" ::: "memory");
#pragma unroll
        for (int it = 0; it < 4; ++it)
#pragma unroll
            for (int r = 0; r < 4; ++r) { const int i = 16 * it + 4 * fq + r; const f32x4 p0 = *(LAS const f32x4*)(SSQ + i * 8), p1 = *(LAS const f32x4*)(SSQ + i * 8 + 4);
                const float tot = ((p0[0] + p0[1]) + (p0[2] + p0[3])) + ((p1[0] + p1[1]) + (p1[2] + p1[3]));
                const float rs = rsqrtf(tot * (1.f / 128.f) + RMS_EPS);
                pend[4 * it + r] = f2bf(ao[it][r] * rs * ng * siluf(zv[4 * it + r])); }
    }
#pragma unroll
    for (int it = 0; it < 4; ++it)
#pragma unroll
        for (int r = 0; r < 4; ++r) mbase[(size_t)(64 * (NCHUNK - 1) + 16 * it + 4 * fq + r) * DM] = pend[4 * it + r];
    __syncthreads();
}
}

#ifndef PG8_ALIGN
#define PG8_ALIGN true
#endif
constexpr int NWAVES = 8;
constexpr int RING_BYTES = 131072;
constexpr int MISC_OFF = 147456 - 512;
constexpr int LDS_BYTES = 147456;
#ifndef LAS
#define LAS __attribute__((address_space(3)))
#endif
#define GAS __attribute__((address_space(1)))
typedef unsigned v4u __attribute__((ext_vector_type(4)));
typedef float f32x4 __attribute__((ext_vector_type(4)));
#define LDS_WAIT() asm volatile("s_waitcnt lgkmcnt(0)" ::: "memory")
#define VM_WAIT() asm volatile("s_waitcnt vmcnt(0)" ::: "memory")
constexpr int CW_BAR = 4096, CW_QUEUE = 8192;


__device__ __forceinline__ unsigned pk2(float lo, float hi) { return (unsigned)f2bf(lo) | ((unsigned)f2bf(hi) << 16); }
__device__ __forceinline__ void p0_transpose_item(const float* colp, int ld, const float* gain, int gain_n, int K, bf16_t* WT, LAS float* scr, int k0, int n0, int lane) {
#pragma unroll 8
    for (int i = 0; i < 32; ++i) { const int kk = 2 * i + (lane >> 5); float v = 0.f;
        if (colp) { v = colp[(size_t)(k0 + kk) * ld]; if (gain && (k0 + kk) < gain_n) v *= gain[k0 + kk]; }
        scr[kk * 33 + (lane & 31)] = v; }
    LDS_WAIT(); asm volatile("" ::: "memory");
    const int c = lane & 7;
#pragma unroll
    for (int j = 0; j < 4; ++j) { const int n = (lane >> 3) + 8 * j; const LAS float* s = scr + (8 * c) * 33 + n;
        v4u o; o.x = pk2(s[0 * 33], s[1 * 33]); o.y = pk2(s[2 * 33], s[3 * 33]); o.z = pk2(s[4 * 33], s[5 * 33]); o.w = pk2(s[6 * 33], s[7 * 33]);
        *(v4u*)(WT + (size_t)(n0 + n) * K + k0 + 8 * c) = o; }
    LDS_WAIT(); asm volatile("" ::: "memory");
}
__device__ __forceinline__ void p0_prologue(const Args& a, LAS unsigned char* lds, int vcu, int G, int wave, int lane) {
    unsigned char* ws = a.ws;
    LAS float* scr = (LAS float*)(lds + wave * 16384);
    const int gw = vcu * NWAVES + wave, NGW = G * NWAVES;
    constexpr int I_IN = 16 * (PJ / 32), I_OUT = 16 * 32, I_GU = 16 * (2 * DFF / 32), I_DN = (DFF / 64) * 32, I_W1 = 2 * 32 * 4, I_W2 = 2 * 2 * 2;
    constexpr int NITEMS = I_IN + I_OUT + I_GU + I_DN + I_W1 + I_W2;
    for (int it = gw; it < NITEMS; it += NGW) {
        int r = it;
        if (r < I_IN) { const int nblk = PJ / 32, kb = r / nblk, nb = r % nblk; const int n = nb * 32 + (lane & 31); const int oc = win_orig_col(n);
            p0_transpose_item(oc < 0 ? nullptr : a.w_in + oc, IN_W, nullptr, 0, DM, (bf16_t*)(ws + WS_WIN), scr, kb * 64, nb * 32, lane); continue; } r -= I_IN;
        if (r < I_OUT) { const int kb = r / 32, nb = r % 32; const int n = nb * 32 + (lane & 31);
            p0_transpose_item(a.w_out + n, DM, a.nsa_norm_g, 512, DM, (bf16_t*)(ws + WS_WOUT), scr, kb * 64, nb * 32, lane); continue; } r -= I_OUT;
        if (r < I_GU) { const int nblk = 2 * DFF / 32, kb = r / nblk, nb = r % nblk; const int n = nb * 32 + (lane & 31); const int pn = n >> 8, wi = n & 255;
            const float* W = (wi < 128) ? a.w_gate : a.w_up;
            p0_transpose_item(W + pn * 128 + (wi & 127), DFF, a.norm2_g, DM, DM, (bf16_t*)(ws + WS_WGU), scr, kb * 64, nb * 32, lane); continue; } r -= I_GU;
        if (r < I_DN) { const int kb = r / 32, nb = r % 32; const int n = nb * 32 + (lane & 31);
            p0_transpose_item(a.w_down + n, DM, nullptr, 0, DFF, (bf16_t*)(ws + WS_WDN), scr, kb * 64, nb * 32, lane); continue; } r -= I_DN;
        if (r < I_W1) { const int i = r / 128, rr = r % 128, kb = rr / 4, nb = rr % 4; const int n = nb * 32 + (lane & 31);
            p0_transpose_item(a.cmp_w1 + (size_t)i * 2048 * 128 + n, 128, nullptr, 0, 2048, (bf16_t*)(ws + WS_W1T) + (size_t)i * 128 * 2048, scr, kb * 64, nb * 32, lane); continue; } r -= I_W1;
        { const int i = r / 4, rr = r % 4, kb = rr / 2, nb = rr % 2; const int n = nb * 32 + (lane & 31);
            p0_transpose_item(a.cmp_w2 + (size_t)i * 128 * 64 + n, 64, nullptr, 0, 128, (bf16_t*)(ws + WS_W2T) + (size_t)i * 64 * 128, scr, kb * 64, nb * 32, lane); }
    }
    bf16_t* xn = (bf16_t*)(ws + WS_XN);
    for (int m = gw; m < MTOK; m += NGW) {
        const f32x4* xr = (const f32x4*)(a.x + (size_t)m * DM) + lane;
        f32x4 v[4]; float s = 0.f;
#pragma unroll
        for (int j = 0; j < 4; ++j) { v[j] = xr[64 * j]; s += (v[j].x * v[j].x + v[j].y * v[j].y) + (v[j].z * v[j].z + v[j].w * v[j].w); }
        s = wave_sum(s); const float rstd = rsqrtf(s * (1.f / DM) + RMS_EPS);
        unsigned long long* o8 = (unsigned long long*)(xn + (size_t)m * DM) + lane;
#pragma unroll
        for (int j = 0; j < 4; ++j) { const f32x4 gg = *((const f32x4*)a.norm1_g + lane + 64 * j);
            o8[64 * j] = (unsigned long long)pk2(v[j].x * rstd * gg.x, v[j].y * rstd * gg.y) | ((unsigned long long)pk2(v[j].z * rstd * gg.z, v[j].w * rstd * gg.w) << 32); }
    }
    float* tab = (float*)(ws + WS_ROPE);
    for (int i = gw * 64 + lane; i < MTOK * 8; i += NGW * 64) {
        const int m = i >> 3, f = i & 7;
        const float inv = powf(500000.0f, -(float)f * (2.0f / 16.0f));
        const float ang = (float)a.positions[m] * inv;
        tab[m * 16 + f] = cosf(ang); tab[m * 16 + 8 + f] = sinf(ang);
    }
}
__device__ __forceinline__ void p7_final(const Args& a, int vcu, int G, int wave, int lane) {
    const int gw = vcu * NWAVES + wave, NGW = G * NWAVES; const float* ss = (const float*)(a.ws + WS_SS3);
    for (int m = gw; m < MTOK; m += NGW) {
        const f32x4* sp = (const f32x4*)(ss + (size_t)m * 16); const f32x4 t = (sp[0] + sp[1]) + (sp[2] + sp[3]);
        const float rstd = rsqrtf(((t[0] + t[1]) + (t[2] + t[3])) * (1.f / DM) + RMS_EPS);
        f32x4* xr = (f32x4*)(a.out + (size_t)m * DM) + lane;
#pragma unroll
        for (int j = 0; j < 4; ++j) { const f32x4 gg = *((const f32x4*)a.final_g + lane + 64 * j); xr[64 * j] = xr[64 * j] * rstd * gg; }
    }
}

__global__ void __launch_bounds__(NWAVES * 64, 2) mk_fwd(Args args) {
    extern __shared__ __attribute__((aligned(16))) unsigned char lds_raw[];
    LAS unsigned char* lds = (LAS unsigned char*)lds_raw;
    volatile LAS unsigned* MISC = (volatile LAS unsigned*)(lds + MISC_OFF);
    const int tid = threadIdx.x, lane = tid & 63, wave = __builtin_amdgcn_readfirstlane(tid >> 6);
    const int G = gridDim.x; const int bx = blockIdx.x; const int vcu = (G % 8 == 0) ? (bx % 8) * (G / 8) + bx / 8 : bx;
    unsigned char* ws = args.ws;
    for (int u = tid; u < (LDS_BYTES - MISC_OFF) / 4; u += NWAVES * 64) ((LAS unsigned*)(lds + MISC_OFF))[u] = 0u;
    __syncthreads();
    const int lo = args.ph_lo, hi = args.ph_hi;
    const bool multi = (hi - lo) > 1;
    XcdBarrier bar; bar.bar = (unsigned*)(ws + WS_CTL) + CW_BAR; bar.x = 0; bar.st = nullptr;
    if (multi) bar = xcd_barrier_post((unsigned*)(ws + WS_CTL) + CW_BAR, MISC + 8);
#define IN(k) (lo <= (k) && (k) < hi)
#define REPB(k)
#define REPE
#define SEAM(k) do { if (IN(k) && IN((k) + 1)) xcd_barrier(bar); } while (0)
    if (IN(0)) { REPB(0) p0_prologue(args, lds, vcu, G, wave, lane); REPE SEAM(0); }
    if (IN(1)) { REPB(1)
        pg8::Gemm g{(const bf16_t*)(ws + WS_XN), (const bf16_t*)(ws + WS_WIN), MTOK, PJ, DM}; pg8::StaticOrder S; S.init(MTOK, PJ, G, bx);
        pg8::EpiProj E{(bf16_t*)(ws + WS_PROJ), (const float*)(ws + WS_ROPE), -1};
        pg8::gemm_phase<pg8::EpiProj, pg8::StaticOrder, PG8_ALIGN, PG8_SP2>(lds, g, S, E);
        REPE SEAM(1);
    }
    if (IN(2)) { REPB(2)
        if (!(args.flags & 1)) for (int u = vcu; u < 512; u += G) nsa::compress_unit(ws, args.cmp_pos, lds, u, wave, lane);
        if (!(args.flags & 2)) for (int u = vcu; u < 1024; u += G) gdn::prep_unit(args, lds, u, wave, lane);
        REPE SEAM(2);
    }
    if (IN(3)) { REPB(3)
        if (bx < BATCH * GH && !(args.flags & 4)) gdn::scan_unit(args, lds, bx, wave, lane);
        unsigned* qctr = (unsigned*)(ws + WS_CTL) + CW_QUEUE; LAS int* QW = (LAS int*)(lds + nsa::L_QUEUE);
        if (!(args.flags & 8)) for (;;) {
            if (tid == 0) *QW = (int)atomicAdd(qctr, 1u);
            __syncthreads();
            const int u = *QW;
            if (u >= 1024) break;
            nsa::attn_unit(ws, lds, (u & 31) >> 1, u & 1, 31 - (u >> 5), wave, lane);
        }
        REPE SEAM(3);
    }
    if (IN(4)) { REPB(4)
        pg8::Gemm g{(const bf16_t*)(ws + WS_MIX), (const bf16_t*)(ws + WS_WOUT), MTOK, DM, DM}; pg8::StaticOrder S; S.init(MTOK, DM, G, bx);
        pg8::EpiOut E{args.x, args.out, (bf16_t*)(ws + WS_XN), (float*)(ws + WS_SS2), (const float*)(ws + WS_SSQN), 8};
        pg8::gemm_phase<pg8::EpiOut, pg8::StaticOrder, PG8_ALIGN, PG8_SP2>(lds, g, S, E);
        REPE SEAM(4);
    }
    if (IN(5)) { REPB(5)
        pg8::Gemm g{(const bf16_t*)(ws + WS_XN), (const bf16_t*)(ws + WS_WGU), MTOK, 2 * DFF, DM}; pg8::StaticOrder S; S.init(MTOK, 2 * DFF, G, bx);
        pg8::EpiGU E{(bf16_t*)(ws + WS_PROJ), (const float*)(ws + WS_SS2), -1};
        pg8::gemm_phase<pg8::EpiGU, pg8::StaticOrder, PG8_ALIGN, PG8_SP2>(lds, g, S, E);
        REPE SEAM(5);
    }
    if (IN(6)) {
        pg8::Gemm g{(const bf16_t*)(ws + WS_PROJ), (const bf16_t*)(ws + WS_WDN), MTOK, DM, DFF}; pg8::StaticOrder S; S.init(MTOK, DM, G, bx);
        pg8::EpiDown E{args.out, (float*)(ws + WS_SS3), -1};
        pg8::gemm_phase<pg8::EpiDown, pg8::StaticOrder, PG8_ALIGN, PG8_SP2>(lds, g, S, E);
        SEAM(6);
    }
    if (IN(7)) p7_final(args, vcu, G, wave, lane);
#undef IN
#undef SEAM
}

extern "C" void kernel_launch(void* const* d_in, const int* in_sizes, int n_in, void* d_out, int out_size, void* d_ws, size_t ws_size, hipStream_t stream) {
    static int grid = 0;
    if (grid == 0) {
        if (n_in != 18 || ws_size < WS_END) { fprintf(stderr, "kernel_launch: unexpected inputs / workspace (%d, %zu)\n", n_in, ws_size); grid = -1; return; }
        int dev = 0, cus = 0;
        if (hipGetDevice(&dev) != hipSuccess || hipDeviceGetAttribute(&cus, hipDeviceAttributeMultiprocessorCount, dev) != hipSuccess) { grid = -1; return; }
        if (hipFuncSetAttribute((const void*)mk_fwd, hipFuncAttributeMaxDynamicSharedMemorySize, LDS_BYTES) != hipSuccess) { fprintf(stderr, "kernel_launch: hipFuncSetAttribute failed\n"); grid = -1; return; }
        (void)hipGetLastError();
        grid = cus;
    }
    if (grid < 0) return;
    (void)hipMemsetAsync((char*)d_ws + WS_CTL, 0, 1 * MiB, stream);
    Args a{};
    a.x = (const float*)d_in[0]; a.positions = (const int*)d_in[1]; a.norm1_g = (const float*)d_in[2]; a.w_in = (const float*)d_in[3]; a.cmp_pos = (const float*)d_in[4];
    a.cmp_w1 = (const float*)d_in[5]; a.cmp_w2 = (const float*)d_in[6]; a.nsa_norm_g = (const float*)d_in[7]; a.conv_w = (const float*)d_in[8]; a.a_log = (const float*)d_in[9];
    a.dt_bias = (const float*)d_in[10]; a.gdn_norm_g = (const float*)d_in[11]; a.w_out = (const float*)d_in[12]; a.norm2_g = (const float*)d_in[13]; a.w_gate = (const float*)d_in[14];
    a.w_up = (const float*)d_in[15]; a.w_down = (const float*)d_in[16]; a.final_g = (const float*)d_in[17];
    a.out = (float*)d_out; a.ws = (unsigned char*)d_ws;
    unsigned char* ws = (unsigned char*)d_ws;
    bf16_t* proj = (bf16_t*)(ws + WS_PROJ); bf16_t* mix = (bf16_t*)(ws + WS_MIX);
    auto launch = [&](int lo, int hi) { a.ph_lo = lo; a.ph_hi = hi; hipLaunchKernelGGL(mk_fwd, dim3(grid), dim3(NWAVES * 64), LDS_BYTES, stream, a); };
#if defined(PROBE_SUB3)
    launch(0, 4); (void)hipMemsetAsync((char*)d_ws + WS_CTL, 0, 1 * MiB, stream); a.flags = PROBE_SUB3; launch(3, 4); a.flags = 0; (void)hipMemsetAsync((char*)d_ws + WS_CTL, 0, 1 * MiB, stream); launch(4, 8);
#elif defined(PROBE_SUB)
    launch(0, 3); a.flags = PROBE_SUB; launch(2, 3); a.flags = 0; (void)hipMemsetAsync((char*)d_ws + WS_CTL, 0, 1 * MiB, stream); launch(3, 8);
#elif defined(PROBE_DUP)
    launch(0, PROBE_DUP + 1); (void)hipMemsetAsync((char*)d_ws + WS_CTL, 0, 1 * MiB, stream); launch(PROBE_DUP, 8);
#else
    launch(0, 8);
#endif
}
```

```cpp
#include <hip/hip_runtime.h>
#include <stdint.h>
#include <stdio.h>

typedef unsigned short bf16_t;

constexpr int BATCH = 16, SEQ = 2048, DM = 1024, MTOK = BATCH * SEQ;
constexpr int NSA_HEADS = 8, NSA_G = 2, HPG = 4, HD = 64;
constexpr int NCMP = 127, CMP_L = 32, CMP_S = 16, CMP_HID = 128;
constexpr int NSEL = 32, SELB = 64, TOPN = 8, WIN = 512;
constexpr int GH = 4, GD = 128, DFF = 2816;
constexpr int IN_W = 3360;
constexpr int PJ = 3584;
constexpr int PC_Q = 0, PC_KCMP = 512, PC_VCMP = 640, PC_KSLC = 768, PC_VSLC = 896, PC_KWIN = 1024, PC_VWIN = 1152;
constexpr int PC_GQ = 1280, PC_GK = 1792, PC_GV = 2304, PC_Z = 2816, PC_GATE = 3328, PC_B = 3352, PC_A = 3356;
constexpr float RMS_EPS = 1e-6f;
constexpr float QSCALE = 0.125f * 1.4426950408889634f;

constexpr size_t MiB = 1u << 20;
constexpr size_t WS_CTL = 0;
constexpr size_t WS_ROPE = 1 * MiB;
constexpr size_t WS_KC = 3 * MiB;
constexpr size_t WS_VC = 3 * MiB + 512 * 1024;
constexpr size_t WS_SSQN = 4 * MiB;
constexpr size_t WS_SS2 = 5 * MiB;
constexpr size_t WS_SS3 = 7 * MiB;
constexpr size_t WS_WIN = 9 * MiB;
constexpr size_t WS_WOUT = 16 * MiB;
constexpr size_t WS_WGU = 18 * MiB;
constexpr size_t WS_WDN = 29 * MiB;
constexpr size_t WS_W1T = 35 * MiB;
constexpr size_t WS_W2T = 36 * MiB;
constexpr size_t WS_GL = 37 * MiB;
constexpr size_t WS_XN = 40 * MiB;
constexpr size_t WS_MIX = 104 * MiB;
constexpr size_t WS_PROJ = 168 * MiB;
constexpr size_t WS_END = 392 * MiB;

__device__ __forceinline__ float bf2f(bf16_t v) { return __uint_as_float(((unsigned)v) << 16); }
__device__ __forceinline__ bf16_t f2bf(float f) { unsigned u = __float_as_uint(f); return (bf16_t)((u + 0x7fffu + ((u >> 16) & 1u)) >> 16); }
__device__ __forceinline__ float wave_sum(float v) {
#pragma unroll
    for (int o = 1; o < 64; o <<= 1) v += __shfl_xor(v, o);
    return v;
}
__device__ __forceinline__ float wave_max(float v) {
#pragma unroll
    for (int o = 1; o < 64; o <<= 1) v = fmaxf(v, __shfl_xor(v, o));
    return v;
}
__device__ __forceinline__ float siluf(float x) { return x * __builtin_amdgcn_rcpf(1.f + __builtin_amdgcn_exp2f(-1.4426950408889634f * x)); }
__device__ __forceinline__ float sigmf(float x) { return __builtin_amdgcn_rcpf(1.f + __builtin_amdgcn_exp2f(-1.4426950408889634f * x)); }

__host__ __device__ __forceinline__ int win_orig_col(int p) {
    if (p < 1280) return p;
    if (p < 2816) return p - 1280 + 1304;
    if (p < 3328) return p - 2816 + 2840;
    if (p < 3352) return p - 3328 + 1280;
    if (p < 3360) return p;
    return -1;
}
__global__ void __launch_bounds__(128) k_compress_naive(const bf16_t* proj, const float* cmp_pos, const float* w1, const float* w2, bf16_t* kc, bf16_t* vc) {
    int id = blockIdx.x; const int n = id & 127; id >>= 7; const int g = id & 1; id >>= 1; const int b = id & 15; const int i = id >> 4;
    const int j = threadIdx.x; __shared__ float hid[128];
    bf16_t* outp = (i == 0 ? kc : vc) + ((size_t)(b * 2 + g) * 128 + n) * 64;
    if (n == 127) { if (j < 64) outp[j] = 0; return; }
    const bf16_t* xb = proj + (size_t)(b * SEQ + 16 * n) * PJ + (i == 0 ? PC_KCMP : PC_VCMP) + g * 64;
    const float* pw = w1 + (size_t)i * 2048 * 128; const float* pp = cmp_pos + i * 2048;
    float acc = 0.f;
    for (int l = 0; l < 32; ++l)
        for (int d = 0; d < 64; ++d) acc += (bf2f(xb[(size_t)l * PJ + d]) + pp[l * 64 + d]) * pw[(size_t)(l * 64 + d) * 128 + j];
    hid[j] = siluf(acc); __syncthreads();
    if (j < 64) { float o = 0.f; const float* q = w2 + (size_t)i * 128 * 64;
        for (int jj = 0; jj < 128; ++jj) o += hid[jj] * q[jj * 64 + j];
        outp[j] = f2bf(o); }
}
__global__ void __launch_bounds__(256) k_nsa_naive(const bf16_t* proj, const bf16_t* kc, const bf16_t* vc, bf16_t* mix, float* ssqn) {
    const int m = blockIdx.x >> 1, g = blockIdx.x & 1, b = m / SEQ, t = m % SEQ;
    const int w = threadIdx.x >> 6, lane = threadIdx.x & 63, head = g * 4 + w, cur = t >> 6;
    __shared__ float sc[4][512]; __shared__ float imp[32]; __shared__ unsigned selmask; __shared__ int sellist[8];
    const float NEGB = -1e30f;
    float q[64];
    { const bf16_t* qp = proj + (size_t)m * PJ + PC_Q + head * 64;
#pragma unroll
      for (int d = 0; d < 64; ++d) q[d] = bf2f(qp[d]); }
    const size_t rowb = (size_t)b * SEQ;
    float o_cmp = 0.f;
    {
        const bf16_t* kcb = kc + (size_t)(b * 2 + g) * 128 * 64; const bf16_t* vcb = vc + (size_t)(b * 2 + g) * 128 * 64;
        float s[2]; float mx = NEGB;
#pragma unroll
        for (int i = 0; i < 2; ++i) { const int n = lane + 64 * i; float a = 0.f; const bf16_t* kp = kcb + n * 64;
#pragma unroll
            for (int d = 0; d < 64; ++d) a += q[d] * bf2f(kp[d]);
            const bool valid = (n < NCMP) && (16 * n + 31 <= t); s[i] = valid ? a : NEGB; mx = fmaxf(mx, s[i]); }
        mx = wave_max(mx); float p[2], sum = 0.f;
#pragma unroll
        for (int i = 0; i < 2; ++i) { p[i] = s[i] > -1e29f ? exp2f(s[i] - mx) : 0.f; sum += p[i]; }
        sum = wave_sum(sum); const float inv = (t >= 31 && sum > 0.f) ? 1.f / sum : 0.f;
#pragma unroll
        for (int i = 0; i < 2; ++i) sc[w][lane + 64 * i] = p[i] * inv;
        __syncthreads();
        for (int n = 0; n < NCMP; ++n) o_cmp += sc[w][n] * bf2f(vcb[n * 64 + lane]);
        if (threadIdx.x < 32) { const int s_ = threadIdx.x; float a = 0.f;
            for (int h = 0; h < 4; ++h) for (int n = 4 * s_ - 1; n <= 4 * s_ + 3; ++n) if (n >= 0 && n < NCMP) a += sc[h][n];
            imp[s_] = a; }
        __syncthreads();
        if (threadIdx.x == 0) { unsigned mask = 0u;
            for (int r = 0; r < TOPN; ++r) { float best = -3e38f; int bi = 0;
                for (int j = 0; j < NSEL; ++j) { if (mask >> j & 1u) continue;
                    const bool forced = (j == 0) || (j == cur) || (j == cur - 1);
                    const float v = forced ? 1e9f : (j <= cur ? imp[j] : NEGB);
                    if (v > best) { best = v; bi = j; } }
                mask |= 1u << bi; sellist[r] = bi; }
            selmask = mask; }
        __syncthreads();
    }
    float o_slc = 0.f;
    {
        float s[8]; float mx = NEGB;
#pragma unroll
        for (int i = 0; i < 8; ++i) { const int j = sellist[i]; const int kpos = 64 * j + lane; float a = NEGB;
            if (kpos <= t) { const bf16_t* kp = proj + (rowb + kpos) * PJ + PC_KSLC + g * 64; a = 0.f;
#pragma unroll
                for (int d = 0; d < 64; ++d) a += q[d] * bf2f(kp[d]); }
            s[i] = a; mx = fmaxf(mx, a); }
        mx = wave_max(mx); float sum = 0.f;
#pragma unroll
        for (int i = 0; i < 8; ++i) { s[i] = s[i] > -1e29f ? exp2f(s[i] - mx) : 0.f; sum += s[i]; }
        sum = wave_sum(sum); const float inv = 1.f / sum;
        __syncthreads();
#pragma unroll
        for (int i = 0; i < 8; ++i) sc[w][i * 64 + lane] = s[i] * inv;
        __syncthreads();
        for (int i = 0; i < 8; ++i) { const int j = sellist[i]; if (64 * j > t) continue;
            for (int kk = 0; kk < 64; ++kk) { const int kpos = 64 * j + kk; if (kpos > t) break;
                o_slc += sc[w][i * 64 + kk] * bf2f(proj[(rowb + kpos) * PJ + PC_VSLC + g * 64 + lane]); } }
    }
    float o_win = 0.f;
    {
        float s[8]; float mx = NEGB;
#pragma unroll
        for (int i = 0; i < 8; ++i) { const int kpos = t - 511 + lane + 64 * i; float a = NEGB;
            if (kpos >= 0) { const bf16_t* kp = proj + (rowb + kpos) * PJ + PC_KWIN + g * 64; a = 0.f;
#pragma unroll
                for (int d = 0; d < 64; ++d) a += q[d] * bf2f(kp[d]); }
            s[i] = a; mx = fmaxf(mx, a); }
        mx = wave_max(mx); float sum = 0.f;
#pragma unroll
        for (int i = 0; i < 8; ++i) { s[i] = s[i] > -1e29f ? exp2f(s[i] - mx) : 0.f; sum += s[i]; }
        sum = wave_sum(sum); const float inv = 1.f / sum;
        __syncthreads();
#pragma unroll
        for (int i = 0; i < 8; ++i) sc[w][i * 64 + lane] = s[i] * inv;
        __syncthreads();
        for (int kk = 0; kk < 512; ++kk) { const int kpos = t - 511 + kk; if (kpos < 0) continue;
            o_win += sc[w][kk] * bf2f(proj[(rowb + kpos) * PJ + PC_VWIN + g * 64 + lane]); }
    }
    const bf16_t* gp = proj + (size_t)m * PJ + PC_GATE + head * 3;
    const float o = sigmf(bf2f(gp[0])) * o_cmp + sigmf(bf2f(gp[1])) * o_slc + sigmf(bf2f(gp[2])) * o_win;
    mix[(size_t)m * DM + head * 64 + lane] = f2bf(o);
    const float ss = wave_sum(o * o);
    if (lane == 0) ssqn[m * 8 + head] = ss;
}
__global__ void __launch_bounds__(128) k_gdn_naive(const bf16_t* proj, const float* conv_w, const float* a_log, const float* dt_bias, const float* norm_g, bf16_t* mix) {
    const int b = blockIdx.x >> 2, h = blockIdx.x & 3, n = threadIdx.x, wv = n >> 6, lane = n & 63;
    __shared__ float shq[128], shk[128]; __shared__ float red[2][4];
    float S[128];
#pragma unroll
    for (int k = 0; k < 128; ++k) S[k] = 0.f;
    float wq[4], wk[4], wvv[4];
#pragma unroll
    for (int j = 0; j < 4; ++j) { wq[j] = conv_w[j * 1536 + h * 128 + n]; wk[j] = conv_w[j * 1536 + 512 + h * 128 + n]; wvv[j] = conv_w[j * 1536 + 1024 + h * 128 + n]; }
    float xq0 = 0.f, xq1 = 0.f, xq2 = 0.f, xk0 = 0.f, xk1 = 0.f, xk2 = 0.f, xv0 = 0.f, xv1 = 0.f, xv2 = 0.f;
    const float Aexp = -__expf(a_log[h]), dtb = dt_bias[h], ng = norm_g[n];
    for (int t = 0; t < SEQ; ++t) {
        const bf16_t* pr = proj + (size_t)(b * SEQ + t) * PJ;
        const float xq3 = bf2f(pr[PC_GQ + h * 128 + n]), xk3 = bf2f(pr[PC_GK + h * 128 + n]), xv3 = bf2f(pr[PC_GV + h * 128 + n]);
        float qv = siluf(wq[0] * xq0 + wq[1] * xq1 + wq[2] * xq2 + wq[3] * xq3);
        float kv = siluf(wk[0] * xk0 + wk[1] * xk1 + wk[2] * xk2 + wk[3] * xk3);
        const float vv = siluf(wvv[0] * xv0 + wvv[1] * xv1 + wvv[2] * xv2 + wvv[3] * xv3);
        xq0 = xq1; xq1 = xq2; xq2 = xq3; xk0 = xk1; xk1 = xk2; xk2 = xk3; xv0 = xv1; xv1 = xv2; xv2 = xv3;
        float sq = wave_sum(qv * qv), sk = wave_sum(kv * kv);
        if (lane == 0) { red[wv][0] = sq; red[wv][1] = sk; }
        __syncthreads();
        sq = red[0][0] + red[1][0]; sk = red[0][1] + red[1][1];
        qv *= rsqrtf(sq + RMS_EPS) * 0.08838834764831845f; kv *= rsqrtf(sk + RMS_EPS);
        shq[n] = qv; shk[n] = kv;
        __syncthreads();
        const float beta = sigmf(bf2f(pr[PC_B + h])); const float av = bf2f(pr[PC_A + h]) + dtb;
        const float sp = av > 20.f ? av : log1pf(__expf(av)); const float eg = __expf(Aexp * sp);
        float dot = 0.f;
#pragma unroll
        for (int k = 0; k < 128; ++k) dot += S[k] * shk[k];
        const float vn = beta * (vv - eg * dot);
        float o = 0.f;
#pragma unroll
        for (int k = 0; k < 128; ++k) { S[k] = eg * S[k] + shk[k] * vn; o += S[k] * shq[k]; }
        float so = wave_sum(o * o);
        if (lane == 0) red[wv][2] = so;
        __syncthreads();
        so = red[0][2] + red[1][2];
        const float z = bf2f(pr[PC_Z + h * 128 + n]);
        mix[(size_t)(b * SEQ + t) * DM + 512 + h * 128 + n] = f2bf(o * rsqrtf(so * (1.f / 128.f) + RMS_EPS) * ng * siluf(z));
    }
}

namespace pg8 {
#define PG8_LAS __attribute__((address_space(3)))
typedef unsigned short bf16_t;
typedef short bf16x8 __attribute__((ext_vector_type(8)));
typedef float f32x4 __attribute__((ext_vector_type(4)));
typedef unsigned u32x4 __attribute__((ext_vector_type(4)));
constexpr int BM = 256, BK = 64, HALF = 128, HTB = HALF * BK * 2  , STAGE_BYTES = 8 * HTB, NXCD = 8, WGM = 8;

__host__ __device__ __forceinline__ int lds_byte(int r, int c) { const int st = (r >> 4) * 2 + (c >> 5), rr = r & 15, cc = c & 31, ob = rr * 64 + cc * 2; return st * 1024 + (ob ^ (((ob >> 9) & 1) << 5)); }
__host__ __device__ __forceinline__ void stage_rc(int b, int& R, int& C) { const int st = b / 1024, sb = b % 1024, swz = sb ^ (((sb >> 9) & 1) << 5); R = (st >> 1) * 16 + swz / 64; C = (st & 1) * 32 + (swz % 64) / 2; }
__host__ __device__ __forceinline__ int perm32(int rho) { const int n = rho >> 4, i = rho & 15; return 8 * (i >> 2) + 4 * n + (i & 3); }

struct Unit { int pm, pn; };
struct Gemm { const bf16_t* A; const bf16_t* Bt; int M, N, K; };

struct StaticOrder {
    int nM, nN, nwg, G, c;
    __host__ __device__ void init(int M, int N, int G_, int c_) { nM = M / BM; nN = N / BM; nwg = nM * nN; G = G_; c = c_; }
    __host__ __device__ bool next(int i, Unit& u) const {
        const long L = (long)i * G + c; if (L >= nwg) return false;
        int wgid = (int)L; { const int q = nwg / NXCD, r = nwg % NXCD, xcd = wgid % NXCD, off = wgid / NXCD; wgid = (xcd < r ? xcd * (q + 1) : r * (q + 1) + (xcd - r) * q) + off; }
        const int nig = WGM * nN, gid = wgid / nig, fm = gid * WGM, gsz = (nM - fm) < WGM ? (nM - fm) : WGM;
        u.pm = fm + ((wgid % nig) % gsz); u.pn = (wgid % nig) / gsz; return true;
    }
    __device__ __forceinline__ void a_ready(const Unit&) const {}
    __device__ __forceinline__ void done(const Unit&) const {}
};
__device__ __forceinline__ unsigned cvt_pk_bf16(float lo, float hi) { unsigned r; asm volatile("v_cvt_pk_bf16_f32 %0, %1, %2" : "=v"(r) : "v"(lo), "v"(hi)); return r; }
typedef unsigned u32x2 __attribute__((ext_vector_type(2)));
__device__ __forceinline__ float fast_silu(float v) { return v * __builtin_amdgcn_rcpf(1.0f + __builtin_amdgcn_exp2f(-1.4426950408889634f * v)); }

struct EpiProj {
    static constexpr bool PERM = true, AFTER_DRAIN = false, MIDSCALE = false;
    bf16_t* out; const float* rope; int mid_t;
    __device__ __forceinline__ void midscale(f32x4 (&)[2][2][4][2], const Unit&, int, int) const {}
    __device__ __forceinline__ void operator()(const f32x4 (&acc)[2][2][4][2], const Unit& u, int wr, int wc, int fr, int fq) const {
        const int row0 = u.pm * BM + wr * 64 + fr, colt = u.pn * BM, lcol = wc * 32 + 8 * fq;
        const float sc = (u.pn < 2) ? QSCALE : 1.f;
        const bool wave_rope = ((wc & 1) == 0) && (u.pn < 5);
#pragma unroll
        for (int ai = 0; ai < 2; ++ai)
#pragma unroll
            for (int m = 0; m < 4; ++m) {
                const int r = row0 + ai * HALF + m * 16;
                f32x4 c0 = {1.f, 1.f, 1.f, 1.f}, c1 = c0, s0 = {0.f, 0.f, 0.f, 0.f}, s1 = s0;
                if (wave_rope) { const f32x4* tp = (const f32x4*)(rope + (size_t)r * 16); c0 = tp[0]; c1 = tp[1]; s0 = tp[2]; s1 = tp[3]; }
                bf16_t* rowp = out + (size_t)r * PJ + colt + lcol;
#pragma unroll
                for (int bj = 0; bj < 2; ++bj) {
                    f32x4 v0 = acc[ai][bj][m][0] * sc, v1 = acc[ai][bj][m][1] * sc;
                    const bool tile_rope = wave_rope && ((u.pn < 2) || (bj == 0));
                    if (tile_rope) {
                        f32x4 p0, p1;
#pragma unroll
                        for (int j = 0; j < 4; ++j) { p0[j] = __shfl_xor(v0[j], 16); p1[j] = __shfl_xor(v1[j], 16); }
                        if (fq == 0) { v0 = v0 * c0 - p0 * s0; v1 = v1 * c1 - p1 * s1; }
                        else if (fq == 1) { v0 = v0 * c0 + p0 * s0; v1 = v1 * c1 + p1 * s1; }
                    }
                    u32x4 w; w.x = cvt_pk_bf16(v0[0], v0[1]); w.y = cvt_pk_bf16(v0[2], v0[3]); w.z = cvt_pk_bf16(v1[0], v1[1]); w.w = cvt_pk_bf16(v1[2], v1[3]);
                    *(u32x4*)(rowp + bj * HALF) = w;
                }
            }
    }
};
struct EpiOut {
    static constexpr bool PERM = false, AFTER_DRAIN = false, MIDSCALE = true;
    const float* x; float* x1; bf16_t* x1b; float* ss2; const float* ssqn; int mid_t;
    __device__ __forceinline__ void midscale(f32x4 (&acc)[2][2][4][2], const Unit& u, int wr, int fr) const {
#pragma unroll
        for (int ai = 0; ai < 2; ++ai)
#pragma unroll
            for (int m = 0; m < 4; ++m) {
                const int r = u.pm * BM + ai * HALF + wr * 64 + m * 16 + fr;
                const f32x4 a = *(const f32x4*)(ssqn + (size_t)r * 8), b = *(const f32x4*)(ssqn + (size_t)r * 8 + 4);
                const float s = ((a[0] + a[1]) + (a[2] + a[3])) + ((b[0] + b[1]) + (b[2] + b[3]));
                const float rs = __builtin_amdgcn_rsqf(s * (1.0f / 512.0f) + RMS_EPS);
#pragma unroll
                for (int bj = 0; bj < 2; ++bj)
#pragma unroll
                    for (int n = 0; n < 2; ++n) acc[ai][bj][m][n] = acc[ai][bj][m][n] * rs;
            }
    }
    __device__ __forceinline__ void operator()(const f32x4 (&acc)[2][2][4][2], const Unit& u, int wr, int wc, int fr, int fq) const {
#pragma unroll
        for (int ai = 0; ai < 2; ++ai)
#pragma unroll
            for (int m = 0; m < 4; ++m) {
                const int r = u.pm * BM + ai * HALF + wr * 64 + m * 16 + fr; float ssum = 0.f;
#pragma unroll
                for (int bj = 0; bj < 2; ++bj)
#pragma unroll
                    for (int n = 0; n < 2; ++n) {
                        const size_t off = (size_t)r * DM + u.pn * BM + bj * HALF + wc * 32 + n * 16 + 4 * fq;
                        const f32x4 y = *(const f32x4*)(x + off) + acc[ai][bj][m][n];
                        u32x2 w; w.x = cvt_pk_bf16(y[0], y[1]); w.y = cvt_pk_bf16(y[2], y[3]); *(u32x2*)(x1b + off) = w;
                        ssum += (y[0] * y[0] + y[1] * y[1]) + (y[2] * y[2] + y[3] * y[3]);
                    }
                ssum += __shfl_xor(ssum, 16); ssum += __shfl_xor(ssum, 32);
                if (fq == 0) ss2[(size_t)r * 16 + u.pn * 4 + wc] = ssum;
            }
    }
};
struct EpiGU {
    static constexpr bool PERM = true, AFTER_DRAIN = false, MIDSCALE = false;
    bf16_t* h; const float* ss2; int mid_t;
    __device__ __forceinline__ void midscale(f32x4 (&)[2][2][4][2], const Unit&, int, int) const {}
    __device__ __forceinline__ void operator()(const f32x4 (&acc)[2][2][4][2], const Unit& u, int wr, int wc, int fr, int fq) const {
#pragma unroll
        for (int ai = 0; ai < 2; ++ai)
#pragma unroll
            for (int m = 0; m < 4; ++m) {
                const int r = u.pm * BM + ai * HALF + wr * 64 + m * 16 + fr;
                const f32x4* sp = (const f32x4*)(ss2 + (size_t)r * 16); const f32x4 a = sp[0], b = sp[1], c = sp[2], d = sp[3];
                const f32x4 t = (a + b) + (c + d); const float s = (t[0] + t[1]) + (t[2] + t[3]);
                const float rs = __builtin_amdgcn_rsqf(s * (1.0f / 1024.0f) + RMS_EPS);
                const f32x4 g0 = acc[ai][0][m][0] * rs, g1 = acc[ai][0][m][1] * rs, u0 = acc[ai][1][m][0] * rs, u1 = acc[ai][1][m][1] * rs;
                float o[8];
#pragma unroll
                for (int j = 0; j < 4; ++j) { o[j] = fast_silu(g0[j]) * u0[j]; o[4 + j] = fast_silu(g1[j]) * u1[j]; }
                u32x4 w; w.x = cvt_pk_bf16(o[0], o[1]); w.y = cvt_pk_bf16(o[2], o[3]); w.z = cvt_pk_bf16(o[4], o[5]); w.w = cvt_pk_bf16(o[6], o[7]);
                *(u32x4*)(h + (size_t)r * DFF + u.pn * 128 + wc * 32 + 8 * fq) = w;
            }
    }
};
struct EpiDown {
    static constexpr bool PERM = false, AFTER_DRAIN = false, MIDSCALE = false;
    float* x1; const bf16_t* x1b; float* ss3; int mid_t;
    __device__ __forceinline__ void midscale(f32x4 (&)[2][2][4][2], const Unit&, int, int) const {}
    __device__ __forceinline__ void operator()(const f32x4 (&acc)[2][2][4][2], const Unit& u, int wr, int wc, int fr, int fq) const {
#pragma unroll
        for (int ai = 0; ai < 2; ++ai)
#pragma unroll
            for (int m = 0; m < 4; ++m) {
                const int r = u.pm * BM + ai * HALF + wr * 64 + m * 16 + fr; float ssum = 0.f;
#pragma unroll
                for (int bj = 0; bj < 2; ++bj)
#pragma unroll
                    for (int n = 0; n < 2; ++n) {
                        const size_t off = (size_t)r * DM + u.pn * BM + bj * HALF + wc * 32 + n * 16 + 4 * fq;
                        const u32x2 xb = *(const u32x2*)(x1b + off);
                        const f32x4 xr = {__uint_as_float(xb.x << 16), __uint_as_float(xb.x & 0xffff0000u), __uint_as_float(xb.y << 16), __uint_as_float(xb.y & 0xffff0000u)};
                        const f32x4 y = xr + acc[ai][bj][m][n];
                        *(f32x4*)(x1 + off) = y;
                        ssum += (y[0] * y[0] + y[1] * y[1]) + (y[2] * y[2] + y[3] * y[3]);
                    }
                ssum += __shfl_xor(ssum, 16); ssum += __shfl_xor(ssum, 32);
                if (fq == 0) ss3[(size_t)r * 16 + u.pn * 4 + wc] = ssum;
            }
    }
};
template <class Epi, class Sched, bool ALIGN_EPI = false, bool SP2 = false>
__device__ __forceinline__ void gemm_phase(PG8_LAS unsigned char* lds, const Gemm g, const Sched& S, const Epi& E) {
    const int tid = threadIdx.x, wid = __builtin_amdgcn_readfirstlane(tid >> 6), lane = tid & 63, wr = wid >> 2, wc = wid & 3, fr = lane & 15, fq = lane >> 4;
    const int K = g.K, nt = K / BK;
    unsigned voffA[2], voffB[2];
#pragma unroll
    for (int i = 0; i < 2; ++i) { int R, C; stage_rc(tid * 16 + i * 8192, R, C); const int Rb = Epi::PERM ? ((R & ~31) + perm32(R & 31)) : R;
        voffA[i] = (unsigned)(R * K + C) * 2u; voffB[i] = (unsigned)(Rb * K + C) * 2u; }
    const size_t kstep = (size_t)(BK * 2);
    const size_t hstep = (size_t)HALF * K * 2;
    const size_t tstep = 2 * hstep;
    const unsigned ldsw = (unsigned)wid * 1024u;
    const int aoff = lds_byte(wr * 64 + fr, fq * 8), boff = lds_byte(wc * 32 + fr, fq * 8);
#define PG8_SA(b, h) (((b) * 2 + (h)) * HTB)
#define PG8_SB(b, h) ((4 + (b) * 2 + (h)) * HTB)
#define PG8_STAGE(bufoff, gbase, voff) do { _Pragma("unroll") for (int _i = 0; _i < 2; ++_i) \
        __builtin_amdgcn_global_load_lds((const unsigned*)((const char*)(gbase) + (voff)[_i]), (PG8_LAS unsigned*)(lds + (bufoff) + ldsw + _i * 8192), 16, 0, 0); } while (0)
#define PG8_LDA(dst, b, h) do { _Pragma("unroll") for (int m = 0; m < 4; ++m) _Pragma("unroll") for (int k = 0; k < 2; ++k) dst[m][k] = *(const PG8_LAS bf16x8*)(lds + PG8_SA(b, h) + aoff + m * 2048 + k * 1024); } while (0)
#define PG8_LDB(dst, b, h) do { _Pragma("unroll") for (int n = 0; n < 2; ++n) _Pragma("unroll") for (int k = 0; k < 2; ++k) dst[n][k] = *(const PG8_LAS bf16x8*)(lds + PG8_SB(b, h) + boff + n * 2048 + k * 1024); } while (0)
#define PG8_MMA(ai, bj, At, Bt) do { __builtin_amdgcn_s_setprio(1); _Pragma("unroll") for (int m = 0; m < 4; ++m) _Pragma("unroll") for (int n = 0; n < 2; ++n) _Pragma("unroll") for (int k = 0; k < 2; ++k) \
        acc[ai][bj][m][n] = __builtin_amdgcn_mfma_f32_16x16x32_bf16(Bt[n][k], At[m][k], acc[ai][bj][m][n], 0, 0, 0); __builtin_amdgcn_s_setprio(0); } while (0)
#define PG8_WAIT_V(n) asm volatile("s_waitcnt vmcnt(" #n ")" ::: "memory")
#define PG8_WAIT_L(n) asm volatile("s_waitcnt lgkmcnt(" #n ")" ::: "memory")
#define PG8_BAR __builtin_amdgcn_s_barrier()
#define PG8_SCHED __builtin_amdgcn_sched_barrier(0)
    Unit cur, nxt; int ui = 0;
    if (!S.next(0, cur)) return;
    f32x4 acc[2][2][4][2];
#pragma unroll
    for (int a = 0; a < 2; ++a)
#pragma unroll
        for (int b = 0; b < 2; ++b)
#pragma unroll
            for (int m = 0; m < 4; ++m)
#pragma unroll
                for (int n = 0; n < 2; ++n) acc[a][b][m][n] = (f32x4){0.f, 0.f, 0.f, 0.f};
    bf16x8 At[4][2], B0[2][2], B1[2][2];
    const char* cA = (const char*)g.A + (size_t)cur.pm * tstep; const char* cB = (const char*)g.Bt + (size_t)cur.pn * tstep;
    S.a_ready(cur);
    if constexpr (SP2) {
        PG8_STAGE(PG8_SB(0, 0), cB, voffB); PG8_STAGE(PG8_SB(0, 1), cB + hstep, voffB); PG8_STAGE(PG8_SA(0, 0), cA, voffA); PG8_STAGE(PG8_SA(0, 1), cA + hstep, voffA);
        if (wr == 1) PG8_BAR;
        PG8_WAIT_V(2); PG8_BAR;
        PG8_STAGE(PG8_SB(1, 0), cB + kstep, voffB); PG8_STAGE(PG8_SA(1, 0), cA + kstep, voffA); PG8_STAGE(PG8_SB(1, 1), cB + hstep + kstep, voffB);
        PG8_WAIT_V(6); PG8_BAR;
    } else {
        PG8_STAGE(PG8_SB(0, 0), cB, voffB); PG8_STAGE(PG8_SA(0, 0), cA, voffA); PG8_STAGE(PG8_SB(0, 1), cB + hstep, voffB); PG8_STAGE(PG8_SA(0, 1), cA + hstep, voffA);
        if (wr == 1) PG8_BAR;
        PG8_WAIT_V(4); PG8_BAR;
        PG8_STAGE(PG8_SB(1, 0), cB + kstep, voffB); PG8_STAGE(PG8_SA(1, 0), cA + kstep, voffA); PG8_STAGE(PG8_SB(1, 1), cB + hstep + kstep, voffB);
        PG8_WAIT_V(6); PG8_BAR;
    }
    for (;;) {
        const bool has_next = S.next(ui + 1, nxt);
        const char* nA = has_next ? (const char*)g.A + (size_t)nxt.pm * tstep : cA; const char* nB = has_next ? (const char*)g.Bt + (size_t)nxt.pn * tstep : cB;
        for (int t = 0; t < nt; t += 2) {
            const bool last = (t == nt - 2);
            if constexpr (Epi::MIDSCALE) { if (t == E.mid_t) E.midscale(acc, cur, wr, fr); }
            const char* a1 = cA + (size_t)(t + 1) * kstep;
            const char* a2 = last ? nA : cA + (size_t)(t + 2) * kstep; const char* b2 = last ? nB : cB + (size_t)(t + 2) * kstep;
            const char* a3 = a2 + kstep; const char* b3 = b2 + kstep;
            if (last && has_next) S.a_ready(nxt);
            if constexpr (SP2) {
            PG8_LDB(B0, 0, 0); PG8_LDB(B1, 0, 1); PG8_SCHED; PG8_LDA(At, 0, 0); PG8_STAGE(PG8_SA(1, 1), a1 + hstep, voffA);
            PG8_WAIT_V(8); PG8_WAIT_L(0); PG8_BAR; PG8_MMA(0, 0, At, B0); PG8_MMA(0, 1, At, B1); PG8_BAR; PG8_SCHED;
            PG8_LDA(At, 0, 1); PG8_STAGE(PG8_SB(0, 0), b2, voffB); PG8_STAGE(PG8_SB(0, 1), b2 + hstep, voffB); PG8_STAGE(PG8_SA(0, 0), a2, voffA);
            PG8_WAIT_V(8); PG8_WAIT_L(0); PG8_BAR; PG8_MMA(1, 0, At, B0); PG8_MMA(1, 1, At, B1); PG8_BAR; PG8_SCHED;
            PG8_LDB(B0, 1, 0); PG8_LDB(B1, 1, 1); PG8_SCHED; PG8_LDA(At, 1, 0); PG8_STAGE(PG8_SA(0, 1), a2 + hstep, voffA);
            PG8_WAIT_V(8); PG8_WAIT_L(0); PG8_BAR; PG8_MMA(0, 0, At, B0); PG8_MMA(0, 1, At, B1); PG8_BAR; PG8_SCHED;
            PG8_LDA(At, 1, 1); PG8_STAGE(PG8_SB(1, 0), b3, voffB); PG8_STAGE(PG8_SB(1, 1), b3 + hstep, voffB); PG8_STAGE(PG8_SA(1, 0), a3, voffA);
            PG8_WAIT_V(8); PG8_WAIT_L(0); PG8_BAR; PG8_MMA(1, 0, At, B0); PG8_MMA(1, 1, At, B1); PG8_BAR; PG8_SCHED;
            } else {
            PG8_LDB(B0, 0, 0); PG8_SCHED; PG8_LDA(At, 0, 0); PG8_STAGE(PG8_SA(1, 1), a1 + hstep, voffA);
            PG8_WAIT_L(8); PG8_BAR; PG8_WAIT_L(0); PG8_MMA(0, 0, At, B0); PG8_BAR; PG8_SCHED;
            PG8_LDB(B1, 0, 1); PG8_STAGE(PG8_SB(0, 0), b2, voffB);
            PG8_BAR; PG8_WAIT_L(0); PG8_MMA(0, 1, At, B1); PG8_BAR;
            PG8_LDA(At, 0, 1); PG8_STAGE(PG8_SA(0, 0), a2, voffA);
            PG8_BAR; PG8_WAIT_L(0); PG8_MMA(1, 0, At, B0); PG8_BAR; PG8_SCHED;
            PG8_STAGE(PG8_SB(0, 1), b2 + hstep, voffB);
            PG8_WAIT_V(6); PG8_BAR; PG8_MMA(1, 1, At, B1); PG8_BAR;
            PG8_LDB(B0, 1, 0); PG8_SCHED; PG8_LDA(At, 1, 0); PG8_STAGE(PG8_SA(0, 1), a2 + hstep, voffA);
            PG8_WAIT_L(8); PG8_BAR; PG8_WAIT_L(0); PG8_MMA(0, 0, At, B0); PG8_BAR; PG8_SCHED;
            PG8_LDB(B1, 1, 1); PG8_STAGE(PG8_SB(1, 0), b3, voffB);
            PG8_BAR; PG8_WAIT_L(0); PG8_MMA(0, 1, At, B1); PG8_BAR;
            PG8_LDA(At, 1, 1); PG8_STAGE(PG8_SA(1, 0), a3, voffA);
            PG8_BAR; PG8_WAIT_L(0); PG8_MMA(1, 0, At, B0); PG8_BAR; PG8_SCHED;
            PG8_STAGE(PG8_SB(1, 1), b3 + hstep, voffB);
            PG8_WAIT_V(6); PG8_BAR; PG8_MMA(1, 1, At, B1); PG8_BAR;
            }
        }
        if constexpr (ALIGN_EPI) { if (wr == 0) PG8_BAR; }
        if constexpr (!Epi::AFTER_DRAIN) { E(acc, cur, wr, wc, fr, fq); S.done(cur); }
        if (!has_next) break;
#pragma unroll
        for (int a = 0; a < 2; ++a)
#pragma unroll
            for (int b = 0; b < 2; ++b)
#pragma unroll
                for (int m = 0; m < 4; ++m)
#pragma unroll
                    for (int n = 0; n < 2; ++n) acc[a][b][m][n] = (f32x4){0.f, 0.f, 0.f, 0.f};
        cur = nxt; cA = nA; cB = nB; ++ui;
        if constexpr (ALIGN_EPI) { if (wr == 1) PG8_BAR; }
    }
    PG8_WAIT_V(0);
    if constexpr (!ALIGN_EPI) { if (wr == 0) PG8_BAR; }
    PG8_BAR;
    if constexpr (Epi::AFTER_DRAIN) { E.fused(acc, cur, wr, wc, fr, fq, lds, wid, lane); S.done(cur); }
#undef PG8_SA
#undef PG8_SB
#undef PG8_STAGE
#undef PG8_LDA
#undef PG8_LDB
#undef PG8_MMA
#undef PG8_WAIT_V
#undef PG8_WAIT_L
#undef PG8_BAR
#undef PG8_SCHED
}
}

#ifndef PG8_SP2
#define PG8_SP2 true
#endif

#define LAS __attribute__((address_space(3)))
#define XB_TMO      128
#define XB_XCNT(j)  (256  + 64 * (j))
#define XB_XSUB(j)  (1280 + 64 * (j))
#define XB_XGEN(j)  (2304 + 64 * (j))
#define XB_TOP      3328
#define XB_TOPGEN   3392
#define XCD_BAR_WORDS 3456
#define XB_SPIN_CAP (1u << 18)

__device__ __forceinline__ unsigned xb_ld(unsigned* p)              { return __hip_atomic_load(p, __ATOMIC_RELAXED, __HIP_MEMORY_SCOPE_AGENT); }
__device__ __forceinline__ unsigned xb_add(unsigned* p, unsigned v) { return __hip_atomic_fetch_add(p, v, __ATOMIC_RELAXED, __HIP_MEMORY_SCOPE_AGENT); }
__device__ __forceinline__ unsigned xb_xcc_id() { return (unsigned)__builtin_amdgcn_s_getreg((3 << 11) | 20) & 0xFu; }
#define XB_SPIN(cond, bar) do { unsigned _sp = 0; while (cond) { __builtin_amdgcn_s_sleep(1); \
    if ((++_sp & 255u) == 0u) { if (xb_ld(&(bar)[XB_TMO])) break; if (_sp > XB_SPIN_CAP) { atomicAdd(&(bar)[XB_TMO], 1u); break; } } } } while (0)

struct XcdBarrier {
    unsigned* bar; unsigned x;
    volatile LAS unsigned* st;
};

__device__ __forceinline__ XcdBarrier xcd_barrier_post(unsigned* bar, volatile LAS unsigned* st) {
    XcdBarrier b; b.bar = bar; b.x = xb_xcc_id(); b.st = st;
    if (threadIdx.x == 0) (void)xb_add(&bar[XB_XCNT(b.x)], 1u);
    return b;
}
__device__ __forceinline__ void xcd_barrier_complete(unsigned* bar, unsigned x, unsigned& nloc, unsigned& nx) {
    const unsigned G = gridDim.x * gridDim.y * gridDim.z;
    unsigned sum, cnt, mine, sp = 0u;
    for (;;) {
        sum = 0u; cnt = 0u; mine = 0u;
#pragma unroll
        for (unsigned j = 0; j < 16; ++j) { const unsigned c = xb_ld(&bar[XB_XCNT(j)]); sum += c; cnt += (c > 0u) ? 1u : 0u; mine = (j == x) ? c : mine; }
        if (sum == G) break;
        __builtin_amdgcn_s_sleep(1);
        if ((++sp & 255u) == 0u) { if (xb_ld(&bar[XB_TMO])) break; if (sp > XB_SPIN_CAP) { atomicAdd(&bar[XB_TMO], 1u); break; } }
    }
    nloc = mine > 0u ? mine : 1u; nx = cnt > 0u ? cnt : 1u;
}

__device__ __forceinline__ void xcd_barrier(const XcdBarrier& b) {
    asm volatile("s_waitcnt vmcnt(0)" ::: "memory");
    __syncthreads();
    if (threadIdx.x == 0) {
        unsigned* bar = b.bar;
        __builtin_amdgcn_s_waitcnt(0);
        unsigned nloc = b.st[0], nx = b.st[1];
        if (nloc == 0u) { xcd_barrier_complete(bar, b.x, nloc, nx); b.st[0] = nloc; b.st[1] = nx; }
        const unsigned old = xb_add(&bar[XB_XSUB(b.x)], 1u);
        const unsigned gen = old / nloc;
        if (old + 1u == (gen + 1u) * nloc) {
            __builtin_amdgcn_fence(__ATOMIC_RELEASE, "agent");
            asm volatile("s_waitcnt vmcnt(0)" ::: "memory");
            const unsigned og = xb_add(&bar[XB_TOP], 1u);
            const unsigned tg = og / nx;
            if (og + 1u == (tg + 1u) * nx) xb_add(&bar[XB_TOPGEN], 1u);
            else XB_SPIN(xb_ld(&bar[XB_TOPGEN]) == tg, bar);
            __builtin_amdgcn_fence(__ATOMIC_ACQUIRE, "agent");
            xb_add(&bar[XB_XGEN(b.x)], 1u);
            asm volatile("s_waitcnt vmcnt(0)" ::: "memory");
        } else {
            XB_SPIN(xb_ld(&bar[XB_XGEN(b.x)]) == gen, bar);
            __builtin_amdgcn_fence(__ATOMIC_ACQUIRE, "agent");
            asm volatile("s_waitcnt vmcnt(0)" ::: "memory");
        }
    }
    __syncthreads();
}

struct Args {
    const float* x; const int* positions; const float* norm1_g; const float* w_in; const float* cmp_pos; const float* cmp_w1; const float* cmp_w2;
    const float* nsa_norm_g; const float* conv_w; const float* a_log; const float* dt_bias; const float* gdn_norm_g; const float* w_out; const float* norm2_g;
    const float* w_gate; const float* w_up; const float* w_down; const float* final_g;
    float* out; unsigned char* ws; int ph_lo, ph_hi, flags, pad;
};

#ifndef LAS
#define LAS __attribute__((address_space(3)))
#endif
namespace nsa {
typedef float f32x16 __attribute__((ext_vector_type(16)));
typedef float f32x4 __attribute__((ext_vector_type(4)));
typedef float f32x2 __attribute__((ext_vector_type(2)));
typedef __bf16 bf16x2_t __attribute__((ext_vector_type(2)));
typedef short bf16x8 __attribute__((ext_vector_type(8)));
typedef short s16x4 __attribute__((ext_vector_type(4)));
typedef unsigned u32x4 __attribute__((ext_vector_type(4)));
typedef unsigned u32x2 __attribute__((ext_vector_type(2)));

constexpr int L_KV = 0, KV_STAGE = 16384;
constexpr int L_IMP = 49152;
constexpr int L_SELM = 81920;
constexpr int L_UNION = 81920 + 256;
constexpr int L_QUEUE = 81920 + 260;
constexpr int L_RED = 0;
constexpr int L_HT = 81920 + 512;
constexpr float THR = 8.0f;
constexpr float NEG_INF = -__builtin_inff();

__device__ __forceinline__ int crow(int r, int hi) { return (r & 3) + 8 * (r >> 2) + 4 * hi; }
__device__ __forceinline__ unsigned cvtpk(float lo, float hi) { f32x2 v = {lo, hi}; bf16x2_t b = __builtin_convertvector(v, bf16x2_t); return __builtin_bit_cast(unsigned, b); }
__device__ __forceinline__ bf16x8 pack8(float a0, float a1, float a2, float a3, float a4, float a5, float a6, float a7) {
    u32x4 w; w.x = cvtpk(a0, a1); w.y = cvtpk(a2, a3); w.z = cvtpk(a4, a5); w.w = cvtpk(a6, a7); return __builtin_bit_cast(bf16x8, w); }
__device__ __forceinline__ void dma_tile(const unsigned char* gbase, size_t pitch, LAS unsigned char* dst, int wave, int lane) {
    const int row = wave * 8 + (lane >> 3); const int c = (lane & 7) ^ (lane >> 3);
    __builtin_amdgcn_global_load_lds((const unsigned*)(gbase + (size_t)row * pitch + c * 16), (LAS unsigned*)(dst + wave * 1024), 16, 0, 0);
}
typedef short v4i16_t __attribute__((ext_vector_type(4)));
__device__ __forceinline__ s16x4 vtr(LAS const unsigned char* p) { return __builtin_bit_cast(s16x4, __builtin_amdgcn_ds_read_tr16_b64_v4i16((LAS v4i16_t*)p)); }

__device__ __forceinline__ void qk_tile(f32x16& p0, f32x16& p1, LAS const unsigned char* kbuf, const bf16x8 (&qr)[4], int r32, int hi, const f32x16& cinit) {
    LAS const unsigned char* k0 = kbuf + r32 * 128; const int sw = r32 & 7;
    { const int off = ((0 + hi) ^ sw) << 4;
      p0 = __builtin_amdgcn_mfma_f32_32x32x16_bf16(*(LAS const bf16x8*)(k0 + off), qr[0], cinit, 0, 0, 0);
      p1 = __builtin_amdgcn_mfma_f32_32x32x16_bf16(*(LAS const bf16x8*)(k0 + 4096 + off), qr[0], cinit, 0, 0, 0); }
#pragma unroll
    for (int ds = 1; ds < 4; ++ds) {
        const int off = ((2 * ds + hi) ^ sw) << 4;
        const bf16x8 a0 = *(LAS const bf16x8*)(k0 + off), a1 = *(LAS const bf16x8*)(k0 + 4096 + off);
        p0 = __builtin_amdgcn_mfma_f32_32x32x16_bf16(a0, qr[ds], p0, 0, 0, 0);
        p1 = __builtin_amdgcn_mfma_f32_32x32x16_bf16(a1, qr[ds], p1, 0, 0, 0);
    }
}
#define NSA_TR(dst, addr, off) asm volatile("ds_read_b64_tr_b16 %0, %1 offset:%c2" : "=&v"(dst) : "v"(addr), "i"(off) : "memory")
__device__ __forceinline__ void pv_tile(f32x16 (&o)[2], unsigned va0, unsigned va1, const bf16x8 (&pb)[4]) {
    s16x4 lo[4], hh[4];
    NSA_TR(lo[0], va0, 0); NSA_TR(hh[0], va0, 1024); NSA_TR(lo[1], va0, 2048); NSA_TR(hh[1], va0, 3072);
    NSA_TR(lo[2], va0, 4096); NSA_TR(hh[2], va0, 5120); NSA_TR(lo[3], va0, 6144); NSA_TR(hh[3], va0, 7168);
    asm volatile("s_waitcnt lgkmcnt(0)" ::: "memory"); __builtin_amdgcn_sched_barrier(0);
#pragma unroll
    for (int ks = 0; ks < 4; ++ks) { const bf16x8 a = {lo[ks][0], lo[ks][1], lo[ks][2], lo[ks][3], hh[ks][0], hh[ks][1], hh[ks][2], hh[ks][3]};
        o[0] = __builtin_amdgcn_mfma_f32_32x32x16_bf16(a, pb[ks], o[0], 0, 0, 0); }
    s16x4 lo2[4], hh2[4];
    NSA_TR(lo2[0], va1, 0); NSA_TR(hh2[0], va1, 1024); NSA_TR(lo2[1], va1, 2048); NSA_TR(hh2[1], va1, 3072);
    NSA_TR(lo2[2], va1, 4096); NSA_TR(hh2[2], va1, 5120); NSA_TR(lo2[3], va1, 6144); NSA_TR(hh2[3], va1, 7168);
    asm volatile("s_waitcnt lgkmcnt(0)" ::: "memory"); __builtin_amdgcn_sched_barrier(0);
#pragma unroll
    for (int ks = 0; ks < 4; ++ks) { const bf16x8 a = {lo2[ks][0], lo2[ks][1], lo2[ks][2], lo2[ks][3], hh2[ks][0], hh2[ks][1], hh2[ks][2], hh2[ks][3]};
        o[1] = __builtin_amdgcn_mfma_f32_32x32x16_bf16(a, pb[ks], o[1], 0, 0, 0); }
}
__device__ __forceinline__ float max3f(float a, float b, float c) { return __builtin_fmaxf(__builtin_fmaxf(a, b), c); }
__device__ __forceinline__ float max32(const f32x16& p, const f32x16& q) {
    float a = max3f(p[0], p[1], p[2]), b = max3f(q[0], q[1], q[2]);
    a = max3f(a, p[3], p[4]); b = max3f(b, q[3], q[4]); a = max3f(a, p[5], p[6]); b = max3f(b, q[5], q[6]);
    a = max3f(a, p[7], p[8]); b = max3f(b, q[7], q[8]); a = max3f(a, p[9], p[10]); b = max3f(b, q[9], q[10]);
    a = max3f(a, p[11], p[12]); b = max3f(b, q[11], q[12]); a = max3f(a, p[13], p[14]); b = max3f(b, q[13], q[14]);
    return max3f(a, b, __builtin_fmaxf(p[15], q[15]));
}
__device__ __forceinline__ float max16(const f32x16& p) {
    float a = max3f(p[0], p[1], p[2]), b = max3f(p[3], p[4], p[5]); a = max3f(a, p[6], p[7]); b = max3f(b, p[8], p[9]);
    a = max3f(a, p[10], p[11]); b = max3f(b, p[12], p[13]); return max3f(a, b, __builtin_fmaxf(p[14], p[15]));
}
__device__ __forceinline__ float sum16(const f32x16& p) {
    return (((p[0] + p[1]) + (p[2] + p[3])) + ((p[4] + p[5]) + (p[6] + p[7]))) + (((p[8] + p[9]) + (p[10] + p[11])) + ((p[12] + p[13]) + (p[14] + p[15])));
}
__device__ __forceinline__ void mask_tile(f32x16& p0, f32x16& p1, int key0, int hi, int lo, int hi_) {
    const int rlo = lo - key0 - 4 * hi, rhi = hi_ - key0 - 4 * hi;
#pragma unroll
    for (int r = 0; r < 16; ++r) { const int k = (r & 3) + 8 * (r >> 2);
        p0[r] = (k >= rlo && k <= rhi) ? p0[r] : NEG_INF; p1[r] = (k + 32 >= rlo && k + 32 <= rhi) ? p1[r] : NEG_INF; }
}
__device__ __forceinline__ void attn_tile(LAS const unsigned char* kbuf, unsigned vb0, unsigned vb1, const bf16x8 (&qr)[4],
                                          f32x16 (&o)[2], f32x16& negm, float& mref, float& l, bool& seen, int key0, int lo, int hi_, int mode, bool lanesel, int r32, int hi) {
    f32x16 p0, p1;
    if (mode == 0) qk_tile(p0, p1, kbuf, qr, r32, hi, negm);
    else { f32x16 ci;
#pragma unroll
        for (int r = 0; r < 16; ++r) ci[r] = lanesel ? negm[r] : NEG_INF;
        qk_tile(p0, p1, kbuf, qr, r32, hi, ci);
        if (mode == 2) mask_tile(p0, p1, key0, hi, lo, hi_); }
    float mx = max32(p0, p1); mx = fmaxf(mx, __shfl_xor(mx, 32));
    const bool fin = mx > -1e29f;
    const float d = seen ? (mx > THR ? mx : 0.f) : (fin ? mx : 0.f);
    if (__any(d != 0.f)) {
        const float f = seen ? __builtin_amdgcn_exp2f(-d) : 1.f;
        mref += d; l *= f; o[0] = o[0] * f; o[1] = o[1] * f;
#pragma unroll
        for (int r = 0; r < 16; ++r) { p0[r] -= d; p1[r] -= d; negm[r] = -mref; }
    }
    seen = seen || fin;
#pragma unroll
    for (int r = 0; r < 16; ++r) { p0[r] = __builtin_amdgcn_exp2f(p0[r]); p1[r] = __builtin_amdgcn_exp2f(p1[r]); }
    l += sum16(p0) + sum16(p1);
    bf16x8 pb[4];
    pb[0] = pack8(p0[0], p0[1], p0[2], p0[3], p0[4], p0[5], p0[6], p0[7]); pb[1] = pack8(p0[8], p0[9], p0[10], p0[11], p0[12], p0[13], p0[14], p0[15]);
    pb[2] = pack8(p1[0], p1[1], p1[2], p1[3], p1[4], p1[5], p1[6], p1[7]); pb[3] = pack8(p1[8], p1[9], p1[10], p1[11], p1[12], p1[13], p1[14], p1[15]);
    pv_tile(o, vb0, vb1, pb);
}

__device__ __forceinline__ void attn_unit(unsigned char* ws, LAS unsigned char* lds, int b, int g, int qb, int wave, int lane) {
    const int tid = threadIdx.x, r32 = lane & 31, hi = lane >> 5, hh = wave >> 1, th = wave & 1, head = g * 4 + hh;
    const int tl = 32 * th + r32, t = 64 * qb + tl; const size_t m = (size_t)b * SEQ + t;
    const bf16_t* proj = (const bf16_t*)(ws + WS_PROJ);
    const unsigned char* pb_ = (const unsigned char*)(proj + (size_t)b * SEQ * PJ);
    LAS unsigned char* kv = lds + L_KV; const unsigned kva = (unsigned)(uintptr_t)kv;
    LAS float* IMP = (LAS float*)(lds + L_IMP); LAS unsigned* SELM = (LAS unsigned*)(lds + L_SELM); LAS unsigned* UNI = (LAS unsigned*)(lds + L_UNION);
    const int gq = (lane & 15) >> 2, gp = lane & 3, x7 = 4 * hi + gq, clow = 2 * ((lane >> 4) & 1) + (gp >> 1);
    const int vo0 = x7 * 128 + (((0 + clow) ^ x7) << 4) + (gp & 1) * 8, vo1 = x7 * 128 + (((4 + clow) ^ x7) << 4) + (gp & 1) * 8;
    bf16x8 qr[4];
    { const bf16_t* qp = proj + m * PJ + PC_Q + head * 64 + 8 * hi;
#pragma unroll
      for (int ds = 0; ds < 4; ++ds) qr[ds] = *(const bf16x8*)(qp + 16 * ds); }
    const bf16_t* gp_ = proj + m * PJ + PC_GATE + head * 3;
    const float g_cmp = sigmf(bf2f(gp_[0])), g_slc = sigmf(bf2f(gp_[1])), g_win = sigmf(bf2f(gp_[2]));
    f32x16 outa[2]; outa[0] = (f32x16){}; outa[1] = (f32x16){};
    if (tid == 0) *UNI = 0u;
    {
        const bool two = qb >= 16;
        const unsigned char* kcb = ws + WS_KC + (size_t)(b * 2 + g) * 128 * 128; const unsigned char* vcb = ws + WS_VC + (size_t)(b * 2 + g) * 128 * 128;
        dma_tile(kcb, 128, kv, wave, lane); dma_tile(vcb, 128, kv + 8192, wave, lane);
        if (two) { dma_tile(kcb + 64 * 128, 128, kv + KV_STAGE, wave, lane); dma_tile(vcb + 64 * 128, 128, kv + KV_STAGE + 8192, wave, lane); }
        asm volatile("s_waitcnt vmcnt(0)" ::: "memory"); __syncthreads();
        f32x16 c00, c01, c10, c11;
        const f32x16 zc = (f32x16){};
        qk_tile(c00, c01, kv, qr, r32, hi, zc);
        const int nmax = t >= 31 ? (((t - 31) >> 4) < 126 ? ((t - 31) >> 4) : 126) : -1;
        mask_tile(c00, c01, 0, hi, 0, nmax);
        if (two) { qk_tile(c10, c11, kv + KV_STAGE, qr, r32, hi, zc); mask_tile(c10, c11, 64, hi, 0, nmax); }
        else { c10 = (f32x16){}; c11 = (f32x16){};
#pragma unroll
            for (int r = 0; r < 16; ++r) { c10[r] = NEG_INF; c11[r] = NEG_INF; } }
        float mx = fmaxf(fmaxf(max16(c00), max16(c01)), fmaxf(max16(c10), max16(c11))); mx = fmaxf(mx, __shfl_xor(mx, 32));
        mx = fmaxf(mx, -1e30f);
#pragma unroll
        for (int r = 0; r < 16; ++r) { c00[r] = __builtin_amdgcn_exp2f(c00[r] - mx); c01[r] = __builtin_amdgcn_exp2f(c01[r] - mx);
            c10[r] = __builtin_amdgcn_exp2f(c10[r] - mx); c11[r] = __builtin_amdgcn_exp2f(c11[r] - mx); }
        float ls = (sum16(c00) + sum16(c01)) + (sum16(c10) + sum16(c11)); ls += __shfl_xor(ls, 32);
        const float inv = ls > 0.f ? 1.0f / ls : 0.f;
        c00 = c00 * inv; c01 = c01 * inv; c10 = c10 * inv; c11 = c11 * inv;
        float Gv[16], Ev[16];
#pragma unroll
        for (int a = 0; a < 4; ++a) {
            Gv[a] = (c00[4 * a] + c00[4 * a + 1]) + (c00[4 * a + 2] + c00[4 * a + 3]); Ev[a] = c00[4 * a + 3];
            Gv[4 + a] = (c01[4 * a] + c01[4 * a + 1]) + (c01[4 * a + 2] + c01[4 * a + 3]); Ev[4 + a] = c01[4 * a + 3];
            Gv[8 + a] = (c10[4 * a] + c10[4 * a + 1]) + (c10[4 * a + 2] + c10[4 * a + 3]); Ev[8 + a] = c10[4 * a + 3];
            Gv[12 + a] = (c11[4 * a] + c11[4 * a + 1]) + (c11[4 * a + 2] + c11[4 * a + 3]); Ev[12 + a] = c11[4 * a + 3];
        }
        LAS float* ip = IMP + ((hh * 64 + tl) * 32) + hi;
#pragma unroll
        for (int a = 0; a < 16; ++a) {
            const float eprev = a > 0 ? Ev[a > 0 ? a - 1 : 0] : 0.f;
            const float send = hi ? eprev : Ev[a];
            const float recv = __shfl_xor(send, 32);
            ip[2 * a] = Gv[a] + recv;
        }
        f32x16 oc[2]; oc[0] = (f32x16){}; oc[1] = (f32x16){};
        { bf16x8 pb[4];
          pb[0] = pack8(c00[0], c00[1], c00[2], c00[3], c00[4], c00[5], c00[6], c00[7]); pb[1] = pack8(c00[8], c00[9], c00[10], c00[11], c00[12], c00[13], c00[14], c00[15]);
          pb[2] = pack8(c01[0], c01[1], c01[2], c01[3], c01[4], c01[5], c01[6], c01[7]); pb[3] = pack8(c01[8], c01[9], c01[10], c01[11], c01[12], c01[13], c01[14], c01[15]);
          pv_tile(oc, kva + 8192 + vo0, kva + 8192 + vo1, pb); }
        if (two) { bf16x8 pb[4];
          pb[0] = pack8(c10[0], c10[1], c10[2], c10[3], c10[4], c10[5], c10[6], c10[7]); pb[1] = pack8(c10[8], c10[9], c10[10], c10[11], c10[12], c10[13], c10[14], c10[15]);
          pb[2] = pack8(c11[0], c11[1], c11[2], c11[3], c11[4], c11[5], c11[6], c11[7]); pb[3] = pack8(c11[8], c11[9], c11[10], c11[11], c11[12], c11[13], c11[14], c11[15]);
          pv_tile(oc, kva + KV_STAGE + 8192 + vo0, kva + KV_STAGE + 8192 + vo1, pb); }
        outa[0] = oc[0] * g_cmp; outa[1] = oc[1] * g_cmp;
    }
    __syncthreads();
    {
        const int tok = 8 * wave + (lane >> 3), sub = lane & 7;
        f32x4 v = *(LAS const f32x4*)(IMP + (0 * 64 + tok) * 32 + 4 * sub);
        v = v + *(LAS const f32x4*)(IMP + (1 * 64 + tok) * 32 + 4 * sub);
        v = v + *(LAS const f32x4*)(IMP + (2 * 64 + tok) * 32 + 4 * sub);
        v = v + *(LAS const f32x4*)(IMP + (3 * 64 + tok) * 32 + 4 * sub);
        float sc[4];
#pragma unroll
        for (int i = 0; i < 4; ++i) { const int s = 4 * sub + i; const bool forced = (s == 0) || (s == qb) || (s == qb - 1);
            sc[i] = forced ? 1e9f : (s <= qb ? v[i] : -1e30f); }
        unsigned taken = 0u, mask = 0u;
#pragma unroll 1
        for (int round = 0; round < TOPN; ++round) {
            float bv = -3e38f; int bi = 64;
#pragma unroll
            for (int i = 0; i < 4; ++i) { const bool ok = !((taken >> i) & 1u) && sc[i] > bv; bv = ok ? sc[i] : bv; bi = ok ? 4 * sub + i : bi; }
#pragma unroll
            for (int off = 1; off < 8; off <<= 1) { const float ov = __shfl_xor(bv, off); const int oi = __shfl_xor(bi, off);
                const bool take = (ov > bv) || (ov == bv && oi < bi); bv = take ? ov : bv; bi = take ? oi : bi; }
            mask |= 1u << bi; if ((bi >> 2) == sub) taken |= 1u << (bi & 3);
        }
        if (sub == 0) SELM[tok] = mask;
        unsigned um = mask; um |= __shfl_xor(um, 8); um |= __shfl_xor(um, 16); um |= __shfl_xor(um, 32);
        if (lane == 0) atomicOr((unsigned*)UNI, um);
    }
    __syncthreads();
    const unsigned mysel = SELM[tl]; const unsigned uni = *UNI;
    {
        const int wlo = qb > 8 ? qb - 8 : 0;
        unsigned wrem = ((2u << qb) - 1u) & ~((1u << wlo) - 1u);
        unsigned srem = uni & ((2u << qb) - 1u);
        const unsigned char* kwin = pb_ + (size_t)(PC_KWIN + g * 64) * 2; const unsigned char* vwin = pb_ + (size_t)(PC_VWIN + g * 64) * 2;
        const unsigned char* kslc = pb_ + (size_t)(PC_KSLC + g * 64) * 2; const unsigned char* vslc = pb_ + (size_t)(PC_VSLC + g * 64) * 2;
        const size_t pitch = (size_t)PJ * 2;
#define NEXT_TILE(B, J) do { if (wrem) { B = 1; J = __builtin_ctz(wrem); wrem &= wrem - 1; } else if (srem) { B = 2; J = __builtin_ctz(srem); srem &= srem - 1; } else { B = 0; J = 0; } } while (0)
#define ISSUE_TILE(B, J, ST) do { LAS unsigned char* d_ = kv + (ST) * KV_STAGE; \
            dma_tile(((B) == 1 ? kwin : kslc) + (size_t)(J) * 64 * pitch, pitch, d_, wave, lane); dma_tile(((B) == 1 ? vwin : vslc) + (size_t)(J) * 64 * pitch, pitch, d_ + 8192, wave, lane); } while (0)
        int cb, cj, nb_, nj, n2b, n2j;
        NEXT_TILE(cb, cj); NEXT_TILE(nb_, nj);
        ISSUE_TILE(cb, cj, 0); if (nb_) ISSUE_TILE(nb_, nj, 1);
        int st = 0;
        f32x16 o[2]; o[0] = (f32x16){}; o[1] = (f32x16){}; f32x16 negm = (f32x16){}; float mref = 0.f, lrun = 0.f; bool seen = false; int prevb = cb;
        while (cb) {
            NEXT_TILE(n2b, n2j);
            if (nb_) asm volatile("s_waitcnt vmcnt(2)" ::: "memory"); else asm volatile("s_waitcnt vmcnt(0)" ::: "memory");
            __builtin_amdgcn_s_barrier(); asm volatile("" ::: "memory");
            { const int st2 = st >= 1 ? st - 1 : 2;
              if (n2b) ISSUE_TILE(n2b, n2j, st2); }
            if (cb != prevb) {
                float lt = lrun + __shfl_xor(lrun, 32); const float f = g_win / lt;
                outa[0] = outa[0] + o[0] * f; outa[1] = outa[1] + o[1] * f;
                o[0] = (f32x16){}; o[1] = (f32x16){}; negm = (f32x16){}; mref = 0.f; lrun = 0.f; seen = false; prevb = cb;
            }
            LAS const unsigned char* kb = kv + st * KV_STAGE;
            {
                bool run = true, lsel = true; int mode, lo_ = 0, hi2 = t;
                if (cb == 1) { mode = ((cj >= qb - 7) && (cj <= qb - 1)) ? 0 : 2; lo_ = t - (WIN - 1); }
                else { lsel = (mysel >> cj) & 1u; const unsigned long long bal = __ballot(lsel);
                    run = bal != 0ull; mode = (cj == qb) ? 2 : ((bal == ~0ull) ? 0 : 1); }
                if (run) attn_tile(kb, kva + st * KV_STAGE + 8192 + vo0, kva + st * KV_STAGE + 8192 + vo1, qr, o, negm, mref, lrun, seen, 64 * cj, lo_, hi2, mode, lsel, r32, hi);
            }
            cb = nb_; cj = nj; nb_ = n2b; nj = n2j; st = st == 2 ? 0 : st + 1;
        }
#undef NEXT_TILE
#undef ISSUE_TILE
        { float lt = lrun + __shfl_xor(lrun, 32); const float f = (prevb == 1 ? g_win : g_slc) / lt;
          outa[0] = outa[0] + o[0] * f; outa[1] = outa[1] + o[1] * f; }
    }
    {
        bf16_t* mp = (bf16_t*)(ws + WS_MIX) + m * DM + head * 64; float ss = 0.f;
#pragma unroll
        for (int dt = 0; dt < 2; ++dt)
#pragma unroll
            for (int a = 0; a < 4; ++a) {
                const float y0 = outa[dt][4 * a], y1 = outa[dt][4 * a + 1], y2 = outa[dt][4 * a + 2], y3 = outa[dt][4 * a + 3];
                ss += (y0 * y0 + y1 * y1) + (y2 * y2 + y3 * y3);
                u32x2 w; w.x = cvtpk(y0, y1); w.y = cvtpk(y2, y3);
                *(u32x2*)(mp + 32 * dt + 8 * a + 4 * hi) = w;
            }
        ss += __shfl_xor(ss, 32);
        if (hi == 0) ((float*)(ws + WS_SSQN))[m * 8 + head] = ss;
    }
    __syncthreads();
}

__device__ __forceinline__ void compress_unit(unsigned char* ws, const float* cmp_pos, LAS unsigned char* lds, int unit, int wave, int lane) {
    const int nt = unit & 7, g = (unit >> 3) & 1, b = (unit >> 4) & 15, i = unit >> 8;
    const int c = lane & 15, q = lane >> 4, n = 16 * nt + c;
    const bf16_t* proj = (const bf16_t*)(ws + WS_PROJ); const bf16_t* w1t = (const bf16_t*)(ws + WS_W1T) + (size_t)i * 128 * 2048;
    const bf16_t* w2t = (const bf16_t*)(ws + WS_W2T) + (size_t)i * 64 * 128;
    f32x4 acc[8];
#pragma unroll
    for (int jt = 0; jt < 8; ++jt) acc[jt] = (f32x4){0.f, 0.f, 0.f, 0.f};
#pragma unroll 2
    for (int s = 0; s < 8; ++s) {
        const int ks = 8 * wave + s, l = ks >> 1, d0 = (ks & 1) * 32 + 8 * q;
        const u32x4 xv = *(const u32x4*)(proj + (size_t)(b * SEQ + 16 * n + l) * PJ + (i ? PC_VCMP : PC_KCMP) + g * 64 + d0);
        const f32x4 pA = *(const f32x4*)(cmp_pos + i * 2048 + l * 64 + d0), pB = *(const f32x4*)(cmp_pos + i * 2048 + l * 64 + d0 + 4);
        const bf16x8 bfrag = pack8(__uint_as_float(xv.x << 16) + pA[0], __uint_as_float(xv.x & 0xffff0000u) + pA[1], __uint_as_float(xv.y << 16) + pA[2], __uint_as_float(xv.y & 0xffff0000u) + pA[3],
                                   __uint_as_float(xv.z << 16) + pB[0], __uint_as_float(xv.z & 0xffff0000u) + pB[1], __uint_as_float(xv.w << 16) + pB[2], __uint_as_float(xv.w & 0xffff0000u) + pB[3]);
#pragma unroll
        for (int jt = 0; jt < 8; ++jt) { const bf16x8 af = *(const bf16x8*)(w1t + (size_t)(16 * jt + c) * 2048 + 32 * ks + 8 * q);
            acc[jt] = __builtin_amdgcn_mfma_f32_16x16x32_bf16(af, bfrag, acc[jt], 0, 0, 0); }
    }
    LAS f32x4* RED = (LAS f32x4*)(lds + L_RED);
#pragma unroll
    for (int jt = 0; jt < 8; ++jt) RED[(wave * 8 + jt) * 64 + lane] = acc[jt];
    __syncthreads();
    f32x4 h = RED[(0 * 8 + wave) * 64 + lane];
#pragma unroll
    for (int w2 = 1; w2 < 8; ++w2) h = h + RED[(w2 * 8 + wave) * 64 + lane];
    LAS unsigned char* HT = lds + L_HT;
    { u32x2 w; w.x = cvtpk(siluf(h[0]), siluf(h[1])); w.y = cvtpk(siluf(h[2]), siluf(h[3])); *(LAS u32x2*)(HT + c * 256 + (16 * wave + 4 * q) * 2) = w; }
    __syncthreads();
    if (wave < 4) {
        f32x4 o2 = {0.f, 0.f, 0.f, 0.f};
#pragma unroll
        for (int s = 0; s < 4; ++s) { const bf16x8 bf = *(LAS const bf16x8*)(HT + c * 256 + (32 * s + 8 * q) * 2);
            const bf16x8 af = *(const bf16x8*)(w2t + (size_t)(16 * wave + c) * 128 + 32 * s + 8 * q);
            o2 = __builtin_amdgcn_mfma_f32_16x16x32_bf16(af, bf, o2, 0, 0, 0); }
        bf16_t* outp = (bf16_t*)(ws + (i ? WS_VC : WS_KC)) + ((size_t)(b * 2 + g) * 128 + n) * 64 + 16 * wave + 4 * q;
        u32x2 w; w.x = cvtpk(o2[0], o2[1]); w.y = cvtpk(o2[2], o2[3]); if (n == 127) { w.x = 0u; w.y = 0u; }
        *(u32x2*)outp = w;
    }
    __syncthreads();
}
}

namespace gdn {
typedef float f32x4 __attribute__((ext_vector_type(4)));
typedef short bf16x8 __attribute__((ext_vector_type(8)));
typedef unsigned u32x4 __attribute__((ext_vector_type(4)));
typedef unsigned u32x2 __attribute__((ext_vector_type(2)));
using nsa::cvtpk; using nsa::pack8;

constexpr int REC_W = 0, REC_QG = 16384, REC_KD = 32768, REC_QK = 49152, REC_BYTES = 57344;
constexpr int UREC_BYTES = 32768;
constexpr int NCHUNK = SEQ / 64;
constexpr int P_KR = 0, P_QR = 16384, P_STG = 32768, P_AT = 32768, P_QKI = 49152, P_SC = 67584, P_HALF = 69632;
constexpr int SLAB = 17408;
constexpr int SC_BETA = 0, SC_GC = 64, SC_EGC = 128, SC_EKD = 192, SC_RK2 = 256, SC_RQ2 = 320;
constexpr int S_BUF = 0, S_SSQ = 2 * REC_BYTES;

__device__ __forceinline__ int perm32pos(int kl) { return 8 * ((kl & 15) >> 2) + 4 * (kl >> 4) + (kl & 3); }
__device__ __forceinline__ int off256(int i, int k) { const int pos = perm32pos(k & 31), ch = 4 * (k >> 5) + (pos >> 3); return i * 256 + ((ch ^ (i & 15)) << 4) + (pos & 7) * 2; }
__device__ __forceinline__ int off128(int row, int j) { const int pos = perm32pos(j & 31), ch = 4 * (j >> 5) + (pos >> 3); return row * 128 + ((ch ^ (row & 7)) << 4) + (pos & 7) * 2; }
__device__ __forceinline__ float softplusf(float x) { return x > 20.f ? x : log1pf(__expf(x)); }

__device__ __forceinline__ void conv64(float (&y)[64], LAS const bf16_t* sp, const float* cw, int ch1536, bool first) {
    const float w0 = cw[ch1536], w1 = cw[1536 + ch1536], w2 = cw[2 * 1536 + ch1536], w3 = cw[3 * 1536 + ch1536];
    float x0 = first ? 0.f : bf2f(sp[0]), x1 = first ? 0.f : bf2f(sp[128]), x2 = first ? 0.f : bf2f(sp[256]);
#pragma unroll
    for (int i = 0; i < 64; ++i) { const float x3 = bf2f(sp[(i + 3) * 128]); y[i] = siluf(w0 * x0 + w1 * x1 + w2 * x2 + w3 * x3); x0 = x1; x1 = x2; x2 = x3; }
}
__device__ __forceinline__ void slab_dma(const bf16_t* projrow, const int* cols, int nmat, LAS unsigned char* stg, int w4, int lane) {
    for (int p = w4; p < 17 * nmat; p += 4) { const int mat = p / 17, pr = p % 17;
        __builtin_amdgcn_global_load_lds((const unsigned*)(projrow + (size_t)(4 * pr + (lane >> 4)) * PJ + cols[mat] + (lane & 15) * 8), (LAS unsigned*)(stg + mat * SLAB + pr * 1024), 16, 0, 0); }
}

__device__ __forceinline__ void prep_unit(const Args& a, LAS unsigned char* lds, int u, int wave, int lane) {
    unsigned char* ws = a.ws;
    int tid = threadIdx.x; asm volatile("" : "+v"(tid));
    lane = tid & 63;
    const int half = tid >> 8, c = tid & 255, w4 = wave & 3, fr = lane & 15, fq = lane >> 4;
    const int bh = u >> 4, b = bh >> 2, h = bh & 3, chunk = 2 * (u & 15) + half;
    LAS unsigned char* L = lds + half * P_HALF; LAS float* SC = (LAS float*)(L + P_SC); LAS float* AT = (LAS float*)(L + P_AT);
    const bf16_t* proj = (const bf16_t*)(ws + WS_PROJ); const size_t row0 = (size_t)b * SEQ + 64 * chunk;
    unsigned char* rec = (unsigned char*)a.out + (size_t)(bh * NCHUNK + chunk) * REC_BYTES;
    unsigned char* urec = ws + WS_XN + (size_t)(bh * NCHUNK + chunk) * UREC_BYTES;
    if (w4 == 0) {
        const bf16_t* pr = proj + (row0 + lane) * PJ;
        const float beta = sigmf(bf2f(pr[PC_B + h])); const float av = bf2f(pr[PC_A + h]) + a.dt_bias[h];
        float g = -__expf(a.a_log[h]) * softplusf(av);
#pragma unroll
        for (int o = 1; o < 64; o <<= 1) { const float up = __shfl_up(g, o); if (lane >= o) g += up; }
        const float glast = __shfl(g, 63);
        SC[SC_BETA + lane] = beta; SC[SC_GC + lane] = g; SC[SC_EGC + lane] = __expf(g); SC[SC_EKD + lane] = __expf(glast - g);
        if (lane == 63) ((float*)(ws + WS_GL))[bh * NCHUNK + chunk] = __expf(g);
    }
    float x[64];
    const int kc = c & 127;
    { const bf16_t* prow = proj + (row0 - 3) * PJ + h * 128; const int cols_qk[2] = {PC_GQ, PC_GK}; const int cols_v[2] = {PC_GV, PC_GV};
      slab_dma(prow, cols_qk, 2, L + P_STG, w4, lane);
      asm volatile("s_waitcnt vmcnt(0)" ::: "memory"); __syncthreads();
      const int pos = perm32pos(kc & 31), ch = 4 * (kc >> 5) + (pos >> 3), jb = (pos & 7) * 2;
      if (c < 128) { conv64(x, (LAS const bf16_t*)(L + P_STG) + kc, a.conv_w, h * 128 + kc, chunk == 0);
#pragma unroll
          for (int i = 0; i < 64; ++i) *(LAS bf16_t*)(L + P_QR + i * 256 + ((ch ^ (i & 15)) << 4) + jb) = f2bf(x[i]);
      } else { conv64(x, (LAS const bf16_t*)(L + P_STG + SLAB) + kc, a.conv_w, 512 + h * 128 + kc, chunk == 0);
#pragma unroll
          for (int i = 0; i < 64; ++i) { const bf16_t kb = f2bf(x[i]); *(LAS bf16_t*)(L + P_KR + i * 256 + ((ch ^ (i & 15)) << 4) + jb) = kb; x[i] = bf2f(kb); }
      }
      __syncthreads();
      slab_dma(prow, cols_v, 1, L + P_STG, w4, lane);
      asm volatile("s_waitcnt vmcnt(0)" ::: "memory"); __syncthreads();
      if (c < 128) conv64(x, (LAS const bf16_t*)(L + P_STG) + kc, a.conv_w, 1024 + h * 128 + kc, chunk == 0);
    }
    __syncthreads();
    f32x4 kk[4], qk[4], qq;
    {
        bf16x8 ak[4], aq[4];
        const int ri = 16 * w4 + fr;
#pragma unroll
        for (int s = 0; s < 4; ++s) { const int o = ri * 256 + (((4 * s + fq) ^ fr) << 4); ak[s] = *(LAS const bf16x8*)(L + P_KR + o); aq[s] = *(LAS const bf16x8*)(L + P_QR + o); }
        qq = (f32x4){0.f, 0.f, 0.f, 0.f};
#pragma unroll
        for (int s = 0; s < 4; ++s) qq = __builtin_amdgcn_mfma_f32_16x16x32_bf16(aq[s], aq[s], qq, 0, 0, 0);
#pragma unroll
        for (int nt = 0; nt < 4; ++nt) {
            kk[nt] = (f32x4){0.f, 0.f, 0.f, 0.f}; qk[nt] = (f32x4){0.f, 0.f, 0.f, 0.f};
            if (nt <= w4) {
                const int rj = 16 * nt + fr;
#pragma unroll
                for (int s = 0; s < 4; ++s) { const bf16x8 bk = *(LAS const bf16x8*)(L + P_KR + rj * 256 + (((4 * s + fq) ^ fr) << 4));
                    kk[nt] = __builtin_amdgcn_mfma_f32_16x16x32_bf16(ak[s], bk, kk[nt], 0, 0, 0);
                    qk[nt] = __builtin_amdgcn_mfma_f32_16x16x32_bf16(aq[s], bk, qk[nt], 0, 0, 0); }
            }
        }
#pragma unroll
        for (int nt = 0; nt < 4; ++nt) if (nt == w4) {
#pragma unroll
            for (int r = 0; r < 4; ++r) if (fr == 4 * fq + r) { SC[SC_RK2 + 16 * w4 + fr] = kk[nt][r]; SC[SC_RQ2 + 16 * w4 + fr] = qq[r]; } }
    }
    __syncthreads();
    {
#pragma unroll
        for (int nt = 0; nt < 4; ++nt) {
            const int j = 16 * nt + fr; const float rkj = rsqrtf(SC[SC_RK2 + j] + RMS_EPS), gcj = SC[SC_GC + j];
            f32x4 av; float qv[4];
#pragma unroll
            for (int r = 0; r < 4; ++r) { const int i = 16 * w4 + 4 * fq + r; const float gci = SC[SC_GC + i];
                const float dec = __expf(fminf(gci - gcj, 0.f));
                const float rki = rsqrtf(SC[SC_RK2 + i] + RMS_EPS), rqi = rsqrtf(SC[SC_RQ2 + i] + RMS_EPS);
                av[r] = (nt <= w4 && j < i) ? SC[SC_BETA + i] * kk[nt][r] * rki * rkj * dec : 0.f;
                qv[r] = (nt <= w4 && j <= i) ? qk[nt][r] * rqi * rkj * 0.08838834764831845f * dec : 0.f; }
            *(LAS f32x4*)(AT + j * 64 + 16 * w4 + 4 * fq) = av;
#pragma unroll
            for (int r = 0; r < 4; ++r) { const int i = 16 * w4 + 4 * fq + r; *(LAS bf16_t*)(L + P_QKI + off128(i, j)) = f2bf(qv[r]); }
        }
        if (c >= 128) {
#define KDV(j) (x[j] * SC[SC_EKD + (j)] * rsqrtf(SC[SC_RK2 + (j)] + RMS_EPS))
#pragma unroll
            for (int ch = 0; ch < 8; ++ch) { const int j0 = 32 * (ch >> 2) + 4 * (ch & 3);
                const bf16x8 v = pack8(KDV(j0), KDV(j0 + 1), KDV(j0 + 2), KDV(j0 + 3), KDV(j0 + 16), KDV(j0 + 17), KDV(j0 + 18), KDV(j0 + 19));
                *(bf16x8*)(rec + REC_KD + kc * 128 + ((ch ^ (kc & 7)) << 4)) = v; }
#undef KDV
#pragma unroll
            for (int i = 0; i < 64; ++i) x[i] = x[i] * SC[SC_BETA + i] * SC[SC_EGC + i] * rsqrtf(SC[SC_RK2 + i] + RMS_EPS);
        } else {
#pragma unroll
            for (int i = 0; i < 64; ++i) x[i] = x[i] * SC[SC_BETA + i];
        }
        { const int i = c >> 2; const float f = rsqrtf(SC[SC_RQ2 + i] + RMS_EPS) * 0.08838834764831845f * SC[SC_EGC + i];
#pragma unroll
          for (int cc = 0; cc < 4; ++cc) { const int o = i * 256 + ((4 * (c & 3) + cc) << 4);
              const u32x4 v = *(LAS const u32x4*)(L + P_QR + o);
              const bf16x8 w = pack8(__uint_as_float(v.x << 16) * f, __uint_as_float(v.x & 0xffff0000u) * f, __uint_as_float(v.y << 16) * f, __uint_as_float(v.y & 0xffff0000u) * f,
                                     __uint_as_float(v.z << 16) * f, __uint_as_float(v.z & 0xffff0000u) * f, __uint_as_float(v.w << 16) * f, __uint_as_float(v.w & 0xffff0000u) * f);
              *(bf16x8*)(rec + REC_QG + o) = w; } }
    }
    __syncthreads();
    {
        const LAS f32x4* AT4 = (const LAS f32x4*)AT;
#pragma unroll
        for (int j = 0; j < 63; ++j) {
            const float xj = x[j];
#pragma unroll
            for (int i4 = (j + 1) / 4; i4 < 16; ++i4) { const f32x4 av = AT4[j * 16 + i4];
#pragma unroll
                for (int r = 0; r < 4; ++r) if (4 * i4 + r > j) x[4 * i4 + r] -= av[r] * xj; }
            __builtin_amdgcn_sched_barrier(0);
        }
#pragma unroll
        for (int cc = 0; cc < 2; ++cc) { const int o = (c * 2 + cc) * 16; *(u32x4*)(rec + REC_QK + o) = *(LAS const u32x4*)(L + P_QKI + o); }
        if (c < 128) {
            const int wv = kc >> 4, cc = kc & 15;
#pragma unroll
            for (int it = 0; it < 4; ++it)
#pragma unroll
                for (int q = 0; q < 4; ++q) { const int i0 = 16 * it + 4 * q;
                    *(f32x4*)(urec + (size_t)(((wv * 4 + it) * 64) + q * 16 + cc) * 16) = (f32x4){x[i0], x[i0 + 1], x[i0 + 2], x[i0 + 3]}; }
        } else {
            const int pos = perm32pos(kc & 31), ch = 4 * (kc >> 5) + (pos >> 3), jb = (pos & 7) * 2;
#pragma unroll
            for (int i = 0; i < 64; ++i) *(LAS bf16_t*)(L + P_KR + i * 256 + ((ch ^ (i & 15)) << 4) + jb) = f2bf(-x[i]);
        }
    }
    __syncthreads();
#pragma unroll
    for (int cc = 0; cc < 4; ++cc) { const int o = (c * 4 + cc) * 16; *(u32x4*)(rec + REC_W + o) = *(LAS const u32x4*)(L + P_KR + o); }
    __syncthreads();
}

__device__ __forceinline__ float row_sum16(float v) {
    v += __builtin_bit_cast(float, __builtin_amdgcn_update_dpp(0, __builtin_bit_cast(int, v), 0x128, 0xf, 0xf, false));
    v += __builtin_bit_cast(float, __builtin_amdgcn_update_dpp(0, __builtin_bit_cast(int, v), 0x124, 0xf, 0xf, false));
    v += __builtin_bit_cast(float, __builtin_amdgcn_update_dpp(0, __builtin_bit_cast(int, v), 0x122, 0xf, 0xf, false));
    v += __builtin_bit_cast(float, __builtin_amdgcn_update_dpp(0, __builtin_bit_cast(int, v), 0x121, 0xf, 0xf, false));
    return v;
}
__device__ __forceinline__ void scan_unit(const Args& a, LAS unsigned char* lds, int bh, int wave, int lane) {
    unsigned char* ws = a.ws;
    const int b = bh >> 2, h = bh & 3, fr = lane & 15, fq = lane >> 4;
    const unsigned char* recb = (const unsigned char*)a.out + (size_t)bh * NCHUNK * REC_BYTES;
    const unsigned char* urecb = ws + WS_XN + (size_t)bh * NCHUNK * UREC_BYTES;
    const float* gl = (const float*)(ws + WS_GL) + bh * NCHUNK;
    const bf16_t* zbase = (const bf16_t*)(ws + WS_PROJ) + (size_t)b * SEQ * PJ + PC_Z + h * 128 + 16 * wave + fr;
    bf16_t* mbase = (bf16_t*)(ws + WS_MIX) + (size_t)b * SEQ * DM + 512 + h * 128 + 16 * wave + fr;
    const float ng = a.gdn_norm_g[16 * wave + fr];
    f32x4 S[8];
#pragma unroll
    for (int kt = 0; kt < 8; ++kt) S[kt] = (f32x4){0.f, 0.f, 0.f, 0.f};
#pragma unroll
    for (int p = 0; p < 7; ++p) __builtin_amdgcn_global_load_lds((const unsigned*)(recb + (size_t)(wave + 8 * p) * 1024 + lane * 16), (LAS unsigned*)(lds + S_BUF + (wave + 8 * p) * 1024), 16, 0, 0);
    f32x4 un[4]; unsigned short zn[16]; float egn; bf16_t pend[16];
    { const f32x4* up = (const f32x4*)urecb + (wave * 4) * 64 + lane;
#pragma unroll
      for (int it = 0; it < 4; ++it) un[it] = up[it * 64];
#pragma unroll
      for (int it = 0; it < 4; ++it)
#pragma unroll
          for (int r = 0; r < 4; ++r) zn[4 * it + r] = zbase[(size_t)(16 * it + 4 * fq + r) * PJ];
      egn = gl[0];
#pragma unroll
      for (int i = 0; i < 16; ++i) pend[i] = 0; }
    for (int ck = 0; ck < NCHUNK; ++ck) {
        LAS const unsigned char* buf = lds + S_BUF + (ck & 1) * REC_BYTES;
        asm volatile("s_waitcnt vmcnt(0)" ::: "memory"); __syncthreads();
        if (ck + 1 < NCHUNK) { const unsigned char* src = recb + (size_t)(ck + 1) * REC_BYTES; LAS unsigned char* dst = lds + S_BUF + ((ck + 1) & 1) * REC_BYTES;
#pragma unroll
            for (int p = 0; p < 7; ++p) __builtin_amdgcn_global_load_lds((const unsigned*)(src + (size_t)(wave + 8 * p) * 1024 + lane * 16), (LAS unsigned*)(dst + (wave + 8 * p) * 1024), 16, 0, 0); }
        if (ck > 0) {
#pragma unroll
            for (int it = 0; it < 4; ++it)
#pragma unroll
                for (int r = 0; r < 4; ++r) mbase[(size_t)(64 * (ck - 1) + 16 * it + 4 * fq + r) * DM] = pend[4 * it + r]; }
        f32x4 av[4], ao[4]; float zv[16];
#pragma unroll
        for (int it = 0; it < 4; ++it) { av[it] = un[it]; ao[it] = (f32x4){0.f, 0.f, 0.f, 0.f}; }
#pragma unroll
        for (int i = 0; i < 16; ++i) zv[i] = bf2f(zn[i]);
        const float egl = egn;
        { const int cn = ck + 1 < NCHUNK ? ck + 1 : ck;
          const f32x4* up = (const f32x4*)(urecb + (size_t)cn * UREC_BYTES) + (wave * 4) * 64 + lane;
#pragma unroll
          for (int it = 0; it < 4; ++it) un[it] = up[it * 64];
#pragma unroll
          for (int it = 0; it < 4; ++it)
#pragma unroll
              for (int r = 0; r < 4; ++r) zn[4 * it + r] = zbase[(size_t)(64 * cn + 16 * it + 4 * fq + r) * PJ];
          egn = gl[cn]; }
        bf16x8 Sb[4];
#pragma unroll
        for (int s = 0; s < 4; ++s) Sb[s] = pack8(S[2 * s][0], S[2 * s][1], S[2 * s][2], S[2 * s][3], S[2 * s + 1][0], S[2 * s + 1][1], S[2 * s + 1][2], S[2 * s + 1][3]);
#pragma unroll
        for (int it = 0; it < 4; ++it) { const int o = (16 * it + fr) * 256;
#pragma unroll
            for (int s = 0; s < 4; ++s) { const int co = ((4 * s + fq) ^ fr) << 4;
                av[it] = __builtin_amdgcn_mfma_f32_16x16x32_bf16(*(LAS const bf16x8*)(buf + REC_W + o + co), Sb[s], av[it], 0, 0, 0);
                ao[it] = __builtin_amdgcn_mfma_f32_16x16x32_bf16(*(LAS const bf16x8*)(buf + REC_QG + o + co), Sb[s], ao[it], 0, 0, 0); } }
        bf16x8 vb[2];
#pragma unroll
        for (int s = 0; s < 2; ++s) vb[s] = pack8(av[2 * s][0], av[2 * s][1], av[2 * s][2], av[2 * s][3], av[2 * s + 1][0], av[2 * s + 1][1], av[2 * s + 1][2], av[2 * s + 1][3]);
#pragma unroll
        for (int it = 0; it < 4; ++it) { const int o = (16 * it + fr) * 128;
#pragma unroll
            for (int s = 0; s < 2; ++s) ao[it] = __builtin_amdgcn_mfma_f32_16x16x32_bf16(*(LAS const bf16x8*)(buf + REC_QK + o + (((4 * s + fq) ^ (fr & 7)) << 4)), vb[s], ao[it], 0, 0, 0); }
        LAS float* SSQ = (LAS float*)(lds + S_SSQ) + (ck & 1) * 512;
#pragma unroll
        for (int it = 0; it < 4; ++it)
#pragma unroll
            for (int r = 0; r < 4; ++r) { const float s2 = row_sum16(ao[it][r] * ao[it][r]);
                if (fr == 0) SSQ[(16 * it + 4 * fq + r) * 8 + wave] = s2; }
#pragma unroll
        for (int kt = 0; kt < 8; ++kt) { S[kt] = S[kt] * egl; const int o = (16 * kt + fr) * 128;
#pragma unroll
            for (int s = 0; s < 2; ++s) S[kt] = __builtin_amdgcn_mfma_f32_16x16x32_bf16(*(LAS const bf16x8*)(buf + REC_KD + o + (((4 * s + fq) ^ (fr & 7)) << 4)), vb[s], S[kt], 0, 0, 0); }
        asm volatile("s_waitcnt lgkmcnt(0)" ::: "memory"); __builtin_amdgcn_s_barrier(); asm volatile("" ::: "memory");
#pragma unroll
        for (int it = 0; it < 4; ++it)
#pragma unroll
            for (int r = 0; r < 4; ++r) { const int i = 16 * it + 4 * fq + r; const f32x4 p0 = *(LAS const f32x4*)(SSQ + i * 8), p1 = *(LAS const f32x4*)(SSQ + i * 8 + 4);
                const float tot = ((p0[0] + p0[1]) + (p0[2] + p0[3])) + ((p1[0] + p1[1]) + (p1[2] + p1[3]));
                const float rs = rsqrtf(tot * (1.f / 128.f) + RMS_EPS);
                pend[4 * it + r] = f2bf(ao[it][r] * rs * ng * siluf(zv[4 * it + r])); }
    }
#pragma unroll
    for (int it = 0; it < 4; ++it)
#pragma unroll
        for (int r = 0; r < 4; ++r) mbase[(size_t)(64 * (NCHUNK - 1) + 16 * it + 4 * fq + r) * DM] = pend[4 * it + r];
    __syncthreads();
}
}

#ifndef PG8_ALIGN
#define PG8_ALIGN true
#endif
constexpr int NWAVES = 8;
constexpr int RING_BYTES = 131072;
constexpr int MISC_OFF = 147456 - 512;
constexpr int LDS_BYTES = 147456;
#ifndef LAS
#define LAS __attribute__((address_space(3)))
#endif
#define GAS __attribute__((address_space(1)))
typedef unsigned v4u __attribute__((ext_vector_type(4)));
typedef float f32x4 __attribute__((ext_vector_type(4)));
#define LDS_WAIT() asm volatile("s_waitcnt lgkmcnt(0)" ::: "memory")
#define VM_WAIT() asm volatile("s_waitcnt vmcnt(0)" ::: "memory")
constexpr int CW_BAR = 4096, CW_QUEUE = 8192;


__device__ __forceinline__ unsigned pk2(float lo, float hi) { return (unsigned)f2bf(lo) | ((unsigned)f2bf(hi) << 16); }
__device__ __forceinline__ void p0_transpose_item(const float* colp, int ld, const float* gain, int gain_n, int K, bf16_t* WT, LAS float* scr, int k0, int n0, int lane) {
#pragma unroll
    for (int i = 0; i < 32; ++i) { const int kk = 2 * i + (lane >> 5); float v = 0.f;
        if (colp) { v = colp[(size_t)(k0 + kk) * ld]; if (gain && (k0 + kk) < gain_n) v *= gain[k0 + kk]; }
        scr[kk * 33 + (lane & 31)] = v; }
    LDS_WAIT(); asm volatile("" ::: "memory");
    const int c = lane & 7;
#pragma unroll
    for (int j = 0; j < 4; ++j) { const int n = (lane >> 3) + 8 * j; const LAS float* s = scr + (8 * c) * 33 + n;
        v4u o; o.x = pk2(s[0 * 33], s[1 * 33]); o.y = pk2(s[2 * 33], s[3 * 33]); o.z = pk2(s[4 * 33], s[5 * 33]); o.w = pk2(s[6 * 33], s[7 * 33]);
        *(v4u*)(WT + (size_t)(n0 + n) * K + k0 + 8 * c) = o; }
    LDS_WAIT(); asm volatile("" ::: "memory");
}
__device__ __forceinline__ void p0_prologue(const Args& a, LAS unsigned char* lds, int vcu, int G, int wave, int lane) {
    unsigned char* ws = a.ws;
    LAS float* scr = (LAS float*)(lds + wave * 16384);
    const int gw = vcu * NWAVES + wave, NGW = G * NWAVES;
    constexpr int I_IN = 16 * (PJ / 32), I_OUT = 16 * 32, I_GU = 16 * (2 * DFF / 32), I_DN = (DFF / 64) * 32, I_W1 = 2 * 32 * 4, I_W2 = 2 * 2 * 2;
    constexpr int NITEMS = I_IN + I_OUT + I_GU + I_DN + I_W1 + I_W2;
    for (int it = gw; it < NITEMS; it += NGW) {
        int r = it;
        if (r < I_IN) { const int nblk = PJ / 32, kb = r / nblk, nb = r % nblk; const int n = nb * 32 + (lane & 31); const int oc = win_orig_col(n);
            p0_transpose_item(oc < 0 ? nullptr : a.w_in + oc, IN_W, nullptr, 0, DM, (bf16_t*)(ws + WS_WIN), scr, kb * 64, nb * 32, lane); continue; } r -= I_IN;
        if (r < I_OUT) { const int kb = r / 32, nb = r % 32; const int n = nb * 32 + (lane & 31);
            p0_transpose_item(a.w_out + n, DM, a.nsa_norm_g, 512, DM, (bf16_t*)(ws + WS_WOUT), scr, kb * 64, nb * 32, lane); continue; } r -= I_OUT;
        if (r < I_GU) { const int nblk = 2 * DFF / 32, kb = r / nblk, nb = r % nblk; const int n = nb * 32 + (lane & 31); const int pn = n >> 8, wi = n & 255;
            const float* W = (wi < 128) ? a.w_gate : a.w_up;
            p0_transpose_item(W + pn * 128 + (wi & 127), DFF, a.norm2_g, DM, DM, (bf16_t*)(ws + WS_WGU), scr, kb * 64, nb * 32, lane); continue; } r -= I_GU;
        if (r < I_DN) { const int kb = r / 32, nb = r % 32; const int n = nb * 32 + (lane & 31);
            p0_transpose_item(a.w_down + n, DM, nullptr, 0, DFF, (bf16_t*)(ws + WS_WDN), scr, kb * 64, nb * 32, lane); continue; } r -= I_DN;
        if (r < I_W1) { const int i = r / 128, rr = r % 128, kb = rr / 4, nb = rr % 4; const int n = nb * 32 + (lane & 31);
            p0_transpose_item(a.cmp_w1 + (size_t)i * 2048 * 128 + n, 128, nullptr, 0, 2048, (bf16_t*)(ws + WS_W1T) + (size_t)i * 128 * 2048, scr, kb * 64, nb * 32, lane); continue; } r -= I_W1;
        { const int i = r / 4, rr = r % 4, kb = rr / 2, nb = rr % 2; const int n = nb * 32 + (lane & 31);
            p0_transpose_item(a.cmp_w2 + (size_t)i * 128 * 64 + n, 64, nullptr, 0, 128, (bf16_t*)(ws + WS_W2T) + (size_t)i * 64 * 128, scr, kb * 64, nb * 32, lane); }
    }
    bf16_t* xn = (bf16_t*)(ws + WS_XN);
    for (int m0 = gw * 4; m0 < MTOK; m0 += NGW * 4) {
        f32x4 v[4][4];
#pragma unroll
        for (int rr = 0; rr < 4; ++rr) { const f32x4* xr = (const f32x4*)(a.x + (size_t)(m0 + rr) * DM) + lane;
#pragma unroll
            for (int j = 0; j < 4; ++j) v[rr][j] = xr[64 * j]; }
        f32x4 gg[4];
#pragma unroll
        for (int j = 0; j < 4; ++j) gg[j] = *((const f32x4*)a.norm1_g + lane + 64 * j);
#pragma unroll
        for (int rr = 0; rr < 4; ++rr) { float s = 0.f;
#pragma unroll
            for (int j = 0; j < 4; ++j) s += (v[rr][j].x * v[rr][j].x + v[rr][j].y * v[rr][j].y) + (v[rr][j].z * v[rr][j].z + v[rr][j].w * v[rr][j].w);
            s = wave_sum(s); const float rstd = rsqrtf(s * (1.f / DM) + RMS_EPS);
            unsigned long long* o8 = (unsigned long long*)(xn + (size_t)(m0 + rr) * DM) + lane;
#pragma unroll
            for (int j = 0; j < 4; ++j) o8[64 * j] = (unsigned long long)pk2(v[rr][j].x * rstd * gg[j].x, v[rr][j].y * rstd * gg[j].y) | ((unsigned long long)pk2(v[rr][j].z * rstd * gg[j].z, v[rr][j].w * rstd * gg[j].w) << 32); }
    }
    float* tab = (float*)(ws + WS_ROPE);
    for (int i = gw * 64 + lane; i < MTOK * 8; i += NGW * 64) {
        const int m = i >> 3, f = i & 7;
        const float inv = powf(500000.0f, -(float)f * (2.0f / 16.0f));
        const float ang = (float)a.positions[m] * inv;
        tab[m * 16 + f] = cosf(ang); tab[m * 16 + 8 + f] = sinf(ang);
    }
}
__device__ __forceinline__ void p7_final(const Args& a, int vcu, int G, int wave, int lane) {
    const int gw = vcu * NWAVES + wave, NGW = G * NWAVES; const float* ss = (const float*)(a.ws + WS_SS3);
    for (int m = gw; m < MTOK; m += NGW) {
        const f32x4* sp = (const f32x4*)(ss + (size_t)m * 16); const f32x4 t = (sp[0] + sp[1]) + (sp[2] + sp[3]);
        const float rstd = rsqrtf(((t[0] + t[1]) + (t[2] + t[3])) * (1.f / DM) + RMS_EPS);
        f32x4* xr = (f32x4*)(a.out + (size_t)m * DM) + lane;
#pragma unroll
        for (int j = 0; j < 4; ++j) { const f32x4 gg = *((const f32x4*)a.final_g + lane + 64 * j); xr[64 * j] = xr[64 * j] * rstd * gg; }
    }
}

__global__ void __launch_bounds__(NWAVES * 64, 2) mk_fwd(Args args) {
    extern __shared__ __attribute__((aligned(16))) unsigned char lds_raw[];
    LAS unsigned char* lds = (LAS unsigned char*)lds_raw;
    volatile LAS unsigned* MISC = (volatile LAS unsigned*)(lds + MISC_OFF);
    const int tid = threadIdx.x, lane = tid & 63, wave = __builtin_amdgcn_readfirstlane(tid >> 6);
    const int G = gridDim.x; const int bx = blockIdx.x; const int vcu = (G % 8 == 0) ? (bx % 8) * (G / 8) + bx / 8 : bx;
    unsigned char* ws = args.ws;
    for (int u = tid; u < (LDS_BYTES - MISC_OFF) / 4; u += NWAVES * 64) ((LAS unsigned*)(lds + MISC_OFF))[u] = 0u;
    __syncthreads();
    const int lo = args.ph_lo, hi = args.ph_hi;
    const bool multi = (hi - lo) > 1;
    XcdBarrier bar; bar.bar = (unsigned*)(ws + WS_CTL) + CW_BAR; bar.x = 0; bar.st = nullptr;
    if (multi) bar = xcd_barrier_post((unsigned*)(ws + WS_CTL) + CW_BAR, MISC + 8);
#define IN(k) (lo <= (k) && (k) < hi)
#define REPB(k)
#define REPE
#define SEAM(k) do { if (IN(k) && IN((k) + 1)) xcd_barrier(bar); } while (0)
    if (IN(0)) { REPB(0) p0_prologue(args, lds, vcu, G, wave, lane); REPE SEAM(0); }
    if (IN(1)) { REPB(1)
        pg8::Gemm g{(const bf16_t*)(ws + WS_XN), (const bf16_t*)(ws + WS_WIN), MTOK, PJ, DM}; pg8::StaticOrder S; S.init(MTOK, PJ, G, bx);
        pg8::EpiProj E{(bf16_t*)(ws + WS_PROJ), (const float*)(ws + WS_ROPE), -1};
        pg8::gemm_phase<pg8::EpiProj, pg8::StaticOrder, PG8_ALIGN, PG8_SP2>(lds, g, S, E);
        REPE SEAM(1);
    }
    if (IN(2)) { REPB(2)
        if (!(args.flags & 1)) for (int u = vcu; u < 512; u += G) nsa::compress_unit(ws, args.cmp_pos, lds, u, wave, lane);
        if (!(args.flags & 2)) for (int u = vcu; u < 1024; u += G) gdn::prep_unit(args, lds, u, wave, lane);
        REPE SEAM(2);
    }
    if (IN(3)) { REPB(3)
        if (bx < BATCH * GH && !(args.flags & 4)) gdn::scan_unit(args, lds, bx, wave, lane);
        unsigned* qctr = (unsigned*)(ws + WS_CTL) + CW_QUEUE; LAS int* QW = (LAS int*)(lds + nsa::L_QUEUE);
        if (!(args.flags & 8)) for (;;) {
            if (tid == 0) *QW = (int)atomicAdd(qctr, 1u);
            __syncthreads();
            const int u = *QW;
            if (u >= 1024) break;
            nsa::attn_unit(ws, lds, (u & 31) >> 1, u & 1, 31 - (u >> 5), wave, lane);
        }
        REPE SEAM(3);
    }
    if (IN(4)) { REPB(4)
        pg8::Gemm g{(const bf16_t*)(ws + WS_MIX), (const bf16_t*)(ws + WS_WOUT), MTOK, DM, DM}; pg8::StaticOrder S; S.init(MTOK, DM, G, bx);
        pg8::EpiOut E{args.x, args.out, (bf16_t*)(ws + WS_XN), (float*)(ws + WS_SS2), (const float*)(ws + WS_SSQN), 8};
        pg8::gemm_phase<pg8::EpiOut, pg8::StaticOrder, PG8_ALIGN, PG8_SP2>(lds, g, S, E);
        REPE SEAM(4);
    }
    if (IN(5)) { REPB(5)
        pg8::Gemm g{(const bf16_t*)(ws + WS_XN), (const bf16_t*)(ws + WS_WGU), MTOK, 2 * DFF, DM}; pg8::StaticOrder S; S.init(MTOK, 2 * DFF, G, bx);
        pg8::EpiGU E{(bf16_t*)(ws + WS_PROJ), (const float*)(ws + WS_SS2), -1};
        pg8::gemm_phase<pg8::EpiGU, pg8::StaticOrder, PG8_ALIGN, PG8_SP2>(lds, g, S, E);
        REPE SEAM(5);
    }
    if (IN(6)) {
        pg8::Gemm g{(const bf16_t*)(ws + WS_PROJ), (const bf16_t*)(ws + WS_WDN), MTOK, DM, DFF}; pg8::StaticOrder S; S.init(MTOK, DM, G, bx);
        pg8::EpiDown E{args.out, (const bf16_t*)(ws + WS_XN), (float*)(ws + WS_SS3), -1};
        pg8::gemm_phase<pg8::EpiDown, pg8::StaticOrder, PG8_ALIGN, PG8_SP2>(lds, g, S, E);
        SEAM(6);
    }
    if (IN(7)) p7_final(args, vcu, G, wave, lane);
#undef IN
#undef SEAM
}

extern "C" void kernel_launch(void* const* d_in, const int* in_sizes, int n_in, void* d_out, int out_size, void* d_ws, size_t ws_size, hipStream_t stream) {
    static int grid = 0;
    if (grid == 0) {
        if (n_in != 18 || ws_size < WS_END) { fprintf(stderr, "kernel_launch: unexpected inputs / workspace (%d, %zu)\n", n_in, ws_size); grid = -1; return; }
        int dev = 0, cus = 0;
        if (hipGetDevice(&dev) != hipSuccess || hipDeviceGetAttribute(&cus, hipDeviceAttributeMultiprocessorCount, dev) != hipSuccess) { grid = -1; return; }
        if (hipFuncSetAttribute((const void*)mk_fwd, hipFuncAttributeMaxDynamicSharedMemorySize, LDS_BYTES) != hipSuccess) { fprintf(stderr, "kernel_launch: hipFuncSetAttribute failed\n"); grid = -1; return; }
        (void)hipGetLastError();
        grid = cus;
    }
    if (grid < 0) return;
    (void)hipMemsetAsync((char*)d_ws + WS_CTL, 0, 1 * MiB, stream);
    Args a{};
    a.x = (const float*)d_in[0]; a.positions = (const int*)d_in[1]; a.norm1_g = (const float*)d_in[2]; a.w_in = (const float*)d_in[3]; a.cmp_pos = (const float*)d_in[4];
    a.cmp_w1 = (const float*)d_in[5]; a.cmp_w2 = (const float*)d_in[6]; a.nsa_norm_g = (const float*)d_in[7]; a.conv_w = (const float*)d_in[8]; a.a_log = (const float*)d_in[9];
    a.dt_bias = (const float*)d_in[10]; a.gdn_norm_g = (const float*)d_in[11]; a.w_out = (const float*)d_in[12]; a.norm2_g = (const float*)d_in[13]; a.w_gate = (const float*)d_in[14];
    a.w_up = (const float*)d_in[15]; a.w_down = (const float*)d_in[16]; a.final_g = (const float*)d_in[17];
    a.out = (float*)d_out; a.ws = (unsigned char*)d_ws;
    unsigned char* ws = (unsigned char*)d_ws;
    bf16_t* proj = (bf16_t*)(ws + WS_PROJ); bf16_t* mix = (bf16_t*)(ws + WS_MIX);
    auto launch = [&](int lo, int hi) { a.ph_lo = lo; a.ph_hi = hi; hipLaunchKernelGGL(mk_fwd, dim3(grid), dim3(NWAVES * 64), LDS_BYTES, stream, a); };
#if defined(PROBE_SUB3)
    launch(0, 4); (void)hipMemsetAsync((char*)d_ws + WS_CTL, 0, 1 * MiB, stream); a.flags = PROBE_SUB3; launch(3, 4); a.flags = 0; (void)hipMemsetAsync((char*)d_ws + WS_CTL, 0, 1 * MiB, stream); launch(4, 8);
#elif defined(PROBE_SUB)
    launch(0, 3); a.flags = PROBE_SUB; launch(2, 3); a.flags = 0; (void)hipMemsetAsync((char*)d_ws + WS_CTL, 0, 1 * MiB, stream); launch(3, 8);
#elif defined(PROBE_DUP)
    launch(0, PROBE_DUP + 1); (void)hipMemsetAsync((char*)d_ws + WS_CTL, 0, 1 * MiB, stream); launch(PROBE_DUP, 8);
#else
    launch(0, 8);
#endif
}
```

```cpp
#include <hip/hip_runtime.h>
#include <stdint.h>
#include <stdio.h>

typedef unsigned short bf16_t;

constexpr int BATCH = 16, SEQ = 2048, DM = 1024, MTOK = BATCH * SEQ;
constexpr int NSA_HEADS = 8, NSA_G = 2, HPG = 4, HD = 64;
constexpr int NCMP = 127, CMP_L = 32, CMP_S = 16, CMP_HID = 128;
constexpr int NSEL = 32, SELB = 64, TOPN = 8, WIN = 512;
constexpr int GH = 4, GD = 128, DFF = 2816;
constexpr int IN_W = 3360;
constexpr int PJ = 3584;
constexpr int PC_Q = 0, PC_KCMP = 512, PC_VCMP = 640, PC_KSLC = 768, PC_VSLC = 896, PC_KWIN = 1024, PC_VWIN = 1152;
constexpr int PC_GQ = 1280, PC_GK = 1792, PC_GV = 2304, PC_Z = 2816, PC_GATE = 3328, PC_B = 3352, PC_A = 3356;
constexpr float RMS_EPS = 1e-6f;
constexpr int F8_WSCALE = 0x79797979;
constexpr float F8_WMUL = 64.0f;
constexpr float QSCALE = 0.125f * 1.4426950408889634f;

constexpr size_t MiB = 1u << 20;
constexpr size_t WS_CTL = 0;
constexpr size_t WS_ROPE = 1 * MiB;
constexpr size_t WS_KC = 3 * MiB;
constexpr size_t WS_VC = 3 * MiB + 512 * 1024;
constexpr size_t WS_SSQN = 4 * MiB;
constexpr size_t WS_SS2 = 5 * MiB;
constexpr size_t WS_SS3 = 7 * MiB;
constexpr size_t WS_WIN = 9 * MiB;
constexpr size_t WS_WOUT = 16 * MiB;
constexpr size_t WS_WGU = 18 * MiB;
constexpr size_t WS_WDN = 29 * MiB;
constexpr size_t WS_W1T = 35 * MiB;
constexpr size_t WS_W2T = 36 * MiB;
constexpr size_t WS_GL = 37 * MiB;
constexpr size_t WS_XN = 40 * MiB;
constexpr size_t WS_MIX = 104 * MiB;
constexpr size_t WS_PROJ = 168 * MiB;
constexpr size_t WS_X1F8 = 392 * MiB;
constexpr size_t WS_END = 424 * MiB;

__device__ __forceinline__ float bf2f(bf16_t v) { return __uint_as_float(((unsigned)v) << 16); }
__device__ __forceinline__ bf16_t f2bf(float f) { unsigned u = __float_as_uint(f); return (bf16_t)((u + 0x7fffu + ((u >> 16) & 1u)) >> 16); }
__device__ __forceinline__ float wave_sum(float v) {
#pragma unroll
    for (int o = 1; o < 64; o <<= 1) v += __shfl_xor(v, o);
    return v;
}
__device__ __forceinline__ float wave_max(float v) {
#pragma unroll
    for (int o = 1; o < 64; o <<= 1) v = fmaxf(v, __shfl_xor(v, o));
    return v;
}
__device__ __forceinline__ float siluf(float x) { return x * __builtin_amdgcn_rcpf(1.f + __builtin_amdgcn_exp2f(-1.4426950408889634f * x)); }
__device__ __forceinline__ float sigmf(float x) { return __builtin_amdgcn_rcpf(1.f + __builtin_amdgcn_exp2f(-1.4426950408889634f * x)); }

__host__ __device__ __forceinline__ int win_orig_col(int p) {
    if (p < 1280) return p;
    if (p < 2816) return p - 1280 + 1304;
    if (p < 3328) return p - 2816 + 2840;
    if (p < 3352) return p - 3328 + 1280;
    if (p < 3360) return p;
    return -1;
}

constexpr int PROF_WORD_OFF = 147456 - 512 + 64;
#ifdef PROF_SEG
#ifndef PROF_BLOCK
#define PROF_BLOCK 0
#endif
#define PROF_DECL unsigned long long _pt0 = 0;
#define PROF_BEGIN(id) if ((id) == PROF_SEG) _pt0 = __builtin_amdgcn_s_memrealtime();
#define PROF_END(id) if ((id) == PROF_SEG && threadIdx.x == 0 && blockIdx.x == PROF_BLOCK) { *(__attribute__((address_space(3))) unsigned*)(lds + PROF_WORD_OFF) += (unsigned)(__builtin_amdgcn_s_memrealtime() - _pt0); }
#define PROF_FLUSH() do { if (threadIdx.x == 0 && blockIdx.x == PROF_BLOCK) { __attribute__((address_space(3))) unsigned* pw_ = (__attribute__((address_space(3))) unsigned*)(lds + PROF_WORD_OFF); const unsigned d_ = *pw_; *pw_ = 0u; \
        const unsigned long long t0_ = __builtin_amdgcn_s_memrealtime(); while (__builtin_amdgcn_s_memrealtime() - t0_ < (unsigned long long)d_) __builtin_amdgcn_s_sleep(4); } __syncthreads(); } while (0)
#else
#define PROF_DECL
#define PROF_BEGIN(id)
#define PROF_END(id)
#define PROF_FLUSH() do {} while (0)
#endif
__global__ void __launch_bounds__(128) k_compress_naive(const bf16_t* proj, const float* cmp_pos, const float* w1, const float* w2, bf16_t* kc, bf16_t* vc) {
    int id = blockIdx.x; const int n = id & 127; id >>= 7; const int g = id & 1; id >>= 1; const int b = id & 15; const int i = id >> 4;
    const int j = threadIdx.x; __shared__ float hid[128];
    bf16_t* outp = (i == 0 ? kc : vc) + ((size_t)(b * 2 + g) * 128 + n) * 64;
    if (n == 127) { if (j < 64) outp[j] = 0; return; }
    const bf16_t* xb = proj + (size_t)(b * SEQ + 16 * n) * PJ + (i == 0 ? PC_KCMP : PC_VCMP) + g * 64;
    const float* pw = w1 + (size_t)i * 2048 * 128; const float* pp = cmp_pos + i * 2048;
    float acc = 0.f;
    for (int l = 0; l < 32; ++l)
        for (int d = 0; d < 64; ++d) acc += (bf2f(xb[(size_t)l * PJ + d]) + pp[l * 64 + d]) * pw[(size_t)(l * 64 + d) * 128 + j];
    hid[j] = siluf(acc); __syncthreads();
    if (j < 64) { float o = 0.f; const float* q = w2 + (size_t)i * 128 * 64;
        for (int jj = 0; jj < 128; ++jj) o += hid[jj] * q[jj * 64 + j];
        outp[j] = f2bf(o); }
}
__global__ void __launch_bounds__(256) k_nsa_naive(const bf16_t* proj, const bf16_t* kc, const bf16_t* vc, bf16_t* mix, float* ssqn) {
    const int m = blockIdx.x >> 1, g = blockIdx.x & 1, b = m / SEQ, t = m % SEQ;
    const int w = threadIdx.x >> 6, lane = threadIdx.x & 63, head = g * 4 + w, cur = t >> 6;
    __shared__ float sc[4][512]; __shared__ float imp[32]; __shared__ unsigned selmask; __shared__ int sellist[8];
    const float NEGB = -1e30f;
    float q[64];
    { const bf16_t* qp = proj + (size_t)m * PJ + PC_Q + head * 64;
#pragma unroll
      for (int d = 0; d < 64; ++d) q[d] = bf2f(qp[d]); }
    const size_t rowb = (size_t)b * SEQ;
    float o_cmp = 0.f;
    {
        const bf16_t* kcb = kc + (size_t)(b * 2 + g) * 128 * 64; const bf16_t* vcb = vc + (size_t)(b * 2 + g) * 128 * 64;
        float s[2]; float mx = NEGB;
#pragma unroll
        for (int i = 0; i < 2; ++i) { const int n = lane + 64 * i; float a = 0.f; const bf16_t* kp = kcb + n * 64;
#pragma unroll
            for (int d = 0; d < 64; ++d) a += q[d] * bf2f(kp[d]);
            const bool valid = (n < NCMP) && (16 * n + 31 <= t); s[i] = valid ? a : NEGB; mx = fmaxf(mx, s[i]); }
        mx = wave_max(mx); float p[2], sum = 0.f;
#pragma unroll
        for (int i = 0; i < 2; ++i) { p[i] = s[i] > -1e29f ? exp2f(s[i] - mx) : 0.f; sum += p[i]; }
        sum = wave_sum(sum); const float inv = (t >= 31 && sum > 0.f) ? 1.f / sum : 0.f;
#pragma unroll
        for (int i = 0; i < 2; ++i) sc[w][lane + 64 * i] = p[i] * inv;
        __syncthreads();
        for (int n = 0; n < NCMP; ++n) o_cmp += sc[w][n] * bf2f(vcb[n * 64 + lane]);
        if (threadIdx.x < 32) { const int s_ = threadIdx.x; float a = 0.f;
            for (int h = 0; h < 4; ++h) for (int n = 4 * s_ - 1; n <= 4 * s_ + 3; ++n) if (n >= 0 && n < NCMP) a += sc[h][n];
            imp[s_] = a; }
        __syncthreads();
        if (threadIdx.x == 0) { unsigned mask = 0u;
            for (int r = 0; r < TOPN; ++r) { float best = -3e38f; int bi = 0;
                for (int j = 0; j < NSEL; ++j) { if (mask >> j & 1u) continue;
                    const bool forced = (j == 0) || (j == cur) || (j == cur - 1);
                    const float v = forced ? 1e9f : (j <= cur ? imp[j] : NEGB);
                    if (v > best) { best = v; bi = j; } }
                mask |= 1u << bi; sellist[r] = bi; }
            selmask = mask; }
        __syncthreads();
    }
    float o_slc = 0.f;
    {
        float s[8]; float mx = NEGB;
#pragma unroll
        for (int i = 0; i < 8; ++i) { const int j = sellist[i]; const int kpos = 64 * j + lane; float a = NEGB;
            if (kpos <= t) { const bf16_t* kp = proj + (rowb + kpos) * PJ + PC_KSLC + g * 64; a = 0.f;
#pragma unroll
                for (int d = 0; d < 64; ++d) a += q[d] * bf2f(kp[d]); }
            s[i] = a; mx = fmaxf(mx, a); }
        mx = wave_max(mx); float sum = 0.f;
#pragma unroll
        for (int i = 0; i < 8; ++i) { s[i] = s[i] > -1e29f ? exp2f(s[i] - mx) : 0.f; sum += s[i]; }
        sum = wave_sum(sum); const float inv = 1.f / sum;
        __syncthreads();
#pragma unroll
        for (int i = 0; i < 8; ++i) sc[w][i * 64 + lane] = s[i] * inv;
        __syncthreads();
        for (int i = 0; i < 8; ++i) { const int j = sellist[i]; if (64 * j > t) continue;
            for (int kk = 0; kk < 64; ++kk) { const int kpos = 64 * j + kk; if (kpos > t) break;
                o_slc += sc[w][i * 64 + kk] * bf2f(proj[(rowb + kpos) * PJ + PC_VSLC + g * 64 + lane]); } }
    }
    float o_win = 0.f;
    {
        float s[8]; float mx = NEGB;
#pragma unroll
        for (int i = 0; i < 8; ++i) { const int kpos = t - 511 + lane + 64 * i; float a = NEGB;
            if (kpos >= 0) { const bf16_t* kp = proj + (rowb + kpos) * PJ + PC_KWIN + g * 64; a = 0.f;
#pragma unroll
                for (int d = 0; d < 64; ++d) a += q[d] * bf2f(kp[d]); }
            s[i] = a; mx = fmaxf(mx, a); }
        mx = wave_max(mx); float sum = 0.f;
#pragma unroll
        for (int i = 0; i < 8; ++i) { s[i] = s[i] > -1e29f ? exp2f(s[i] - mx) : 0.f; sum += s[i]; }
        sum = wave_sum(sum); const float inv = 1.f / sum;
        __syncthreads();
#pragma unroll
        for (int i = 0; i < 8; ++i) sc[w][i * 64 + lane] = s[i] * inv;
        __syncthreads();
        for (int kk = 0; kk < 512; ++kk) { const int kpos = t - 511 + kk; if (kpos < 0) continue;
            o_win += sc[w][kk] * bf2f(proj[(rowb + kpos) * PJ + PC_VWIN + g * 64 + lane]); }
    }
    const bf16_t* gp = proj + (size_t)m * PJ + PC_GATE + head * 3;
    const float o = sigmf(bf2f(gp[0])) * o_cmp + sigmf(bf2f(gp[1])) * o_slc + sigmf(bf2f(gp[2])) * o_win;
    mix[(size_t)m * DM + head * 64 + lane] = f2bf(o);
    const float ss = wave_sum(o * o);
    if (lane == 0) ssqn[m * 8 + head] = ss;
}
__global__ void __launch_bounds__(128) k_gdn_naive(const bf16_t* proj, const float* conv_w, const float* a_log, const float* dt_bias, const float* norm_g, bf16_t* mix) {
    const int b = blockIdx.x >> 2, h = blockIdx.x & 3, n = threadIdx.x, wv = n >> 6, lane = n & 63;
    __shared__ float shq[128], shk[128]; __shared__ float red[2][4];
    float S[128];
#pragma unroll
    for (int k = 0; k < 128; ++k) S[k] = 0.f;
    float wq[4], wk[4], wvv[4];
#pragma unroll
    for (int j = 0; j < 4; ++j) { wq[j] = conv_w[j * 1536 + h * 128 + n]; wk[j] = conv_w[j * 1536 + 512 + h * 128 + n]; wvv[j] = conv_w[j * 1536 + 1024 + h * 128 + n]; }
    float xq0 = 0.f, xq1 = 0.f, xq2 = 0.f, xk0 = 0.f, xk1 = 0.f, xk2 = 0.f, xv0 = 0.f, xv1 = 0.f, xv2 = 0.f;
    const float Aexp = -__expf(a_log[h]), dtb = dt_bias[h], ng = norm_g[n];
    for (int t = 0; t < SEQ; ++t) {
        const bf16_t* pr = proj + (size_t)(b * SEQ + t) * PJ;
        const float xq3 = bf2f(pr[PC_GQ + h * 128 + n]), xk3 = bf2f(pr[PC_GK + h * 128 + n]), xv3 = bf2f(pr[PC_GV + h * 128 + n]);
        float qv = siluf(wq[0] * xq0 + wq[1] * xq1 + wq[2] * xq2 + wq[3] * xq3);
        float kv = siluf(wk[0] * xk0 + wk[1] * xk1 + wk[2] * xk2 + wk[3] * xk3);
        const float vv = siluf(wvv[0] * xv0 + wvv[1] * xv1 + wvv[2] * xv2 + wvv[3] * xv3);
        xq0 = xq1; xq1 = xq2; xq2 = xq3; xk0 = xk1; xk1 = xk2; xk2 = xk3; xv0 = xv1; xv1 = xv2; xv2 = xv3;
        float sq = wave_sum(qv * qv), sk = wave_sum(kv * kv);
        if (lane == 0) { red[wv][0] = sq; red[wv][1] = sk; }
        __syncthreads();
        sq = red[0][0] + red[1][0]; sk = red[0][1] + red[1][1];
        qv *= rsqrtf(sq + RMS_EPS) * 0.08838834764831845f; kv *= rsqrtf(sk + RMS_EPS);
        shq[n] = qv; shk[n] = kv;
        __syncthreads();
        const float beta = sigmf(bf2f(pr[PC_B + h])); const float av = bf2f(pr[PC_A + h]) + dtb;
        const float sp = av > 20.f ? av : log1pf(__expf(av)); const float eg = __expf(Aexp * sp);
        float dot = 0.f;
#pragma unroll
        for (int k = 0; k < 128; ++k) dot += S[k] * shk[k];
        const float vn = beta * (vv - eg * dot);
        float o = 0.f;
#pragma unroll
        for (int k = 0; k < 128; ++k) { S[k] = eg * S[k] + shk[k] * vn; o += S[k] * shq[k]; }
        float so = wave_sum(o * o);
        if (lane == 0) red[wv][2] = so;
        __syncthreads();
        so = red[0][2] + red[1][2];
        const float z = bf2f(pr[PC_Z + h * 128 + n]);
        mix[(size_t)(b * SEQ + t) * DM + 512 + h * 128 + n] = f2bf(o * rsqrtf(so * (1.f / 128.f) + RMS_EPS) * ng * siluf(z));
    }
}

namespace pg8 {
#define PG8_LAS __attribute__((address_space(3)))
typedef unsigned short bf16_t;
typedef short bf16x8 __attribute__((ext_vector_type(8)));
typedef float f32x4 __attribute__((ext_vector_type(4)));
typedef unsigned u32x4 __attribute__((ext_vector_type(4)));
constexpr int BM = 256, BK = 64, HALF = 128, HTB = HALF * BK * 2  , STAGE_BYTES = 8 * HTB, NXCD = 8, WGM = 8;

__host__ __device__ __forceinline__ int lds_byte(int r, int c) { const int st = (r >> 4) * 2 + (c >> 5), rr = r & 15, cc = c & 31, ob = rr * 64 + cc * 2; return st * 1024 + (ob ^ (((ob >> 9) & 1) << 5)); }
__host__ __device__ __forceinline__ void stage_rc(int b, int& R, int& C) { const int st = b / 1024, sb = b % 1024, swz = sb ^ (((sb >> 9) & 1) << 5); R = (st >> 1) * 16 + swz / 64; C = (st & 1) * 32 + (swz % 64) / 2; }
__host__ __device__ __forceinline__ int perm32(int rho) { const int n = rho >> 4, i = rho & 15; return 8 * (i >> 2) + 4 * n + (i & 3); }

struct Unit { int pm, pn; };
struct Gemm { const bf16_t* A; const bf16_t* Bt; int M, N, K; };

struct StaticOrder {
    int nM, nN, nwg, G, c;
    __host__ __device__ void init(int M, int N, int G_, int c_) { nM = M / BM; nN = N / BM; nwg = nM * nN; G = G_; c = c_; }
    __host__ __device__ bool next(int i, Unit& u) const {
        const long L = (long)i * G + c; if (L >= nwg) return false;
        int wgid = (int)L; { const int q = nwg / NXCD, r = nwg % NXCD, xcd = wgid % NXCD, off = wgid / NXCD; wgid = (xcd < r ? xcd * (q + 1) : r * (q + 1) + (xcd - r) * q) + off; }
        const int nig = WGM * nN, gid = wgid / nig, fm = gid * WGM, gsz = (nM - fm) < WGM ? (nM - fm) : WGM;
        u.pm = fm + ((wgid % nig) % gsz); u.pn = (wgid % nig) / gsz; return true;
    }
    __device__ __forceinline__ void a_ready(const Unit&) const {}
    __device__ __forceinline__ void done(const Unit&) const {}
};
__device__ __forceinline__ unsigned cvt_pk_bf16(float lo, float hi) { unsigned r; asm volatile("v_cvt_pk_bf16_f32 %0, %1, %2" : "=v"(r) : "v"(lo), "v"(hi)); return r; }
typedef unsigned u32x2 __attribute__((ext_vector_type(2)));
__device__ __forceinline__ unsigned pk4_fp8(float a, float b, float c_, float d) { unsigned w = 0u; w = __builtin_amdgcn_cvt_pk_fp8_f32(a, b, w, false); w = __builtin_amdgcn_cvt_pk_fp8_f32(c_, d, w, true); return w; }
__device__ __forceinline__ float fast_silu(float v) { return v * __builtin_amdgcn_rcpf(1.0f + __builtin_amdgcn_exp2f(-1.4426950408889634f * v)); }

struct EpiProj {
    static constexpr bool PERM = true, AFTER_DRAIN = false, MIDSCALE = false;
    bf16_t* out; const float* rope; int mid_t;
    __device__ __forceinline__ void midscale(f32x4 (&)[2][2][4][2], const Unit&, int, int) const {}
    __device__ __forceinline__ void operator()(const f32x4 (&acc)[2][2][4][2], const Unit& u, int wr, int wc, int fr, int fq) const {
        const int row0 = u.pm * BM + wr * 64 + fr, colt = u.pn * BM, lcol = wc * 32 + 8 * fq;
        const float sc = (u.pn < 2) ? QSCALE : 1.f;
        const bool wave_rope = ((wc & 1) == 0) && (u.pn < 5);
#pragma unroll
        for (int ai = 0; ai < 2; ++ai)
#pragma unroll
            for (int m = 0; m < 4; ++m) {
                const int r = row0 + ai * HALF + m * 16;
                f32x4 c0 = {1.f, 1.f, 1.f, 1.f}, c1 = c0, s0 = {0.f, 0.f, 0.f, 0.f}, s1 = s0;
                if (wave_rope) { const f32x4* tp = (const f32x4*)(rope + (size_t)r * 16); c0 = tp[0]; c1 = tp[1]; s0 = tp[2]; s1 = tp[3]; }
                bf16_t* rowp = out + (size_t)r * PJ + colt + lcol;
#pragma unroll
                for (int bj = 0; bj < 2; ++bj) {
                    f32x4 v0 = acc[ai][bj][m][0] * sc, v1 = acc[ai][bj][m][1] * sc;
                    const bool tile_rope = wave_rope && ((u.pn < 2) || (bj == 0));
                    if (tile_rope) {
                        f32x4 p0, p1;
#pragma unroll
                        for (int j = 0; j < 4; ++j) { p0[j] = __shfl_xor(v0[j], 16); p1[j] = __shfl_xor(v1[j], 16); }
                        if (fq == 0) { v0 = v0 * c0 - p0 * s0; v1 = v1 * c1 - p1 * s1; }
                        else if (fq == 1) { v0 = v0 * c0 + p0 * s0; v1 = v1 * c1 + p1 * s1; }
                    }
                    u32x4 w; w.x = cvt_pk_bf16(v0[0], v0[1]); w.y = cvt_pk_bf16(v0[2], v0[3]); w.z = cvt_pk_bf16(v1[0], v1[1]); w.w = cvt_pk_bf16(v1[2], v1[3]);
                    *(u32x4*)(rowp + bj * HALF) = w;
                }
            }
    }
};
struct EpiOut {
    static constexpr bool PERM = false, AFTER_DRAIN = false, MIDSCALE = true;
    const float* x; unsigned char* x1f8; bf16_t* x1b; float* ss2; const float* ssqn; int mid_t;
    __device__ __forceinline__ void midscale(f32x4 (&acc)[2][2][4][2], const Unit& u, int wr, int fr) const {
#pragma unroll
        for (int ai = 0; ai < 2; ++ai)
#pragma unroll
            for (int m = 0; m < 4; ++m) {
                const int r = u.pm * BM + ai * HALF + wr * 64 + m * 16 + fr;
                const f32x4 a = *(const f32x4*)(ssqn + (size_t)r * 8), b = *(const f32x4*)(ssqn + (size_t)r * 8 + 4);
                const float s = ((a[0] + a[1]) + (a[2] + a[3])) + ((b[0] + b[1]) + (b[2] + b[3]));
                const float rs = __builtin_amdgcn_rsqf(s * (1.0f / 512.0f) + RMS_EPS);
#pragma unroll
                for (int bj = 0; bj < 2; ++bj)
#pragma unroll
                    for (int n = 0; n < 2; ++n) acc[ai][bj][m][n] = acc[ai][bj][m][n] * rs;
            }
    }
    __device__ __forceinline__ void operator()(const f32x4 (&acc)[2][2][4][2], const Unit& u, int wr, int wc, int fr, int fq) const {
#pragma unroll
        for (int ai = 0; ai < 2; ++ai)
#pragma unroll
            for (int m = 0; m < 4; ++m) {
                const int r = u.pm * BM + ai * HALF + wr * 64 + m * 16 + fr; float ssum = 0.f;
#pragma unroll
                for (int bj = 0; bj < 2; ++bj)
#pragma unroll
                    for (int n = 0; n < 2; ++n) {
                        const size_t off = (size_t)r * DM + u.pn * BM + bj * HALF + wc * 32 + n * 16 + 4 * fq;
                        const f32x4 y = *(const f32x4*)(x + off) + acc[ai][bj][m][n];
                        u32x2 w; w.x = cvt_pk_bf16(y[0], y[1]); w.y = cvt_pk_bf16(y[2], y[3]); *(u32x2*)(x1b + off) = w;
                        *(unsigned*)(x1f8 + off) = pk4_fp8(y[0], y[1], y[2], y[3]); asm volatile("" ::: "memory");
                        ssum += (y[0] * y[0] + y[1] * y[1]) + (y[2] * y[2] + y[3] * y[3]);
                    }
                ssum += __shfl_xor(ssum, 16); ssum += __shfl_xor(ssum, 32);
                if (fq == 0) ss2[(size_t)r * 16 + u.pn * 4 + wc] = ssum;
            }
    }
};
struct EpiGU {
    static constexpr bool PERM = true, AFTER_DRAIN = false, MIDSCALE = false;
    unsigned char* h; const float* ss2; int mid_t;
    __device__ __forceinline__ void midscale(f32x4 (&)[2][2][4][2], const Unit&, int, int) const {}
    __device__ __forceinline__ void operator()(const f32x4 (&acc)[2][2][4][2], const Unit& u, int wr, int wc, int fr, int fq) const {
#pragma unroll
        for (int ai = 0; ai < 2; ++ai)
#pragma unroll
            for (int m = 0; m < 4; ++m) {
                const int r = u.pm * BM + ai * HALF + wr * 64 + m * 16 + fr;
                const f32x4* sp = (const f32x4*)(ss2 + (size_t)r * 16); const f32x4 a = sp[0], b = sp[1], c = sp[2], d = sp[3];
                const f32x4 t = (a + b) + (c + d); const float s = (t[0] + t[1]) + (t[2] + t[3]);
                const float rs = __builtin_amdgcn_rsqf(s * (1.0f / 1024.0f) + RMS_EPS);
                const f32x4 g0 = acc[ai][0][m][0] * rs, g1 = acc[ai][0][m][1] * rs, u0 = acc[ai][1][m][0] * rs, u1 = acc[ai][1][m][1] * rs;
                float o[8];
#pragma unroll
                for (int j = 0; j < 4; ++j) { o[j] = fast_silu(g0[j]) * u0[j]; o[4 + j] = fast_silu(g1[j]) * u1[j]; }
                u32x2 w; w.x = pk4_fp8(o[0], o[1], o[2], o[3]); w.y = pk4_fp8(o[4], o[5], o[6], o[7]);
                *(u32x2*)(h + (size_t)r * DFF + u.pn * 128 + wc * 32 + 8 * fq) = w;
                asm volatile("" ::: "memory"); __builtin_amdgcn_sched_barrier(0);
            }
    }
};
struct EpiDown {
    static constexpr bool PERM = false, AFTER_DRAIN = false, MIDSCALE = false;
    float* x1; const bf16_t* x1b; float* ss3; int mid_t;
    __device__ __forceinline__ void midscale(f32x4 (&)[2][2][4][2], const Unit&, int, int) const {}
    __device__ __forceinline__ void operator()(const f32x4 (&acc)[2][2][4][2], const Unit& u, int wr, int wc, int fr, int fq) const {
#pragma unroll
        for (int ai = 0; ai < 2; ++ai)
#pragma unroll
            for (int m = 0; m < 4; ++m) {
                const int r = u.pm * BM + ai * HALF + wr * 64 + m * 16 + fr; float ssum = 0.f;
#pragma unroll
                for (int bj = 0; bj < 2; ++bj)
#pragma unroll
                    for (int n = 0; n < 2; ++n) {
                        const size_t off = (size_t)r * DM + u.pn * BM + bj * HALF + wc * 32 + n * 16 + 4 * fq;
                        const u32x2 xb = *(const u32x2*)(x1b + off);
                        const f32x4 xr = {__uint_as_float(xb.x << 16), __uint_as_float(xb.x & 0xffff0000u), __uint_as_float(xb.y << 16), __uint_as_float(xb.y & 0xffff0000u)};
                        const f32x4 y = xr + acc[ai][bj][m][n];
                        *(f32x4*)(x1 + off) = y;
                        ssum += (y[0] * y[0] + y[1] * y[1]) + (y[2] * y[2] + y[3] * y[3]);
                    }
                ssum += __shfl_xor(ssum, 16); ssum += __shfl_xor(ssum, 32);
                if (fq == 0) ss3[(size_t)r * 16 + u.pn * 4 + wc] = ssum;
            }
    }
};
typedef int v8i32 __attribute__((ext_vector_type(8)));
typedef int v4i32 __attribute__((ext_vector_type(4)));
__device__ __forceinline__ v8i32 cat8(bf16x8 lo, bf16x8 hi) { return __builtin_shufflevector(__builtin_bit_cast(v4i32, lo), __builtin_bit_cast(v4i32, hi), 0, 1, 2, 3, 4, 5, 6, 7); }
template <class Epi, class Sched, bool ALIGN_EPI = false, bool SP2 = false, bool F8 = false>
__device__ __forceinline__ void gemm_phase(PG8_LAS unsigned char* lds, const Gemm g, const Sched& S, const Epi& E) {
    const int tid = threadIdx.x, wid = __builtin_amdgcn_readfirstlane(tid >> 6), lane = tid & 63, wr = wid >> 2, wc = wid & 3, fr = lane & 15, fq = lane >> 4;
    const int K = g.K, nt = K / BK;
    unsigned voffA[2], voffB[2];
#pragma unroll
    for (int i = 0; i < 2; ++i) { int R, C; stage_rc(tid * 16 + i * 8192, R, C); const int Rb = Epi::PERM ? ((R & ~31) + perm32(R & 31)) : R;
        voffA[i] = (unsigned)(R * K + C) * 2u; voffB[i] = (unsigned)(Rb * K + C) * 2u; }
    const size_t kstep = (size_t)(BK * 2);
    const size_t hstep = (size_t)HALF * K * 2;
    const size_t tstep = 2 * hstep;
    const unsigned ldsw = (unsigned)wid * 1024u;
    const int aoff = lds_byte(wr * 64 + fr, fq * 8), boff = lds_byte(wc * 32 + fr, fq * 8);
#define PG8_SA(b, h) (((b) * 2 + (h)) * HTB)
#define PG8_SB(b, h) ((4 + (b) * 2 + (h)) * HTB)
#define PG8_STAGE(bufoff, gbase, voff) do { _Pragma("unroll") for (int _i = 0; _i < 2; ++_i) \
        __builtin_amdgcn_global_load_lds((const unsigned*)((const char*)(gbase) + (voff)[_i]), (PG8_LAS unsigned*)(lds + (bufoff) + ldsw + _i * 8192), 16, 0, 0); } while (0)
#define PG8_LDA(dst, b, h) do { if constexpr (F8) { _Pragma("unroll") for (int m = 0; m < 4; ++m) dst##8[m] = cat8(*(const PG8_LAS bf16x8*)(lds + PG8_SA(b, h) + aoff + m * 2048), *(const PG8_LAS bf16x8*)(lds + PG8_SA(b, h) + aoff + m * 2048 + 1024)); } \
        else { _Pragma("unroll") for (int m = 0; m < 4; ++m) _Pragma("unroll") for (int k = 0; k < 2; ++k) dst[m][k] = *(const PG8_LAS bf16x8*)(lds + PG8_SA(b, h) + aoff + m * 2048 + k * 1024); } } while (0)
#define PG8_LDB(dst, b, h) do { if constexpr (F8) { _Pragma("unroll") for (int n = 0; n < 2; ++n) dst##8[n] = cat8(*(const PG8_LAS bf16x8*)(lds + PG8_SB(b, h) + boff + n * 2048), *(const PG8_LAS bf16x8*)(lds + PG8_SB(b, h) + boff + n * 2048 + 1024)); } \
        else { _Pragma("unroll") for (int n = 0; n < 2; ++n) _Pragma("unroll") for (int k = 0; k < 2; ++k) dst[n][k] = *(const PG8_LAS bf16x8*)(lds + PG8_SB(b, h) + boff + n * 2048 + k * 1024); } } while (0)
#define PG8_MMA(ai, bj, At, Bt) do { __builtin_amdgcn_s_setprio(1); if constexpr (F8) { _Pragma("unroll") for (int m = 0; m < 4; ++m) _Pragma("unroll") for (int n = 0; n < 2; ++n) \
        asm volatile("v_mfma_scale_f32_16x16x128_f8f6f4 %0, %1, %2, %0, %3, %4 op_sel_hi:[0,0,0]" : "+v"(acc[ai][bj][m][n]) : "v"(Bt##8[n]), "v"(At##8[m]), "v"(f8sw), "v"(f8sa)); } else { \
        _Pragma("unroll") for (int m = 0; m < 4; ++m) _Pragma("unroll") for (int n = 0; n < 2; ++n) _Pragma("unroll") for (int k = 0; k < 2; ++k) \
        acc[ai][bj][m][n] = __builtin_amdgcn_mfma_f32_16x16x32_bf16(Bt[n][k], At[m][k], acc[ai][bj][m][n], 0, 0, 0); } __builtin_amdgcn_s_setprio(0); } while (0)
#define PG8_WAIT_V(n) asm volatile("s_waitcnt vmcnt(" #n ")" ::: "memory")
#define PG8_WAIT_L(n) asm volatile("s_waitcnt lgkmcnt(" #n ")" ::: "memory")
#define PG8_BAR __builtin_amdgcn_s_barrier()
#define PG8_SCHED __builtin_amdgcn_sched_barrier(0)
    Unit cur, nxt; int ui = 0;
    if (!S.next(0, cur)) return;
    f32x4 acc[2][2][4][2];
#pragma unroll
    for (int a = 0; a < 2; ++a)
#pragma unroll
        for (int b = 0; b < 2; ++b)
#pragma unroll
            for (int m = 0; m < 4; ++m)
#pragma unroll
                for (int n = 0; n < 2; ++n) acc[a][b][m][n] = (f32x4){0.f, 0.f, 0.f, 0.f};
    bf16x8 At[4][2], B0[2][2], B1[2][2]; v8i32 At8[4], B08[2], B18[2];
    int f8sw = F8_WSCALE, f8sa = 0x7f7f7f7f; asm volatile("" : "+v"(f8sw), "+v"(f8sa));
    const char* cA = (const char*)g.A + (size_t)cur.pm * tstep; const char* cB = (const char*)g.Bt + (size_t)cur.pn * tstep;
    S.a_ready(cur);
    if constexpr (SP2) {
        PG8_STAGE(PG8_SB(0, 0), cB, voffB); PG8_STAGE(PG8_SB(0, 1), cB + hstep, voffB); PG8_STAGE(PG8_SA(0, 0), cA, voffA); PG8_STAGE(PG8_SA(0, 1), cA + hstep, voffA);
        if (wr == 1) PG8_BAR;
        PG8_WAIT_V(2); PG8_BAR;
        PG8_STAGE(PG8_SB(1, 0), cB + kstep, voffB); PG8_STAGE(PG8_SA(1, 0), cA + kstep, voffA); PG8_STAGE(PG8_SB(1, 1), cB + hstep + kstep, voffB);
        PG8_WAIT_V(6); PG8_BAR;
    } else {
        PG8_STAGE(PG8_SB(0, 0), cB, voffB); PG8_STAGE(PG8_SA(0, 0), cA, voffA); PG8_STAGE(PG8_SB(0, 1), cB + hstep, voffB); PG8_STAGE(PG8_SA(0, 1), cA + hstep, voffA);
        if (wr == 1) PG8_BAR;
        PG8_WAIT_V(4); PG8_BAR;
        PG8_STAGE(PG8_SB(1, 0), cB + kstep, voffB); PG8_STAGE(PG8_SA(1, 0), cA + kstep, voffA); PG8_STAGE(PG8_SB(1, 1), cB + hstep + kstep, voffB);
        PG8_WAIT_V(6); PG8_BAR;
    }
    for (;;) {
        const bool has_next = S.next(ui + 1, nxt);
        const char* nA = has_next ? (const char*)g.A + (size_t)nxt.pm * tstep : cA; const char* nB = has_next ? (const char*)g.Bt + (size_t)nxt.pn * tstep : cB;
#pragma unroll 1
        for (int t = 0; t < nt; t += 2) {
            const bool last = (t == nt - 2);
            if constexpr (Epi::MIDSCALE) { if (t == E.mid_t) E.midscale(acc, cur, wr, fr); }
            const char* a1 = cA + (size_t)(t + 1) * kstep;
            const char* a2 = last ? nA : cA + (size_t)(t + 2) * kstep; const char* b2 = last ? nB : cB + (size_t)(t + 2) * kstep;
            const char* a3 = a2 + kstep; const char* b3 = b2 + kstep;
            if (last && has_next) S.a_ready(nxt);
            if constexpr (SP2) {
            PG8_LDB(B0, 0, 0); PG8_LDB(B1, 0, 1); PG8_SCHED; PG8_LDA(At, 0, 0); PG8_STAGE(PG8_SA(1, 1), a1 + hstep, voffA);
            PG8_WAIT_V(8); PG8_WAIT_L(0); PG8_BAR; PG8_MMA(0, 0, At, B0); PG8_MMA(0, 1, At, B1); PG8_BAR; PG8_SCHED;
            PG8_LDA(At, 0, 1); PG8_STAGE(PG8_SB(0, 0), b2, voffB); PG8_STAGE(PG8_SB(0, 1), b2 + hstep, voffB); PG8_STAGE(PG8_SA(0, 0), a2, voffA);
            PG8_WAIT_V(8); PG8_WAIT_L(0); PG8_BAR; PG8_MMA(1, 0, At, B0); PG8_MMA(1, 1, At, B1); PG8_BAR; PG8_SCHED;
            PG8_LDB(B0, 1, 0); PG8_LDB(B1, 1, 1); PG8_SCHED; PG8_LDA(At, 1, 0); PG8_STAGE(PG8_SA(0, 1), a2 + hstep, voffA);
            PG8_WAIT_V(8); PG8_WAIT_L(0); PG8_BAR; PG8_MMA(0, 0, At, B0); PG8_MMA(0, 1, At, B1); PG8_BAR; PG8_SCHED;
            PG8_LDA(At, 1, 1); PG8_STAGE(PG8_SB(1, 0), b3, voffB); PG8_STAGE(PG8_SB(1, 1), b3 + hstep, voffB); PG8_STAGE(PG8_SA(1, 0), a3, voffA);
            PG8_WAIT_V(8); PG8_WAIT_L(0); PG8_BAR; PG8_MMA(1, 0, At, B0); PG8_MMA(1, 1, At, B1); PG8_BAR; PG8_SCHED;
            } else {
            PG8_LDB(B0, 0, 0); PG8_SCHED; PG8_LDA(At, 0, 0); PG8_STAGE(PG8_SA(1, 1), a1 + hstep, voffA);
            PG8_WAIT_L(8); PG8_BAR; PG8_WAIT_L(0); PG8_MMA(0, 0, At, B0); PG8_BAR; PG8_SCHED;
            PG8_LDB(B1, 0, 1); PG8_STAGE(PG8_SB(0, 0), b2, voffB);
            PG8_BAR; PG8_WAIT_L(0); PG8_MMA(0, 1, At, B1); PG8_BAR;
            PG8_LDA(At, 0, 1); PG8_STAGE(PG8_SA(0, 0), a2, voffA);
            PG8_BAR; PG8_WAIT_L(0); PG8_MMA(1, 0, At, B0); PG8_BAR; PG8_SCHED;
            PG8_STAGE(PG8_SB(0, 1), b2 + hstep, voffB);
            PG8_WAIT_V(6); PG8_BAR; PG8_MMA(1, 1, At, B1); PG8_BAR;
            PG8_LDB(B0, 1, 0); PG8_SCHED; PG8_LDA(At, 1, 0); PG8_STAGE(PG8_SA(0, 1), a2 + hstep, voffA);
            PG8_WAIT_L(8); PG8_BAR; PG8_WAIT_L(0); PG8_MMA(0, 0, At, B0); PG8_BAR; PG8_SCHED;
            PG8_LDB(B1, 1, 1); PG8_STAGE(PG8_SB(1, 0), b3, voffB);
            PG8_BAR; PG8_WAIT_L(0); PG8_MMA(0, 1, At, B1); PG8_BAR;
            PG8_LDA(At, 1, 1); PG8_STAGE(PG8_SA(1, 0), a3, voffA);
            PG8_BAR; PG8_WAIT_L(0); PG8_MMA(1, 0, At, B0); PG8_BAR; PG8_SCHED;
            PG8_STAGE(PG8_SB(1, 1), b3 + hstep, voffB);
            PG8_WAIT_V(6); PG8_BAR; PG8_MMA(1, 1, At, B1); PG8_BAR;
            }
        }
        if constexpr (ALIGN_EPI) { if (wr == 0) PG8_BAR; }
        if constexpr (!Epi::AFTER_DRAIN) { E(acc, cur, wr, wc, fr, fq); S.done(cur); }
        if (!has_next) break;
#pragma unroll
        for (int a = 0; a < 2; ++a)
#pragma unroll
            for (int b = 0; b < 2; ++b)
#pragma unroll
                for (int m = 0; m < 4; ++m)
#pragma unroll
                    for (int n = 0; n < 2; ++n) acc[a][b][m][n] = (f32x4){0.f, 0.f, 0.f, 0.f};
        cur = nxt; cA = nA; cB = nB; ++ui;
        if constexpr (ALIGN_EPI) { if (wr == 1) PG8_BAR; }
    }
    PG8_WAIT_V(0);
    if constexpr (!ALIGN_EPI) { if (wr == 0) PG8_BAR; }
    PG8_BAR;
    if constexpr (Epi::AFTER_DRAIN) { E.fused(acc, cur, wr, wc, fr, fq, lds, wid, lane); S.done(cur); }
#undef PG8_SA
#undef PG8_SB
#undef PG8_STAGE
#undef PG8_LDA
#undef PG8_LDB
#undef PG8_MMA
#undef PG8_WAIT_V
#undef PG8_WAIT_L
#undef PG8_BAR
#undef PG8_SCHED
}
}

#ifndef PG8_SP2
#define PG8_SP2 true
#endif

#define LAS __attribute__((address_space(3)))
#define XB_TMO      128
#define XB_XCNT(j)  (256  + 64 * (j))
#define XB_XSUB(j)  (1280 + 64 * (j))
#define XB_XGEN(j)  (2304 + 64 * (j))
#define XB_TOP      3328
#define XB_TOPGEN   3392
#define XCD_BAR_WORDS 3456
#define XB_SPIN_CAP (1u << 18)

__device__ __forceinline__ unsigned xb_ld(unsigned* p)              { return __hip_atomic_load(p, __ATOMIC_RELAXED, __HIP_MEMORY_SCOPE_AGENT); }
__device__ __forceinline__ unsigned xb_add(unsigned* p, unsigned v) { return __hip_atomic_fetch_add(p, v, __ATOMIC_RELAXED, __HIP_MEMORY_SCOPE_AGENT); }
__device__ __forceinline__ unsigned xb_xcc_id() { return (unsigned)__builtin_amdgcn_s_getreg((3 << 11) | 20) & 0xFu; }
#define XB_SPIN(cond, bar) do { unsigned _sp = 0; while (cond) { __builtin_amdgcn_s_sleep(1); \
    if ((++_sp & 255u) == 0u) { if (xb_ld(&(bar)[XB_TMO])) break; if (_sp > XB_SPIN_CAP) { atomicAdd(&(bar)[XB_TMO], 1u); break; } } } } while (0)

struct XcdBarrier {
    unsigned* bar; unsigned x;
    volatile LAS unsigned* st;
};

__device__ __forceinline__ XcdBarrier xcd_barrier_post(unsigned* bar, volatile LAS unsigned* st) {
    XcdBarrier b; b.bar = bar; b.x = xb_xcc_id(); b.st = st;
    if (threadIdx.x == 0) (void)xb_add(&bar[XB_XCNT(b.x)], 1u);
    return b;
}
__device__ __forceinline__ void xcd_barrier_complete(unsigned* bar, unsigned x, unsigned& nloc, unsigned& nx) {
    const unsigned G = gridDim.x * gridDim.y * gridDim.z;
    unsigned sum, cnt, mine, sp = 0u;
    for (;;) {
        sum = 0u; cnt = 0u; mine = 0u;
#pragma unroll
        for (unsigned j = 0; j < 16; ++j) { const unsigned c = xb_ld(&bar[XB_XCNT(j)]); sum += c; cnt += (c > 0u) ? 1u : 0u; mine = (j == x) ? c : mine; }
        if (sum == G) break;
        __builtin_amdgcn_s_sleep(1);
        if ((++sp & 255u) == 0u) { if (xb_ld(&bar[XB_TMO])) break; if (sp > XB_SPIN_CAP) { atomicAdd(&bar[XB_TMO], 1u); break; } }
    }
    nloc = mine > 0u ? mine : 1u; nx = cnt > 0u ? cnt : 1u;
}

__device__ __forceinline__ void xcd_barrier(const XcdBarrier& b) {
    asm volatile("s_waitcnt vmcnt(0)" ::: "memory");
    __syncthreads();
    if (threadIdx.x == 0) {
        unsigned* bar = b.bar;
        __builtin_amdgcn_s_waitcnt(0);
        unsigned nloc = b.st[0], nx = b.st[1];
        if (nloc == 0u) { xcd_barrier_complete(bar, b.x, nloc, nx); b.st[0] = nloc; b.st[1] = nx; }
        const unsigned old = xb_add(&bar[XB_XSUB(b.x)], 1u);
        const unsigned gen = old / nloc;
        if (old + 1u == (gen + 1u) * nloc) {
            __builtin_amdgcn_fence(__ATOMIC_RELEASE, "agent");
            asm volatile("s_waitcnt vmcnt(0)" ::: "memory");
            const unsigned og = xb_add(&bar[XB_TOP], 1u);
            const unsigned tg = og / nx;
            if (og + 1u == (tg + 1u) * nx) xb_add(&bar[XB_TOPGEN], 1u);
            else XB_SPIN(xb_ld(&bar[XB_TOPGEN]) == tg, bar);
            __builtin_amdgcn_fence(__ATOMIC_ACQUIRE, "agent");
            xb_add(&bar[XB_XGEN(b.x)], 1u);
            asm volatile("s_waitcnt vmcnt(0)" ::: "memory");
        } else {
            XB_SPIN(xb_ld(&bar[XB_XGEN(b.x)]) == gen, bar);
            __builtin_amdgcn_fence(__ATOMIC_ACQUIRE, "agent");
            asm volatile("s_waitcnt vmcnt(0)" ::: "memory");
        }
    }
    __syncthreads();
}

struct Args {
    const float* x; const int* positions; const float* norm1_g; const float* w_in; const float* cmp_pos; const float* cmp_w1; const float* cmp_w2;
    const float* nsa_norm_g; const float* conv_w; const float* a_log; const float* dt_bias; const float* gdn_norm_g; const float* w_out; const float* norm2_g;
    const float* w_gate; const float* w_up; const float* w_down; const float* final_g;
    float* out; unsigned char* ws; int ph_lo, ph_hi, flags, pad;
};

#ifndef LAS
#define LAS __attribute__((address_space(3)))
#endif
namespace nsa {
typedef float f32x16 __attribute__((ext_vector_type(16)));
typedef float f32x4 __attribute__((ext_vector_type(4)));
typedef float f32x2 __attribute__((ext_vector_type(2)));
typedef __bf16 bf16x2_t __attribute__((ext_vector_type(2)));
typedef short bf16x8 __attribute__((ext_vector_type(8)));
typedef short s16x4 __attribute__((ext_vector_type(4)));
typedef unsigned u32x4 __attribute__((ext_vector_type(4)));
typedef unsigned u32x2 __attribute__((ext_vector_type(2)));

constexpr int L_KV = 0, KV_STAGE = 16384;
constexpr int L_IMP = 49152;
constexpr int L_SELM = 81920;
constexpr int L_UNION = 81920 + 256;
constexpr int L_QUEUE = 81920 + 260;
constexpr int L_RED = 0;
constexpr int L_HT = 81920 + 512;
constexpr float THR = 8.0f;
constexpr float NEG_INF = -__builtin_inff();

__device__ __forceinline__ int crow(int r, int hi) { return (r & 3) + 8 * (r >> 2) + 4 * hi; }
__device__ __forceinline__ unsigned cvtpk(float lo, float hi) { f32x2 v = {lo, hi}; bf16x2_t b = __builtin_convertvector(v, bf16x2_t); return __builtin_bit_cast(unsigned, b); }
__device__ __forceinline__ bf16x8 pack8(float a0, float a1, float a2, float a3, float a4, float a5, float a6, float a7) {
    u32x4 w; w.x = cvtpk(a0, a1); w.y = cvtpk(a2, a3); w.z = cvtpk(a4, a5); w.w = cvtpk(a6, a7); return __builtin_bit_cast(bf16x8, w); }
__device__ __forceinline__ void dma_tile(const unsigned char* gbase, size_t pitch, LAS unsigned char* dst, int wave, int lane) {
    const int row = wave * 8 + (lane >> 3); const int c = (lane & 7) ^ (lane >> 3);
    __builtin_amdgcn_global_load_lds((const unsigned*)(gbase + (size_t)row * pitch + c * 16), (LAS unsigned*)(dst + wave * 1024), 16, 0, 0);
}
typedef short v4i16_t __attribute__((ext_vector_type(4)));
__device__ __forceinline__ s16x4 vtr(LAS const unsigned char* p) { return __builtin_bit_cast(s16x4, __builtin_amdgcn_ds_read_tr16_b64_v4i16((LAS v4i16_t*)p)); }

__device__ __forceinline__ void qk_tile(f32x16& p0, f32x16& p1, LAS const unsigned char* kbuf, const bf16x8 (&qr)[4], int r32, int hi, const f32x16& cinit) {
    LAS const unsigned char* k0 = kbuf + r32 * 128; const int sw = r32 & 7;
    { const int off = ((0 + hi) ^ sw) << 4;
      p0 = __builtin_amdgcn_mfma_f32_32x32x16_bf16(*(LAS const bf16x8*)(k0 + off), qr[0], cinit, 0, 0, 0);
      p1 = __builtin_amdgcn_mfma_f32_32x32x16_bf16(*(LAS const bf16x8*)(k0 + 4096 + off), qr[0], cinit, 0, 0, 0); }
#pragma unroll
    for (int ds = 1; ds < 4; ++ds) {
        const int off = ((2 * ds + hi) ^ sw) << 4;
        const bf16x8 a0 = *(LAS const bf16x8*)(k0 + off), a1 = *(LAS const bf16x8*)(k0 + 4096 + off);
        p0 = __builtin_amdgcn_mfma_f32_32x32x16_bf16(a0, qr[ds], p0, 0, 0, 0);
        p1 = __builtin_amdgcn_mfma_f32_32x32x16_bf16(a1, qr[ds], p1, 0, 0, 0);
    }
}
#define NSA_TR(dst, addr, off) asm volatile("ds_read_b64_tr_b16 %0, %1 offset:%c2" : "=&v"(dst) : "v"(addr), "i"(off) : "memory")
__device__ __forceinline__ void pv_tile(f32x16 (&o)[2], unsigned va0, unsigned va1, const bf16x8 (&pb)[4]) {
    s16x4 lo[4], hh[4];
    NSA_TR(lo[0], va0, 0); NSA_TR(hh[0], va0, 1024); NSA_TR(lo[1], va0, 2048); NSA_TR(hh[1], va0, 3072);
    NSA_TR(lo[2], va0, 4096); NSA_TR(hh[2], va0, 5120); NSA_TR(lo[3], va0, 6144); NSA_TR(hh[3], va0, 7168);
    asm volatile("s_waitcnt lgkmcnt(0)" ::: "memory"); __builtin_amdgcn_sched_barrier(0);
#pragma unroll
    for (int ks = 0; ks < 4; ++ks) { const bf16x8 a = {lo[ks][0], lo[ks][1], lo[ks][2], lo[ks][3], hh[ks][0], hh[ks][1], hh[ks][2], hh[ks][3]};
        o[0] = __builtin_amdgcn_mfma_f32_32x32x16_bf16(a, pb[ks], o[0], 0, 0, 0); }
    s16x4 lo2[4], hh2[4];
    NSA_TR(lo2[0], va1, 0); NSA_TR(hh2[0], va1, 1024); NSA_TR(lo2[1], va1, 2048); NSA_TR(hh2[1], va1, 3072);
    NSA_TR(lo2[2], va1, 4096); NSA_TR(hh2[2], va1, 5120); NSA_TR(lo2[3], va1, 6144); NSA_TR(hh2[3], va1, 7168);
    asm volatile("s_waitcnt lgkmcnt(0)" ::: "memory"); __builtin_amdgcn_sched_barrier(0);
#pragma unroll
    for (int ks = 0; ks < 4; ++ks) { const bf16x8 a = {lo2[ks][0], lo2[ks][1], lo2[ks][2], lo2[ks][3], hh2[ks][0], hh2[ks][1], hh2[ks][2], hh2[ks][3]};
        o[1] = __builtin_amdgcn_mfma_f32_32x32x16_bf16(a, pb[ks], o[1], 0, 0, 0); }
}
__device__ __forceinline__ float max3f(float a, float b, float c) { return __builtin_fmaxf(__builtin_fmaxf(a, b), c); }
__device__ __forceinline__ float max32(const f32x16& p, const f32x16& q) {
    float a = max3f(p[0], p[1], p[2]), b = max3f(q[0], q[1], q[2]);
    a = max3f(a, p[3], p[4]); b = max3f(b, q[3], q[4]); a = max3f(a, p[5], p[6]); b = max3f(b, q[5], q[6]);
    a = max3f(a, p[7], p[8]); b = max3f(b, q[7], q[8]); a = max3f(a, p[9], p[10]); b = max3f(b, q[9], q[10]);
    a = max3f(a, p[11], p[12]); b = max3f(b, q[11], q[12]); a = max3f(a, p[13], p[14]); b = max3f(b, q[13], q[14]);
    return max3f(a, b, __builtin_fmaxf(p[15], q[15]));
}
__device__ __forceinline__ float max16(const f32x16& p) {
    float a = max3f(p[0], p[1], p[2]), b = max3f(p[3], p[4], p[5]); a = max3f(a, p[6], p[7]); b = max3f(b, p[8], p[9]);
    a = max3f(a, p[10], p[11]); b = max3f(b, p[12], p[13]); return max3f(a, b, __builtin_fmaxf(p[14], p[15]));
}
__device__ __forceinline__ float sum16(const f32x16& p) {
    return (((p[0] + p[1]) + (p[2] + p[3])) + ((p[4] + p[5]) + (p[6] + p[7]))) + (((p[8] + p[9]) + (p[10] + p[11])) + ((p[12] + p[13]) + (p[14] + p[15])));
}
__device__ __forceinline__ void mask_tile(f32x16& p0, f32x16& p1, int key0, int hi, int lo, int hi_) {
    const int rlo = lo - key0 - 4 * hi, rhi = hi_ - key0 - 4 * hi;
#pragma unroll
    for (int r = 0; r < 16; ++r) { const int k = (r & 3) + 8 * (r >> 2);
        p0[r] = (k >= rlo && k <= rhi) ? p0[r] : NEG_INF; p1[r] = (k + 32 >= rlo && k + 32 <= rhi) ? p1[r] : NEG_INF; }
}
__device__ __forceinline__ void attn_tile(LAS const unsigned char* kbuf, unsigned vb0, unsigned vb1, const bf16x8 (&qr)[4],
                                          f32x16 (&o)[2], f32x16& negm, float& mref, float& l, bool& seen, int key0, int lo, int hi_, int mode, bool lanesel, int r32, int hi) {
    f32x16 p0, p1;
    if (mode == 0) qk_tile(p0, p1, kbuf, qr, r32, hi, negm);
    else { f32x16 ci;
#pragma unroll
        for (int r = 0; r < 16; ++r) ci[r] = lanesel ? negm[r] : NEG_INF;
        qk_tile(p0, p1, kbuf, qr, r32, hi, ci);
        if (mode == 2) mask_tile(p0, p1, key0, hi, lo, hi_); }
    float mx = max32(p0, p1); mx = fmaxf(mx, __shfl_xor(mx, 32));
    const bool fin = mx > -1e29f;
    const float d = seen ? (mx > THR ? mx : 0.f) : (fin ? mx : 0.f);
    if (__any(d != 0.f)) {
        const float f = seen ? __builtin_amdgcn_exp2f(-d) : 1.f;
        mref += d; l *= f; o[0] = o[0] * f; o[1] = o[1] * f;
#pragma unroll
        for (int r = 0; r < 16; ++r) { p0[r] -= d; p1[r] -= d; negm[r] = -mref; }
    }
    seen = seen || fin;
#pragma unroll
    for (int r = 0; r < 16; ++r) { p0[r] = __builtin_amdgcn_exp2f(p0[r]); p1[r] = __builtin_amdgcn_exp2f(p1[r]); }
    l += sum16(p0) + sum16(p1);
    bf16x8 pb[4];
    pb[0] = pack8(p0[0], p0[1], p0[2], p0[3], p0[4], p0[5], p0[6], p0[7]); pb[1] = pack8(p0[8], p0[9], p0[10], p0[11], p0[12], p0[13], p0[14], p0[15]);
    pb[2] = pack8(p1[0], p1[1], p1[2], p1[3], p1[4], p1[5], p1[6], p1[7]); pb[3] = pack8(p1[8], p1[9], p1[10], p1[11], p1[12], p1[13], p1[14], p1[15]);
    pv_tile(o, vb0, vb1, pb);
}

__device__ __forceinline__ void attn_unit(unsigned char* ws, LAS unsigned char* lds, int b, int g, int qb, int wave, int lane) {
    const int tid = threadIdx.x, r32 = lane & 31, hi = lane >> 5, hh = wave >> 1, th = wave & 1, head = g * 4 + hh;
    const int tl = 32 * th + r32, t = 64 * qb + tl; const size_t m = (size_t)b * SEQ + t;
    const bf16_t* proj = (const bf16_t*)(ws + WS_PROJ);
    const unsigned char* pb_ = (const unsigned char*)(proj + (size_t)b * SEQ * PJ);
    LAS unsigned char* kv = lds + L_KV; const unsigned kva = (unsigned)(uintptr_t)kv;
    LAS float* IMP = (LAS float*)(lds + L_IMP); LAS unsigned* SELM = (LAS unsigned*)(lds + L_SELM); LAS unsigned* UNI = (LAS unsigned*)(lds + L_UNION);
    const int gq = (lane & 15) >> 2, gp = lane & 3, x7 = 4 * hi + gq, clow = 2 * ((lane >> 4) & 1) + (gp >> 1);
    const int vo0 = x7 * 128 + (((0 + clow) ^ x7) << 4) + (gp & 1) * 8, vo1 = x7 * 128 + (((4 + clow) ^ x7) << 4) + (gp & 1) * 8;
    bf16x8 qr[4];
    { const bf16_t* qp = proj + m * PJ + PC_Q + head * 64 + 8 * hi;
#pragma unroll
      for (int ds = 0; ds < 4; ++ds) qr[ds] = *(const bf16x8*)(qp + 16 * ds); }
    const bf16_t* gp_ = proj + m * PJ + PC_GATE + head * 3;
    const float g_cmp = sigmf(bf2f(gp_[0])), g_slc = sigmf(bf2f(gp_[1])), g_win = sigmf(bf2f(gp_[2]));
    f32x16 outa[2]; outa[0] = (f32x16){}; outa[1] = (f32x16){};
    if (tid == 0) *UNI = 0u;
    PROF_DECL PROF_BEGIN(11)
    {
        const bool two = qb >= 16;
        const unsigned char* kcb = ws + WS_KC + (size_t)(b * 2 + g) * 128 * 128; const unsigned char* vcb = ws + WS_VC + (size_t)(b * 2 + g) * 128 * 128;
        dma_tile(kcb, 128, kv, wave, lane); dma_tile(vcb, 128, kv + 8192, wave, lane);
        if (two) { dma_tile(kcb + 64 * 128, 128, kv + KV_STAGE, wave, lane); dma_tile(vcb + 64 * 128, 128, kv + KV_STAGE + 8192, wave, lane); }
        asm volatile("s_waitcnt vmcnt(0)" ::: "memory"); __syncthreads();
        f32x16 c00, c01, c10, c11;
        const f32x16 zc = (f32x16){};
        qk_tile(c00, c01, kv, qr, r32, hi, zc);
        const int nmax = t >= 31 ? (((t - 31) >> 4) < 126 ? ((t - 31) >> 4) : 126) : -1;
        mask_tile(c00, c01, 0, hi, 0, nmax);
        if (two) { qk_tile(c10, c11, kv + KV_STAGE, qr, r32, hi, zc); mask_tile(c10, c11, 64, hi, 0, nmax); }
        else { c10 = (f32x16){}; c11 = (f32x16){};
#pragma unroll
            for (int r = 0; r < 16; ++r) { c10[r] = NEG_INF; c11[r] = NEG_INF; } }
        float mx = fmaxf(fmaxf(max16(c00), max16(c01)), fmaxf(max16(c10), max16(c11))); mx = fmaxf(mx, __shfl_xor(mx, 32));
        mx = fmaxf(mx, -1e30f);
#pragma unroll
        for (int r = 0; r < 16; ++r) { c00[r] = __builtin_amdgcn_exp2f(c00[r] - mx); c01[r] = __builtin_amdgcn_exp2f(c01[r] - mx);
            c10[r] = __builtin_amdgcn_exp2f(c10[r] - mx); c11[r] = __builtin_amdgcn_exp2f(c11[r] - mx); }
        float ls = (sum16(c00) + sum16(c01)) + (sum16(c10) + sum16(c11)); ls += __shfl_xor(ls, 32);
        const float inv = ls > 0.f ? 1.0f / ls : 0.f;
        c00 = c00 * inv; c01 = c01 * inv; c10 = c10 * inv; c11 = c11 * inv;
        float Gv[16], Ev[16];
#pragma unroll
        for (int a = 0; a < 4; ++a) {
            Gv[a] = (c00[4 * a] + c00[4 * a + 1]) + (c00[4 * a + 2] + c00[4 * a + 3]); Ev[a] = c00[4 * a + 3];
            Gv[4 + a] = (c01[4 * a] + c01[4 * a + 1]) + (c01[4 * a + 2] + c01[4 * a + 3]); Ev[4 + a] = c01[4 * a + 3];
            Gv[8 + a] = (c10[4 * a] + c10[4 * a + 1]) + (c10[4 * a + 2] + c10[4 * a + 3]); Ev[8 + a] = c10[4 * a + 3];
            Gv[12 + a] = (c11[4 * a] + c11[4 * a + 1]) + (c11[4 * a + 2] + c11[4 * a + 3]); Ev[12 + a] = c11[4 * a + 3];
        }
        LAS float* ip = IMP + ((hh * 64 + tl) * 32) + hi;
#pragma unroll
        for (int a = 0; a < 16; ++a) {
            const float eprev = a > 0 ? Ev[a > 0 ? a - 1 : 0] : 0.f;
            const float send = hi ? eprev : Ev[a];
            const float recv = __shfl_xor(send, 32);
            ip[2 * a] = Gv[a] + recv;
        }
        f32x16 oc[2]; oc[0] = (f32x16){}; oc[1] = (f32x16){};
        { bf16x8 pb[4];
          pb[0] = pack8(c00[0], c00[1], c00[2], c00[3], c00[4], c00[5], c00[6], c00[7]); pb[1] = pack8(c00[8], c00[9], c00[10], c00[11], c00[12], c00[13], c00[14], c00[15]);
          pb[2] = pack8(c01[0], c01[1], c01[2], c01[3], c01[4], c01[5], c01[6], c01[7]); pb[3] = pack8(c01[8], c01[9], c01[10], c01[11], c01[12], c01[13], c01[14], c01[15]);
          pv_tile(oc, kva + 8192 + vo0, kva + 8192 + vo1, pb); }
        if (two) { bf16x8 pb[4];
          pb[0] = pack8(c10[0], c10[1], c10[2], c10[3], c10[4], c10[5], c10[6], c10[7]); pb[1] = pack8(c10[8], c10[9], c10[10], c10[11], c10[12], c10[13], c10[14], c10[15]);
          pb[2] = pack8(c11[0], c11[1], c11[2], c11[3], c11[4], c11[5], c11[6], c11[7]); pb[3] = pack8(c11[8], c11[9], c11[10], c11[11], c11[12], c11[13], c11[14], c11[15]);
          pv_tile(oc, kva + KV_STAGE + 8192 + vo0, kva + KV_STAGE + 8192 + vo1, pb); }
        outa[0] = oc[0] * g_cmp; outa[1] = oc[1] * g_cmp;
    }
    __syncthreads();
    PROF_END(11) PROF_BEGIN(12)
    {
        const int tok = 8 * wave + (lane >> 3), sub = lane & 7;
        f32x4 v = *(LAS const f32x4*)(IMP + (0 * 64 + tok) * 32 + 4 * sub);
        v = v + *(LAS const f32x4*)(IMP + (1 * 64 + tok) * 32 + 4 * sub);
        v = v + *(LAS const f32x4*)(IMP + (2 * 64 + tok) * 32 + 4 * sub);
        v = v + *(LAS const f32x4*)(IMP + (3 * 64 + tok) * 32 + 4 * sub);
        float sc[4];
#pragma unroll
        for (int i = 0; i < 4; ++i) { const int s = 4 * sub + i; const bool forced = (s == 0) || (s == qb) || (s == qb - 1);
            sc[i] = forced ? 1e9f : (s <= qb ? v[i] : -1e30f); }
        unsigned taken = 0u, mask = 0u;
#pragma unroll 1
        for (int round = 0; round < TOPN; ++round) {
            float bv = -3e38f; int bi = 64;
#pragma unroll
            for (int i = 0; i < 4; ++i) { const bool ok = !((taken >> i) & 1u) && sc[i] > bv; bv = ok ? sc[i] : bv; bi = ok ? 4 * sub + i : bi; }
#pragma unroll
            for (int off = 1; off < 8; off <<= 1) { const float ov = __shfl_xor(bv, off); const int oi = __shfl_xor(bi, off);
                const bool take = (ov > bv) || (ov == bv && oi < bi); bv = take ? ov : bv; bi = take ? oi : bi; }
            mask |= 1u << bi; if ((bi >> 2) == sub) taken |= 1u << (bi & 3);
        }
        if (sub == 0) SELM[tok] = mask;
        unsigned um = mask; um |= __shfl_xor(um, 8); um |= __shfl_xor(um, 16); um |= __shfl_xor(um, 32);
        if (lane == 0) atomicOr((unsigned*)UNI, um);
    }
    __syncthreads();
    PROF_END(12) PROF_BEGIN(13)
    const unsigned mysel = SELM[tl]; const unsigned uni = *UNI;
    {
        const int wlo = qb > 8 ? qb - 8 : 0;
        unsigned wrem = ((2u << qb) - 1u) & ~((1u << wlo) - 1u);
        unsigned srem = uni & ((2u << qb) - 1u);
        const unsigned char* kwin = pb_ + (size_t)(PC_KWIN + g * 64) * 2; const unsigned char* vwin = pb_ + (size_t)(PC_VWIN + g * 64) * 2;
        const unsigned char* kslc = pb_ + (size_t)(PC_KSLC + g * 64) * 2; const unsigned char* vslc = pb_ + (size_t)(PC_VSLC + g * 64) * 2;
        const size_t pitch = (size_t)PJ * 2;
#define NEXT_TILE(B, J) do { if (wrem) { B = 1; J = __builtin_ctz(wrem); wrem &= wrem - 1; } else if (srem) { B = 2; J = __builtin_ctz(srem); srem &= srem - 1; } else { B = 0; J = 0; } } while (0)
#define ISSUE_TILE(B, J, ST) do { LAS unsigned char* d_ = kv + (ST) * KV_STAGE; \
            dma_tile(((B) == 1 ? kwin : kslc) + (size_t)(J) * 64 * pitch, pitch, d_, wave, lane); dma_tile(((B) == 1 ? vwin : vslc) + (size_t)(J) * 64 * pitch, pitch, d_ + 8192, wave, lane); } while (0)
        int cb, cj, nb_, nj, n2b, n2j;
        NEXT_TILE(cb, cj); NEXT_TILE(nb_, nj);
        ISSUE_TILE(cb, cj, 0); if (nb_) ISSUE_TILE(nb_, nj, 1);
        int st = 0;
        f32x16 o[2]; o[0] = (f32x16){}; o[1] = (f32x16){}; f32x16 negm = (f32x16){}; float mref = 0.f, lrun = 0.f; bool seen = false; int prevb = cb;
        while (cb) {
            NEXT_TILE(n2b, n2j);
            if (nb_) asm volatile("s_waitcnt vmcnt(2)" ::: "memory"); else asm volatile("s_waitcnt vmcnt(0)" ::: "memory");
            __builtin_amdgcn_s_barrier(); asm volatile("" ::: "memory");
            { const int st2 = st >= 1 ? st - 1 : 2;
              if (n2b) ISSUE_TILE(n2b, n2j, st2); }
            if (cb != prevb) {
                float lt = lrun + __shfl_xor(lrun, 32); const float f = g_win / lt;
                outa[0] = outa[0] + o[0] * f; outa[1] = outa[1] + o[1] * f;
                o[0] = (f32x16){}; o[1] = (f32x16){}; negm = (f32x16){}; mref = 0.f; lrun = 0.f; seen = false; prevb = cb;
            }
            LAS const unsigned char* kb = kv + st * KV_STAGE;
            {
                bool run = true, lsel = true; int mode, lo_ = 0, hi2 = t;
                if (cb == 1) { mode = ((cj >= qb - 7) && (cj <= qb - 1)) ? 0 : 2; lo_ = t - (WIN - 1); }
                else { lsel = (mysel >> cj) & 1u; const unsigned long long bal = __ballot(lsel);
                    run = bal != 0ull; mode = (cj == qb) ? 2 : ((bal == ~0ull) ? 0 : 1); }
                if (run) attn_tile(kb, kva + st * KV_STAGE + 8192 + vo0, kva + st * KV_STAGE + 8192 + vo1, qr, o, negm, mref, lrun, seen, 64 * cj, lo_, hi2, mode, lsel, r32, hi);
            }
            cb = nb_; cj = nj; nb_ = n2b; nj = n2j; st = st == 2 ? 0 : st + 1;
        }
#undef NEXT_TILE
#undef ISSUE_TILE
        { float lt = lrun + __shfl_xor(lrun, 32); const float f = (prevb == 1 ? g_win : g_slc) / lt;
          outa[0] = outa[0] + o[0] * f; outa[1] = outa[1] + o[1] * f; }
    }
    PROF_END(13) PROF_BEGIN(14)
    {
        bf16_t* mp = (bf16_t*)(ws + WS_MIX) + m * DM + head * 64; float ss = 0.f;
#pragma unroll
        for (int dt = 0; dt < 2; ++dt)
#pragma unroll
            for (int a = 0; a < 4; ++a) {
                const float y0 = outa[dt][4 * a], y1 = outa[dt][4 * a + 1], y2 = outa[dt][4 * a + 2], y3 = outa[dt][4 * a + 3];
                ss += (y0 * y0 + y1 * y1) + (y2 * y2 + y3 * y3);
                u32x2 w; w.x = cvtpk(y0, y1); w.y = cvtpk(y2, y3);
                *(u32x2*)(mp + 32 * dt + 8 * a + 4 * hi) = w;
            }
        ss += __shfl_xor(ss, 32);
        if (hi == 0) ((float*)(ws + WS_SSQN))[m * 8 + head] = ss;
    }
    __syncthreads();
    PROF_END(14)
}

__device__ __forceinline__ void compress_unit(unsigned char* ws, const float* cmp_pos, LAS unsigned char* lds, int unit, int wave, int lane) {
    PROF_DECL PROF_BEGIN(31)
    const int nh = unit & 1, g = (unit >> 1) & 1, b = (unit >> 2) & 15, i = unit >> 6;
    const int c = lane & 15, q = lane >> 4;
    const bf16_t* proj = (const bf16_t*)(ws + WS_PROJ); const bf16_t* w1t = (const bf16_t*)(ws + WS_W1T) + (size_t)i * 128 * 2048;
    const bf16_t* w2t = (const bf16_t*)(ws + WS_W2T) + (size_t)i * 64 * 128;
    f32x4 acc[8][4];
#pragma unroll
    for (int jt = 0; jt < 8; ++jt)
#pragma unroll
        for (int nt = 0; nt < 4; ++nt) acc[jt][nt] = (f32x4){0.f, 0.f, 0.f, 0.f};
#pragma unroll 2
    for (int s = 0; s < 8; ++s) {
        const int ks = 8 * wave + s, l = ks >> 1, d0 = (ks & 1) * 32 + 8 * q;
        const f32x4 pA = *(const f32x4*)(cmp_pos + i * 2048 + l * 64 + d0), pB = *(const f32x4*)(cmp_pos + i * 2048 + l * 64 + d0 + 4);
        bf16x8 bfr[4];
#pragma unroll
        for (int nt = 0; nt < 4; ++nt) { const int n = 16 * (4 * nh + nt) + c;
            const u32x4 xv = *(const u32x4*)(proj + (size_t)(b * SEQ + 16 * n + l) * PJ + (i ? PC_VCMP : PC_KCMP) + g * 64 + d0);
            bfr[nt] = pack8(__uint_as_float(xv.x << 16) + pA[0], __uint_as_float(xv.x & 0xffff0000u) + pA[1], __uint_as_float(xv.y << 16) + pA[2], __uint_as_float(xv.y & 0xffff0000u) + pA[3],
                            __uint_as_float(xv.z << 16) + pB[0], __uint_as_float(xv.z & 0xffff0000u) + pB[1], __uint_as_float(xv.w << 16) + pB[2], __uint_as_float(xv.w & 0xffff0000u) + pB[3]); }
#pragma unroll
        for (int jt = 0; jt < 8; ++jt) { const bf16x8 af = *(const bf16x8*)(w1t + (size_t)(16 * jt + c) * 2048 + 32 * ks + 8 * q);
#pragma unroll
            for (int nt = 0; nt < 4; ++nt) acc[jt][nt] = __builtin_amdgcn_mfma_f32_16x16x32_bf16(af, bfr[nt], acc[jt][nt], 0, 0, 0); }
    }
    LAS f32x4* RED = (LAS f32x4*)(lds + L_RED); LAS unsigned char* HT = lds + L_HT;
#pragma unroll
    for (int nt = 0; nt < 4; ++nt) {
#pragma unroll
        for (int jt = 0; jt < 8; ++jt) RED[(wave * 8 + jt) * 64 + lane] = acc[jt][nt];
        __syncthreads();
        f32x4 h = RED[(0 * 8 + wave) * 64 + lane];
#pragma unroll
        for (int w2 = 1; w2 < 8; ++w2) h = h + RED[(w2 * 8 + wave) * 64 + lane];
        { u32x2 w; w.x = cvtpk(siluf(h[0]), siluf(h[1])); w.y = cvtpk(siluf(h[2]), siluf(h[3])); *(LAS u32x2*)(HT + nt * 4096 + c * 256 + (16 * wave + 4 * q) * 2) = w; }
        __syncthreads();
    }
    {
        const int et = wave & 3;
#pragma unroll
        for (int k2 = 0; k2 < 2; ++k2) { const int nt = 2 * (wave >> 2) + k2; f32x4 o2 = {0.f, 0.f, 0.f, 0.f};
#pragma unroll
            for (int s = 0; s < 4; ++s) { const bf16x8 bf = *(LAS const bf16x8*)(HT + nt * 4096 + c * 256 + (32 * s + 8 * q) * 2);
                const bf16x8 af = *(const bf16x8*)(w2t + (size_t)(16 * et + c) * 128 + 32 * s + 8 * q);
                o2 = __builtin_amdgcn_mfma_f32_16x16x32_bf16(af, bf, o2, 0, 0, 0); }
            const int n = 16 * (4 * nh + nt) + c;
            bf16_t* outp = (bf16_t*)(ws + (i ? WS_VC : WS_KC)) + ((size_t)(b * 2 + g) * 128 + n) * 64 + 16 * et + 4 * q;
            u32x2 w; w.x = cvtpk(o2[0], o2[1]); w.y = cvtpk(o2[2], o2[3]); if (n == 127) { w.x = 0u; w.y = 0u; }
            *(u32x2*)outp = w; }
    }
    __syncthreads();
    PROF_END(31)
}
}

namespace gdn {
typedef float f32x4 __attribute__((ext_vector_type(4)));
typedef short bf16x8 __attribute__((ext_vector_type(8)));
typedef unsigned u32x4 __attribute__((ext_vector_type(4)));
typedef unsigned u32x2 __attribute__((ext_vector_type(2)));
using nsa::cvtpk; using nsa::pack8;

constexpr int REC_W = 0, REC_QG = 16384, REC_KD = 32768, REC_QK = 49152, REC_BYTES = 57344;
constexpr int UREC_BYTES = 32768;
constexpr int NCHUNK = SEQ / 64;
constexpr int P_KR = 0, P_QR = 16384, P_STG = 32768, P_AT = 32768, P_QKI = 49152, P_SC = 67584, P_HALF = 69632;
constexpr int SLAB = 17408;
constexpr int SC_BETA = 0, SC_GC = 64, SC_EGC = 128, SC_EKD = 192, SC_RK2 = 256, SC_RQ2 = 320, SC_FKD = 384, SC_FW = 448;
constexpr int S_BUF = 0, S_SSQ = 2 * REC_BYTES;

__device__ __forceinline__ int perm32pos(int kl) { return 8 * ((kl & 15) >> 2) + 4 * (kl >> 4) + (kl & 3); }
__device__ __forceinline__ int off256(int i, int k) { const int pos = perm32pos(k & 31), ch = 4 * (k >> 5) + (pos >> 3); return i * 256 + ((ch ^ (i & 15)) << 4) + (pos & 7) * 2; }
__device__ __forceinline__ int off128(int row, int j) { const int pos = perm32pos(j & 31), ch = 4 * (j >> 5) + (pos >> 3); return row * 128 + ((ch ^ (row & 7)) << 4) + (pos & 7) * 2; }
__device__ __forceinline__ float softplusf(float x) { return x > 20.f ? x : log1pf(__expf(x)); }

__device__ __forceinline__ void conv64(float (&y)[64], LAS const bf16_t* sp, const float* cw, int ch1536, bool first) {
    const float w0 = cw[ch1536], w1 = cw[1536 + ch1536], w2 = cw[2 * 1536 + ch1536], w3 = cw[3 * 1536 + ch1536];
    float x0 = first ? 0.f : bf2f(sp[0]), x1 = first ? 0.f : bf2f(sp[128]), x2 = first ? 0.f : bf2f(sp[256]);
#pragma unroll
    for (int i = 0; i < 64; ++i) { const float x3 = bf2f(sp[(i + 3) * 128]); y[i] = siluf(w0 * x0 + w1 * x1 + w2 * x2 + w3 * x3); x0 = x1; x1 = x2; x2 = x3; }
}
__device__ __forceinline__ void slab_dma(const bf16_t* projrow, const int* cols, int nmat, LAS unsigned char* stg, int w4, int lane) {
    for (int p = w4; p < 17 * nmat; p += 4) { const int mat = p / 17, pr = p % 17;
        __builtin_amdgcn_global_load_lds((const unsigned*)(projrow + (size_t)(4 * pr + (lane >> 4)) * PJ + cols[mat] + (lane & 15) * 8), (LAS unsigned*)(stg + mat * SLAB + pr * 1024), 16, 0, 0); }
}

__device__ __forceinline__ void prep_unit(const Args& a, LAS unsigned char* lds, int u, int wave, int lane) {
    unsigned char* ws = a.ws;
    int tid = threadIdx.x; asm volatile("" : "+v"(tid));
    lane = tid & 63;
    const int half = tid >> 8, c = tid & 255, w4 = wave & 3, fr = lane & 15, fq = lane >> 4;
    const int bh = u >> 4, b = bh >> 2, h = bh & 3, chunk = 2 * (u & 15) + half;
    LAS unsigned char* L = lds + half * P_HALF; LAS float* SC = (LAS float*)(L + P_SC); LAS float* AT = (LAS float*)(L + P_AT);
    const bf16_t* proj = (const bf16_t*)(ws + WS_PROJ); const size_t row0 = (size_t)b * SEQ + 64 * chunk;
    unsigned char* rec = (unsigned char*)a.out + (size_t)(bh * NCHUNK + chunk) * REC_BYTES;
    unsigned char* urec = ws + WS_XN + (size_t)(bh * NCHUNK + chunk) * UREC_BYTES;
    PROF_DECL PROF_BEGIN(1)
    if (w4 == 0) {
        const bf16_t* pr = proj + (row0 + lane) * PJ;
        const float beta = sigmf(bf2f(pr[PC_B + h])); const float av = bf2f(pr[PC_A + h]) + a.dt_bias[h];
        float g = -__expf(a.a_log[h]) * softplusf(av);
#pragma unroll
        for (int o = 1; o < 64; o <<= 1) { const float up = __shfl_up(g, o); if (lane >= o) g += up; }
        const float glast = __shfl(g, 63);
        SC[SC_BETA + lane] = beta; SC[SC_GC + lane] = g; SC[SC_EGC + lane] = __expf(g); SC[SC_EKD + lane] = __expf(glast - g);
        if (lane == 63) ((float*)(ws + WS_GL))[bh * NCHUNK + chunk] = __expf(g);
    }
    float x[64];
    const int kc = c & 127;
    { const bf16_t* prow = proj + (row0 - 3) * PJ + h * 128; const int cols_qk[2] = {PC_GQ, PC_GK}; const int cols_v[2] = {PC_GV, PC_GV};
      slab_dma(prow, cols_qk, 2, L + P_STG, w4, lane);
      asm volatile("s_waitcnt vmcnt(0)" ::: "memory"); __syncthreads();
      PROF_END(1) PROF_BEGIN(2)
      const int pos = perm32pos(kc & 31), ch = 4 * (kc >> 5) + (pos >> 3), jb = (pos & 7) * 2;
      if (c < 128) { conv64(x, (LAS const bf16_t*)(L + P_STG) + kc, a.conv_w, h * 128 + kc, chunk == 0);
#pragma unroll
          for (int i = 0; i < 64; i += 2) { const unsigned w = cvtpk(x[i], x[i + 1]);
              *(LAS bf16_t*)(L + P_QR + i * 256 + ((ch ^ (i & 15)) << 4) + jb) = (bf16_t)w; *(LAS bf16_t*)(L + P_QR + (i + 1) * 256 + ((ch ^ ((i + 1) & 15)) << 4) + jb) = (bf16_t)(w >> 16); }
      } else { conv64(x, (LAS const bf16_t*)(L + P_STG + SLAB) + kc, a.conv_w, 512 + h * 128 + kc, chunk == 0);
#pragma unroll
          for (int i = 0; i < 64; i += 2) { const unsigned w = cvtpk(x[i], x[i + 1]);
              *(LAS bf16_t*)(L + P_KR + i * 256 + ((ch ^ (i & 15)) << 4) + jb) = (bf16_t)w; *(LAS bf16_t*)(L + P_KR + (i + 1) * 256 + ((ch ^ ((i + 1) & 15)) << 4) + jb) = (bf16_t)(w >> 16);
              x[i] = __uint_as_float(w << 16); x[i + 1] = __uint_as_float(w & 0xffff0000u); }
      }
      __syncthreads();
      PROF_END(2) PROF_BEGIN(3)
      slab_dma(prow, cols_v, 1, L + P_STG, w4, lane);
      asm volatile("s_waitcnt vmcnt(0)" ::: "memory"); __syncthreads();
      if (c < 128) conv64(x, (LAS const bf16_t*)(L + P_STG) + kc, a.conv_w, 1024 + h * 128 + kc, chunk == 0);
    }
    __syncthreads();
    PROF_END(3) PROF_BEGIN(4)
    f32x4 kk[4], qk[4], qq;
    {
        bf16x8 ak[4], aq[4];
        const int ri = 16 * w4 + fr;
#pragma unroll
        for (int s = 0; s < 4; ++s) { const int o = ri * 256 + (((4 * s + fq) ^ fr) << 4); ak[s] = *(LAS const bf16x8*)(L + P_KR + o); aq[s] = *(LAS const bf16x8*)(L + P_QR + o); }
        qq = (f32x4){0.f, 0.f, 0.f, 0.f};
#pragma unroll
        for (int s = 0; s < 4; ++s) qq = __builtin_amdgcn_mfma_f32_16x16x32_bf16(aq[s], aq[s], qq, 0, 0, 0);
#pragma unroll
        for (int nt = 0; nt < 4; ++nt) {
            kk[nt] = (f32x4){0.f, 0.f, 0.f, 0.f}; qk[nt] = (f32x4){0.f, 0.f, 0.f, 0.f};
            if (nt <= w4) {
                const int rj = 16 * nt + fr;
#pragma unroll
                for (int s = 0; s < 4; ++s) { const bf16x8 bk = *(LAS const bf16x8*)(L + P_KR + rj * 256 + (((4 * s + fq) ^ fr) << 4));
                    kk[nt] = __builtin_amdgcn_mfma_f32_16x16x32_bf16(ak[s], bk, kk[nt], 0, 0, 0);
                    qk[nt] = __builtin_amdgcn_mfma_f32_16x16x32_bf16(aq[s], bk, qk[nt], 0, 0, 0); }
            }
        }
#pragma unroll
        for (int nt = 0; nt < 4; ++nt) if (nt == w4) {
#pragma unroll
            for (int r = 0; r < 4; ++r) if (fr == 4 * fq + r) { const int i = 16 * w4 + fr; const float rk = rsqrtf(kk[nt][r] + RMS_EPS);
                SC[SC_RK2 + i] = rk; SC[SC_RQ2 + i] = rsqrtf(qq[r] + RMS_EPS); SC[SC_FKD + i] = SC[SC_EKD + i] * rk; SC[SC_FW + i] = SC[SC_BETA + i] * SC[SC_EGC + i] * rk; } }
    }
    __syncthreads();
    PROF_END(4) PROF_BEGIN(5)
    {
#pragma unroll
        for (int nt = 0; nt < 4; ++nt) {
            const int j = 16 * nt + fr; const float rkj = SC[SC_RK2 + j], gcj = SC[SC_GC + j];
            f32x4 av; float qv[4];
#pragma unroll
            for (int r = 0; r < 4; ++r) { const int i = 16 * w4 + 4 * fq + r; const float gci = SC[SC_GC + i];
                const float dec = __expf(fminf(gci - gcj, 0.f));
                const float rki = SC[SC_RK2 + i], rqi = SC[SC_RQ2 + i];
                av[r] = (nt <= w4 && j < i) ? SC[SC_BETA + i] * kk[nt][r] * rki * rkj * dec : 0.f;
                qv[r] = (nt <= w4 && j <= i) ? qk[nt][r] * rqi * rkj * 0.08838834764831845f * dec : 0.f; }
            *(LAS f32x4*)(AT + j * 64 + 16 * w4 + 4 * fq) = av;
            { const unsigned w01 = cvtpk(qv[0], qv[1]), w23 = cvtpk(qv[2], qv[3]); const int i0 = 16 * w4 + 4 * fq;
              *(LAS bf16_t*)(L + P_QKI + off128(i0, j)) = (bf16_t)w01; *(LAS bf16_t*)(L + P_QKI + off128(i0 + 1, j)) = (bf16_t)(w01 >> 16);
              *(LAS bf16_t*)(L + P_QKI + off128(i0 + 2, j)) = (bf16_t)w23; *(LAS bf16_t*)(L + P_QKI + off128(i0 + 3, j)) = (bf16_t)(w23 >> 16); }
        }
        if (c >= 128) {
#define KDV(j) (x[j] * SC[SC_FKD + (j)])
#pragma unroll
            for (int ch = 0; ch < 8; ++ch) { const int j0 = 32 * (ch >> 2) + 4 * (ch & 3);
                const bf16x8 v = pack8(KDV(j0), KDV(j0 + 1), KDV(j0 + 2), KDV(j0 + 3), KDV(j0 + 16), KDV(j0 + 17), KDV(j0 + 18), KDV(j0 + 19));
                *(bf16x8*)(rec + REC_KD + kc * 128 + ((ch ^ (kc & 7)) << 4)) = v; }
#undef KDV
#pragma unroll
            for (int i = 0; i < 64; ++i) x[i] = x[i] * SC[SC_FW + i];
        } else {
#pragma unroll
            for (int i = 0; i < 64; ++i) x[i] = x[i] * SC[SC_BETA + i];
        }
        { const int i = c >> 2; const float f = SC[SC_RQ2 + i] * 0.08838834764831845f * SC[SC_EGC + i];
#pragma unroll
          for (int cc = 0; cc < 4; ++cc) { const int o = i * 256 + ((4 * (c & 3) + cc) << 4);
              const u32x4 v = *(LAS const u32x4*)(L + P_QR + o);
              const bf16x8 w = pack8(__uint_as_float(v.x << 16) * f, __uint_as_float(v.x & 0xffff0000u) * f, __uint_as_float(v.y << 16) * f, __uint_as_float(v.y & 0xffff0000u) * f,
                                     __uint_as_float(v.z << 16) * f, __uint_as_float(v.z & 0xffff0000u) * f, __uint_as_float(v.w << 16) * f, __uint_as_float(v.w & 0xffff0000u) * f);
              *(bf16x8*)(rec + REC_QG + o) = w; } }
    }
    __syncthreads();
    PROF_END(5) PROF_BEGIN(6)
    {
        const LAS f32x4* AT4 = (const LAS f32x4*)AT;
#pragma unroll
        for (int j = 0; j < 63; ++j) {
            const float xj = x[j];
#pragma unroll
            for (int i4 = (j + 1) / 4; i4 < 16; ++i4) { const f32x4 av = AT4[j * 16 + i4];
#pragma unroll
                for (int r = 0; r < 4; ++r) if (4 * i4 + r > j) x[4 * i4 + r] -= av[r] * xj; }
            __builtin_amdgcn_sched_barrier(0);
        }
#pragma unroll
        for (int cc = 0; cc < 2; ++cc) { const int o = (c * 2 + cc) * 16; *(u32x4*)(rec + REC_QK + o) = *(LAS const u32x4*)(L + P_QKI + o); }
        if (c < 128) {
            const int wv = kc >> 4, cc = kc & 15;
#pragma unroll
            for (int it = 0; it < 4; ++it)
#pragma unroll
                for (int q = 0; q < 4; ++q) { const int i0 = 16 * it + 4 * q;
                    *(f32x4*)(urec + (size_t)(((wv * 4 + it) * 64) + q * 16 + cc) * 16) = (f32x4){x[i0], x[i0 + 1], x[i0 + 2], x[i0 + 3]}; }
        } else {
            const int pos = perm32pos(kc & 31), ch = 4 * (kc >> 5) + (pos >> 3), jb = (pos & 7) * 2;
#pragma unroll
            for (int i = 0; i < 64; i += 2) { const unsigned w = cvtpk(-x[i], -x[i + 1]);
                *(LAS bf16_t*)(L + P_KR + i * 256 + ((ch ^ (i & 15)) << 4) + jb) = (bf16_t)w; *(LAS bf16_t*)(L + P_KR + (i + 1) * 256 + ((ch ^ ((i + 1) & 15)) << 4) + jb) = (bf16_t)(w >> 16); }
        }
    }
    __syncthreads();
    PROF_END(6) PROF_BEGIN(7)
#pragma unroll
    for (int cc = 0; cc < 4; ++cc) { const int o = (c * 4 + cc) * 16; *(u32x4*)(rec + REC_W + o) = *(LAS const u32x4*)(L + P_KR + o); }
    __syncthreads();
    PROF_END(7)
}

__device__ __forceinline__ float row_sum16(float v) {
    v += __builtin_bit_cast(float, __builtin_amdgcn_update_dpp(0, __builtin_bit_cast(int, v), 0x128, 0xf, 0xf, false));
    v += __builtin_bit_cast(float, __builtin_amdgcn_update_dpp(0, __builtin_bit_cast(int, v), 0x124, 0xf, 0xf, false));
    v += __builtin_bit_cast(float, __builtin_amdgcn_update_dpp(0, __builtin_bit_cast(int, v), 0x122, 0xf, 0xf, false));
    v += __builtin_bit_cast(float, __builtin_amdgcn_update_dpp(0, __builtin_bit_cast(int, v), 0x121, 0xf, 0xf, false));
    return v;
}
__device__ __forceinline__ void scan_unit(const Args& a, LAS unsigned char* lds, int bh, int wave, int lane) {
    unsigned char* ws = a.ws;
    const int b = bh >> 2, h = bh & 3, fr = lane & 15, fq = lane >> 4;
    const unsigned char* recb = (const unsigned char*)a.out + (size_t)bh * NCHUNK * REC_BYTES;
    const unsigned char* urecb = ws + WS_XN + (size_t)bh * NCHUNK * UREC_BYTES;
    const float* gl = (const float*)(ws + WS_GL) + bh * NCHUNK;
    const bf16_t* zbase = (const bf16_t*)(ws + WS_PROJ) + (size_t)b * SEQ * PJ + PC_Z + h * 128 + 16 * wave + fr;
    bf16_t* mbase = (bf16_t*)(ws + WS_MIX) + (size_t)b * SEQ * DM + 512 + h * 128 + 16 * wave + fr;
    const float ng = a.gdn_norm_g[16 * wave + fr];
    f32x4 S[8];
#pragma unroll
    for (int kt = 0; kt < 8; ++kt) S[kt] = (f32x4){0.f, 0.f, 0.f, 0.f};
#pragma unroll
    for (int p = 0; p < 7; ++p) __builtin_amdgcn_global_load_lds((const unsigned*)(recb + (size_t)(wave + 8 * p) * 1024 + lane * 16), (LAS unsigned*)(lds + S_BUF + (wave + 8 * p) * 1024), 16, 0, 0);
    f32x4 un[4]; unsigned short zn[16]; float egn; bf16_t pend[16];
    { const f32x4* up = (const f32x4*)urecb + (wave * 4) * 64 + lane;
#pragma unroll
      for (int it = 0; it < 4; ++it) un[it] = up[it * 64];
#pragma unroll
      for (int it = 0; it < 4; ++it)
#pragma unroll
          for (int r = 0; r < 4; ++r) zn[4 * it + r] = zbase[(size_t)(16 * it + 4 * fq + r) * PJ];
      egn = gl[0];
#pragma unroll
      for (int i = 0; i < 16; ++i) pend[i] = 0; }
    PROF_DECL
    for (int ck = 0; ck < NCHUNK; ++ck) {
        LAS const unsigned char* buf = lds + S_BUF + (ck & 1) * REC_BYTES;
        PROF_BEGIN(21)
        asm volatile("s_waitcnt vmcnt(0)" ::: "memory"); __syncthreads();
        PROF_END(21) PROF_BEGIN(22)
        if (ck + 1 < NCHUNK) { const unsigned char* src = recb + (size_t)(ck + 1) * REC_BYTES; LAS unsigned char* dst = lds + S_BUF + ((ck + 1) & 1) * REC_BYTES;
#pragma unroll
            for (int p = 0; p < 7; ++p) __builtin_amdgcn_global_load_lds((const unsigned*)(src + (size_t)(wave + 8 * p) * 1024 + lane * 16), (LAS unsigned*)(dst + (wave + 8 * p) * 1024), 16, 0, 0); }
        if (ck > 0) {
#pragma unroll
            for (int it = 0; it < 4; ++it)
#pragma unroll
                for (int r = 0; r < 4; ++r) mbase[(size_t)(64 * (ck - 1) + 16 * it + 4 * fq + r) * DM] = pend[4 * it + r]; }
        f32x4 av[4], ao[4]; float zv[16];
#pragma unroll
        for (int it = 0; it < 4; ++it) { av[it] = un[it]; ao[it] = (f32x4){0.f, 0.f, 0.f, 0.f}; }
#pragma unroll
        for (int i = 0; i < 16; ++i) zv[i] = bf2f(zn[i]);
        const float egl = egn;
        { const int cn = ck + 1 < NCHUNK ? ck + 1 : ck;
          const f32x4* up = (const f32x4*)(urecb + (size_t)cn * UREC_BYTES) + (wave * 4) * 64 + lane;
#pragma unroll
          for (int it = 0; it < 4; ++it) un[it] = up[it * 64];
#pragma unroll
          for (int it = 0; it < 4; ++it)
#pragma unroll
              for (int r = 0; r < 4; ++r) zn[4 * it + r] = zbase[(size_t)(64 * cn + 16 * it + 4 * fq + r) * PJ];
          egn = gl[cn]; }
        PROF_END(22) PROF_BEGIN(23)
        bf16x8 Sb[4];
#pragma unroll
        for (int s = 0; s < 4; ++s) Sb[s] = pack8(S[2 * s][0], S[2 * s][1], S[2 * s][2], S[2 * s][3], S[2 * s + 1][0], S[2 * s + 1][1], S[2 * s + 1][2], S[2 * s + 1][3]);
#pragma unroll
        for (int it = 0; it < 4; ++it) { const int o = (16 * it + fr) * 256;
#pragma unroll
            for (int s = 0; s < 4; ++s) { const int co = ((4 * s + fq) ^ fr) << 4;
                av[it] = __builtin_amdgcn_mfma_f32_16x16x32_bf16(*(LAS const bf16x8*)(buf + REC_W + o + co), Sb[s], av[it], 0, 0, 0);
                ao[it] = __builtin_amdgcn_mfma_f32_16x16x32_bf16(*(LAS const bf16x8*)(buf + REC_QG + o + co), Sb[s], ao[it], 0, 0, 0); } }
        bf16x8 vb[2];
#pragma unroll
        for (int s = 0; s < 2; ++s) vb[s] = pack8(av[2 * s][0], av[2 * s][1], av[2 * s][2], av[2 * s][3], av[2 * s + 1][0], av[2 * s + 1][1], av[2 * s + 1][2], av[2 * s + 1][3]);
#pragma unroll
        for (int it = 0; it < 4; ++it) { const int o = (16 * it + fr) * 128;
#pragma unroll
            for (int s = 0; s < 2; ++s) ao[it] = __builtin_amdgcn_mfma_f32_16x16x32_bf16(*(LAS const bf16x8*)(buf + REC_QK + o + (((4 * s + fq) ^ (fr & 7)) << 4)), vb[s], ao[it], 0, 0, 0); }
        PROF_END(23) PROF_BEGIN(24)
        LAS float* SSQ = (LAS float*)(lds + S_SSQ) + (ck & 1) * 512;
#pragma unroll
        for (int it = 0; it < 4; ++it)
#pragma unroll
            for (int r = 0; r < 4; ++r) { const float s2 = row_sum16(ao[it][r] * ao[it][r]);
                if (fr == 0) SSQ[(16 * it + 4 * fq + r) * 8 + wave] = s2; }
#pragma unroll
        for (int kt = 0; kt < 8; ++kt) { S[kt] = S[kt] * egl; const int o = (16 * kt + fr) * 128;
#pragma unroll
            for (int s = 0; s < 2; ++s) S[kt] = __builtin_amdgcn_mfma_f32_16x16x32_bf16(*(LAS const bf16x8*)(buf + REC_KD + o + (((4 * s + fq) ^ (fr & 7)) << 4)), vb[s], S[kt], 0, 0, 0); }
        asm volatile("s_waitcnt lgkmcnt(0)" ::: "memory"); __builtin_amdgcn_s_barrier(); asm volatile("" ::: "memory");
        PROF_END(24) PROF_BEGIN(25)
#pragma unroll
        for (int it = 0; it < 4; ++it)
#pragma unroll
            for (int r = 0; r < 4; ++r) { const int i = 16 * it + 4 * fq + r; const f32x4 p0 = *(LAS const f32x4*)(SSQ + i * 8), p1 = *(LAS const f32x4*)(SSQ + i * 8 + 4);
                const float tot = ((p0[0] + p0[1]) + (p0[2] + p0[3])) + ((p1[0] + p1[1]) + (p1[2] + p1[3]));
                const float rs = rsqrtf(tot * (1.f / 128.f) + RMS_EPS);
                pend[4 * it + r] = f2bf(ao[it][r] * rs * ng * siluf(zv[4 * it + r])); }
        PROF_END(25)
    }
#pragma unroll
    for (int it = 0; it < 4; ++it)
#pragma unroll
        for (int r = 0; r < 4; ++r) mbase[(size_t)(64 * (NCHUNK - 1) + 16 * it + 4 * fq + r) * DM] = pend[4 * it + r];
    __syncthreads();
}
}

#ifndef PG8_ALIGN
#define PG8_ALIGN true
#endif
constexpr int NWAVES = 8;
constexpr int RING_BYTES = 131072;
constexpr int MISC_OFF = 147456 - 512;
constexpr int LDS_BYTES = 147456;
#ifndef LAS
#define LAS __attribute__((address_space(3)))
#endif
#define GAS __attribute__((address_space(1)))
typedef unsigned v4u __attribute__((ext_vector_type(4)));
typedef float f32x4 __attribute__((ext_vector_type(4)));
#define LDS_WAIT() asm volatile("s_waitcnt lgkmcnt(0)" ::: "memory")
#define VM_WAIT() asm volatile("s_waitcnt vmcnt(0)" ::: "memory")
constexpr int CW_BAR = 4096, CW_QUEUE = 8192;


__device__ __forceinline__ unsigned pk2(float lo, float hi) { return (unsigned)f2bf(lo) | ((unsigned)f2bf(hi) << 16); }
template <bool F8OUT = false>
__device__ __forceinline__ void p0_transpose_item(const float* colp, int ld, const float* gain, int gain_n, int K, bf16_t* WT, LAS float* scr, int k0, int n0, int lane) {
#pragma unroll
    for (int i = 0; i < 32; ++i) { const int kk = 2 * i + (lane >> 5); float v = 0.f;
        if (colp) { v = colp[(size_t)(k0 + kk) * ld]; if (gain && (k0 + kk) < gain_n) v *= gain[k0 + kk]; }
        scr[kk * 33 + (lane & 31)] = v; }
    LDS_WAIT(); asm volatile("" ::: "memory");
    const int c = lane & 7;
#pragma unroll
    for (int j = 0; j < 4; ++j) { const int n = (lane >> 3) + 8 * j; const LAS float* s = scr + (8 * c) * 33 + n;
        if constexpr (F8OUT) { unsigned lo = 0u, hi = 0u;
            lo = __builtin_amdgcn_cvt_pk_fp8_f32(s[0 * 33] * F8_WMUL, s[1 * 33] * F8_WMUL, lo, false); lo = __builtin_amdgcn_cvt_pk_fp8_f32(s[2 * 33] * F8_WMUL, s[3 * 33] * F8_WMUL, lo, true);
            hi = __builtin_amdgcn_cvt_pk_fp8_f32(s[4 * 33] * F8_WMUL, s[5 * 33] * F8_WMUL, hi, false); hi = __builtin_amdgcn_cvt_pk_fp8_f32(s[6 * 33] * F8_WMUL, s[7 * 33] * F8_WMUL, hi, true);
            *(unsigned long long*)((unsigned char*)WT + (size_t)(n0 + n) * K + k0 + 8 * c) = (unsigned long long)lo | ((unsigned long long)hi << 32); }
        else { v4u o; o.x = pk2(s[0 * 33], s[1 * 33]); o.y = pk2(s[2 * 33], s[3 * 33]); o.z = pk2(s[4 * 33], s[5 * 33]); o.w = pk2(s[6 * 33], s[7 * 33]);
            *(v4u*)(WT + (size_t)(n0 + n) * K + k0 + 8 * c) = o; } }
    LDS_WAIT(); asm volatile("" ::: "memory");
}
__device__ __forceinline__ void p0_prologue(const Args& a, LAS unsigned char* lds, int vcu, int G, int wave, int lane) {
    unsigned char* ws = a.ws;
    LAS float* scr = (LAS float*)(lds + wave * 16384);
    const int gw = vcu * NWAVES + wave, NGW = G * NWAVES;
    constexpr int I_IN = 16 * (PJ / 32), I_OUT = 16 * 32, I_GU = 16 * (2 * DFF / 32), I_DN = (DFF / 64) * 32, I_W1 = 2 * 32 * 4, I_W2 = 2 * 2 * 2;
    constexpr int NITEMS = I_IN + I_OUT + I_GU + I_DN + I_W1 + I_W2;
    for (int it = gw; it < NITEMS; it += NGW) {
        int r = it;
        if (r < I_IN) { const int nblk = PJ / 32, kb = r / nblk, nb = r % nblk; const int n = nb * 32 + (lane & 31); const int oc = win_orig_col(n);
            p0_transpose_item(oc < 0 ? nullptr : a.w_in + oc, IN_W, nullptr, 0, DM, (bf16_t*)(ws + WS_WIN), scr, kb * 64, nb * 32, lane); continue; } r -= I_IN;
        if (r < I_OUT) { const int kb = r / 32, nb = r % 32; const int n = nb * 32 + (lane & 31);
            p0_transpose_item(a.w_out + n, DM, a.nsa_norm_g, 512, DM, (bf16_t*)(ws + WS_WOUT), scr, kb * 64, nb * 32, lane); continue; } r -= I_OUT;
        if (r < I_GU) { const int nblk = 2 * DFF / 32, kb = r / nblk, nb = r % nblk; const int n = nb * 32 + (lane & 31); const int pn = n >> 8, wi = n & 255;
            const float* W = (wi < 128) ? a.w_gate : a.w_up;
            p0_transpose_item<true>(W + pn * 128 + (wi & 127), DFF, a.norm2_g, DM, DM, (bf16_t*)(ws + WS_WGU), scr, kb * 64, nb * 32, lane); continue; } r -= I_GU;
        if (r < I_DN) { const int kb = r / 32, nb = r % 32; const int n = nb * 32 + (lane & 31);
            p0_transpose_item<true>(a.w_down + n, DM, nullptr, 0, DFF, (bf16_t*)(ws + WS_WDN), scr, kb * 64, nb * 32, lane); continue; } r -= I_DN;
        if (r < I_W1) { const int i = r / 128, rr = r % 128, kb = rr / 4, nb = rr % 4; const int n = nb * 32 + (lane & 31);
            p0_transpose_item(a.cmp_w1 + (size_t)i * 2048 * 128 + n, 128, nullptr, 0, 2048, (bf16_t*)(ws + WS_W1T) + (size_t)i * 128 * 2048, scr, kb * 64, nb * 32, lane); continue; } r -= I_W1;
        { const int i = r / 4, rr = r % 4, kb = rr / 2, nb = rr % 2; const int n = nb * 32 + (lane & 31);
            p0_transpose_item(a.cmp_w2 + (size_t)i * 128 * 64 + n, 64, nullptr, 0, 128, (bf16_t*)(ws + WS_W2T) + (size_t)i * 64 * 128, scr, kb * 64, nb * 32, lane); }
    }
    bf16_t* xn = (bf16_t*)(ws + WS_XN);
    for (int m0 = gw * 4; m0 < MTOK; m0 += NGW * 4) {
        f32x4 v[4][4];
#pragma unroll
        for (int rr = 0; rr < 4; ++rr) { const f32x4* xr = (const f32x4*)(a.x + (size_t)(m0 + rr) * DM) + lane;
#pragma unroll
            for (int j = 0; j < 4; ++j) v[rr][j] = xr[64 * j]; }
        f32x4 gg[4];
#pragma unroll
        for (int j = 0; j < 4; ++j) gg[j] = *((const f32x4*)a.norm1_g + lane + 64 * j);
#pragma unroll
        for (int rr = 0; rr < 4; ++rr) { float s = 0.f;
#pragma unroll
            for (int j = 0; j < 4; ++j) s += (v[rr][j].x * v[rr][j].x + v[rr][j].y * v[rr][j].y) + (v[rr][j].z * v[rr][j].z + v[rr][j].w * v[rr][j].w);
            s = wave_sum(s); const float rstd = rsqrtf(s * (1.f / DM) + RMS_EPS);
            unsigned long long* o8 = (unsigned long long*)(xn + (size_t)(m0 + rr) * DM) + lane;
#pragma unroll
            for (int j = 0; j < 4; ++j) o8[64 * j] = (unsigned long long)pk2(v[rr][j].x * rstd * gg[j].x, v[rr][j].y * rstd * gg[j].y) | ((unsigned long long)pk2(v[rr][j].z * rstd * gg[j].z, v[rr][j].w * rstd * gg[j].w) << 32); }
    }
    float* tab = (float*)(ws + WS_ROPE);
    for (int i = gw * 64 + lane; i < MTOK * 8; i += NGW * 64) {
        const int m = i >> 3, f = i & 7;
        const float inv = powf(500000.0f, -(float)f * (2.0f / 16.0f));
        const float ang = (float)a.positions[m] * inv;
        tab[m * 16 + f] = cosf(ang); tab[m * 16 + 8 + f] = sinf(ang);
    }
}
__device__ __forceinline__ void p7_final(const Args& a, int vcu, int G, int wave, int lane) {
    const int gw = vcu * NWAVES + wave, NGW = G * NWAVES; const float* ss = (const float*)(a.ws + WS_SS3);
    for (int m = gw; m < MTOK; m += NGW) {
        const f32x4* sp = (const f32x4*)(ss + (size_t)m * 16); const f32x4 t = (sp[0] + sp[1]) + (sp[2] + sp[3]);
        const float rstd = rsqrtf(((t[0] + t[1]) + (t[2] + t[3])) * (1.f / DM) + RMS_EPS);
        f32x4* xr = (f32x4*)(a.out + (size_t)m * DM) + lane;
#pragma unroll
        for (int j = 0; j < 4; ++j) { const f32x4 gg = *((const f32x4*)a.final_g + lane + 64 * j); xr[64 * j] = xr[64 * j] * rstd * gg; }
    }
}

__global__ void __launch_bounds__(NWAVES * 64, 2) mk_fwd(Args args) {
    extern __shared__ __attribute__((aligned(16))) unsigned char lds_raw[];
    LAS unsigned char* lds = (LAS unsigned char*)lds_raw;
    volatile LAS unsigned* MISC = (volatile LAS unsigned*)(lds + MISC_OFF);
    const int tid = threadIdx.x, lane = tid & 63, wave = __builtin_amdgcn_readfirstlane(tid >> 6);
    const int G = gridDim.x; const int bx = blockIdx.x; const int vcu = (G % 8 == 0) ? (bx % 8) * (G / 8) + bx / 8 : bx;
    unsigned char* ws = args.ws;
    for (int u = tid; u < (LDS_BYTES - MISC_OFF) / 4; u += NWAVES * 64) ((LAS unsigned*)(lds + MISC_OFF))[u] = 0u;
    __syncthreads();
    const int lo = args.ph_lo, hi = args.ph_hi;
    const bool multi = (hi - lo) > 1;
    XcdBarrier bar; bar.bar = (unsigned*)(ws + WS_CTL) + CW_BAR; bar.x = 0; bar.st = nullptr;
    if (multi) bar = xcd_barrier_post((unsigned*)(ws + WS_CTL) + CW_BAR, MISC + 8);
#define IN(k) (lo <= (k) && (k) < hi)
#define REPB(k)
#define REPE
#define SEAM(k) do { if (IN(k) && IN((k) + 1)) xcd_barrier(bar); } while (0)
    if (IN(0)) { REPB(0) p0_prologue(args, lds, vcu, G, wave, lane); REPE SEAM(0); }
    if (IN(1)) { REPB(1)
        pg8::Gemm g{(const bf16_t*)(ws + WS_XN), (const bf16_t*)(ws + WS_WIN), MTOK, PJ, DM}; pg8::StaticOrder S; S.init(MTOK, PJ, G, bx);
        pg8::EpiProj E{(bf16_t*)(ws + WS_PROJ), (const float*)(ws + WS_ROPE), -1};
        pg8::gemm_phase<pg8::EpiProj, pg8::StaticOrder, PG8_ALIGN, PG8_SP2>(lds, g, S, E);
        REPE SEAM(1);
    }
    if (IN(2)) { REPB(2)
        if (!(args.flags & 1)) for (int u = vcu; u < 128; u += G) nsa::compress_unit(ws, args.cmp_pos, lds, u, wave, lane);
        if (!(args.flags & 2)) {
            unsigned* pctr = (unsigned*)(ws + WS_CTL) + CW_QUEUE + 128; LAS int* QW = (LAS int*)(lds + nsa::L_QUEUE);
            for (;;) {
                if (tid == 0) *QW = (int)atomicAdd(pctr, 1u);
                __syncthreads();
                const int u = *QW;
                if (u >= 1024) break;
                gdn::prep_unit(args, lds, u, wave, lane);
            }
        }
        PROF_FLUSH(); REPE SEAM(2);
    }
    if (IN(3)) { REPB(3)
        if (bx < BATCH * GH && !(args.flags & 4)) gdn::scan_unit(args, lds, bx, wave, lane);
        unsigned* qctr = (unsigned*)(ws + WS_CTL) + CW_QUEUE; LAS int* QW = (LAS int*)(lds + nsa::L_QUEUE);
        if (!(args.flags & 8)) for (;;) {
            if (tid == 0) *QW = (int)atomicAdd(qctr, 1u);
            __syncthreads();
            const int u = *QW;
            if (u >= 1024) break;
            nsa::attn_unit(ws, lds, (u & 31) >> 1, u & 1, 31 - (u >> 5), wave, lane);
        }
        PROF_FLUSH(); REPE SEAM(3);
    }
    if (IN(4)) { REPB(4)
        pg8::Gemm g{(const bf16_t*)(ws + WS_MIX), (const bf16_t*)(ws + WS_WOUT), MTOK, DM, DM}; pg8::StaticOrder S; S.init(MTOK, DM, G, bx);
        pg8::EpiOut E{args.x, ws + WS_X1F8, (bf16_t*)(ws + WS_XN), (float*)(ws + WS_SS2), (const float*)(ws + WS_SSQN), 8};
        pg8::gemm_phase<pg8::EpiOut, pg8::StaticOrder, PG8_ALIGN, PG8_SP2>(lds, g, S, E);
        REPE SEAM(4);
    }
    if (IN(5)) { REPB(5)
        pg8::Gemm g{(const bf16_t*)(ws + WS_X1F8), (const bf16_t*)(ws + WS_WGU), MTOK, 2 * DFF, DM / 2}; pg8::StaticOrder S; S.init(MTOK, 2 * DFF, G, bx);
        pg8::EpiGU E{ws + WS_PROJ, (const float*)(ws + WS_SS2), -1};
        pg8::gemm_phase<pg8::EpiGU, pg8::StaticOrder, PG8_ALIGN, false, true>(lds, g, S, E);
        REPE SEAM(5);
    }
    if (IN(6)) {
        pg8::Gemm g{(const bf16_t*)(ws + WS_PROJ), (const bf16_t*)(ws + WS_WDN), MTOK, DM, DFF / 2}; pg8::StaticOrder S; S.init(MTOK, DM, G, bx);
        pg8::EpiDown E{args.out, (const bf16_t*)(ws + WS_XN), (float*)(ws + WS_SS3), -1};
        pg8::gemm_phase<pg8::EpiDown, pg8::StaticOrder, PG8_ALIGN, false, true>(lds, g, S, E);
        SEAM(6);
    }
    if (IN(7)) p7_final(args, vcu, G, wave, lane);
#undef IN
#undef SEAM
}

extern "C" void kernel_launch(void* const* d_in, const int* in_sizes, int n_in, void* d_out, int out_size, void* d_ws, size_t ws_size, hipStream_t stream) {
    static int grid = 0;
    if (grid == 0) {
        if (n_in != 18 || ws_size < WS_END) { fprintf(stderr, "kernel_launch: unexpected inputs / workspace (%d, %zu)\n", n_in, ws_size); grid = -1; return; }
        int dev = 0, cus = 0;
        if (hipGetDevice(&dev) != hipSuccess || hipDeviceGetAttribute(&cus, hipDeviceAttributeMultiprocessorCount, dev) != hipSuccess) { grid = -1; return; }
        if (hipFuncSetAttribute((const void*)mk_fwd, hipFuncAttributeMaxDynamicSharedMemorySize, LDS_BYTES) != hipSuccess) { fprintf(stderr, "kernel_launch: hipFuncSetAttribute failed\n"); grid = -1; return; }
        (void)hipGetLastError();
        grid = cus;
    }
    if (grid < 0) return;
    (void)hipMemsetAsync((char*)d_ws + WS_CTL, 0, 1 * MiB, stream);
    Args a{};
    a.x = (const float*)d_in[0]; a.positions = (const int*)d_in[1]; a.norm1_g = (const float*)d_in[2]; a.w_in = (const float*)d_in[3]; a.cmp_pos = (const float*)d_in[4];
    a.cmp_w1 = (const float*)d_in[5]; a.cmp_w2 = (const float*)d_in[6]; a.nsa_norm_g = (const float*)d_in[7]; a.conv_w = (const float*)d_in[8]; a.a_log = (const float*)d_in[9];
    a.dt_bias = (const float*)d_in[10]; a.gdn_norm_g = (const float*)d_in[11]; a.w_out = (const float*)d_in[12]; a.norm2_g = (const float*)d_in[13]; a.w_gate = (const float*)d_in[14];
    a.w_up = (const float*)d_in[15]; a.w_down = (const float*)d_in[16]; a.final_g = (const float*)d_in[17];
    a.out = (float*)d_out; a.ws = (unsigned char*)d_ws;
    unsigned char* ws = (unsigned char*)d_ws;
    bf16_t* proj = (bf16_t*)(ws + WS_PROJ); bf16_t* mix = (bf16_t*)(ws + WS_MIX);
    auto launch = [&](int lo, int hi) { a.ph_lo = lo; a.ph_hi = hi; hipLaunchKernelGGL(mk_fwd, dim3(grid), dim3(NWAVES * 64), LDS_BYTES, stream, a); };
#if defined(PROBE_SUB3)
    launch(0, 4); (void)hipMemsetAsync((char*)d_ws + WS_CTL, 0, 1 * MiB, stream); a.flags = PROBE_SUB3; launch(3, 4); a.flags = 0; (void)hipMemsetAsync((char*)d_ws + WS_CTL, 0, 1 * MiB, stream); launch(4, 8);
#elif defined(PROBE_SUB)
    launch(0, 3); a.flags = PROBE_SUB; launch(2, 3); a.flags = 0; (void)hipMemsetAsync((char*)d_ws + WS_CTL, 0, 1 * MiB, stream); launch(3, 8);
#elif defined(PROBE_DUP)
    launch(0, PROBE_DUP + 1); (void)hipMemsetAsync((char*)d_ws + WS_CTL, 0, 1 * MiB, stream); launch(PROBE_DUP, 8);
#else
    launch(0, 8);
#endif
}
```
